# Optimizing an MI355X kernel written in HIP

```python
import jax, jax.numpy as jnp
from jax import lax
import numpy as np

D_MODEL = 2048
BATCH = 16
SEQ = 2048
DEPTH = 4

GRID_W = 64
CTX_LEN = 256
EPS = 1e-6
NEG = -1e30

MIX_WIDTH = D_MODEL
CONV_WIDTH = MIX_WIDTH // 4
FOURIER_WIDTH = MIX_WIDTH // 4
FOURIER_GROUPS = 4
HEAD_DIM = 64
ATTN_WIDTH = MIX_WIDTH // 4
ATTN_HEADS = ATTN_WIDTH // HEAD_DIM
ATTN_KV_HEADS = ATTN_HEADS // 4
KV_WIDTH = ATTN_KV_HEADS * HEAD_DIM
WINDOW = 128
BLOCK = 128
SCALE = HEAD_DIM ** -0.5
ROPE_THETA = 10000.0
MLP_WIDTH = MIX_WIDTH // 4
MLP_GROUPS = 4
CHUNK = 128
D_FF = -(-8 * D_MODEL // (3 * 256)) * 256

OFF_AX = 0
OFF_AB = OFF_AX + CONV_WIDTH
OFF_AC = OFF_AB + CONV_WIDTH
OFF_F = OFF_AC + CONV_WIDTH
OFF_Q = OFF_F + FOURIER_WIDTH
OFF_K = OFF_Q + ATTN_WIDTH
OFF_V = OFF_K + KV_WIDTH
OFF_U = OFF_V + KV_WIDTH
OFF_MV = OFF_U + MLP_WIDTH
N_PROJ = OFF_MV + MLP_WIDTH

kernel_name = "hybrid_parallel_group_diffusion_trunk"


def rmsnorm(x, g):
    xf = x.astype(jnp.float32)
    y = xf * lax.rsqrt(jnp.mean(xf * xf, axis=-1, keepdims=True) + EPS)
    return (y * g.astype(jnp.float32)).astype(x.dtype)


def short_conv(xt, gb, gc, w_conv):
    z = gc * xt
    zp = jnp.pad(z, ((0, 0), (1, 1), (0, 0)))
    y = zp[:, :-2] * w_conv[0] + zp[:, 1:-1] * w_conv[1] + zp[:, 2:] * w_conv[2]
    return gb * y


def fourier_mix(z):
    b, n_pos, _ = z.shape
    zg = z.reshape(b, n_pos, FOURIER_GROUPS, FOURIER_WIDTH // FOURIER_GROUPS).astype(jnp.float32)
    f = jnp.fft.fftn(zg, axes=(1, 3), norm='ortho')
    return jnp.real(f).astype(z.dtype).reshape(b, n_pos, FOURIER_WIDTH)


def axial_rope(t, row, col):
    half = HEAD_DIM // 2
    quarter = half // 2
    inv = ROPE_THETA ** (-jnp.arange(quarter, dtype=jnp.float32) / quarter)

    def rot(ta, pos):
        ang = pos.astype(jnp.float32)[:, None] * inv[None, :]
        cs = jnp.cos(ang)[None, :, None, :].astype(t.dtype)
        sn = jnp.sin(ang)[None, :, None, :].astype(t.dtype)
        t1, t2 = ta[..., :quarter], ta[..., quarter:]
        return jnp.concatenate([t1 * cs - t2 * sn, t2 * cs + t1 * sn], axis=-1)

    return jnp.concatenate([rot(t[..., :half], row), rot(t[..., half:], col)], axis=-1)


def latent_attention(q, k, v, kc, vc, sink):
    b, n_pos = q.shape[0], q.shape[1]
    n_blk = n_pos // BLOCK
    lc = kc.shape[1]
    grp = ATTN_HEADS // ATTN_KV_HEADS
    qb = q.reshape(b, n_blk, BLOCK, ATTN_KV_HEADS, grp, HEAD_DIM)

    def band(t):
        tp = jnp.pad(t, ((0, 0), (BLOCK, BLOCK), (0, 0), (0, 0)))
        tp = tp.reshape(b, n_blk + 2, BLOCK, ATTN_KV_HEADS, HEAD_DIM)
        return jnp.concatenate([tp[:, :-2], tp[:, 1:-1], tp[:, 2:]], axis=2)

    kb, vb = band(k), band(v)
    s_loc = jnp.einsum('bnqkgd,bnjkd->bnkgqj', qb, kb).astype(jnp.float32) * SCALE
    s_ctx = jnp.einsum('bnqkgd,bckd->bnkgqc', qb, kc).astype(jnp.float32) * SCALE
    blk = jnp.arange(n_blk)[:, None, None]
    qpos = blk * BLOCK + jnp.arange(BLOCK)[None, :, None]
    kpos = (blk - 1) * BLOCK + jnp.arange(3 * BLOCK)[None, None, :]
    valid = (jnp.abs(qpos - kpos) <= WINDOW) & (kpos >= 0) & (kpos < n_pos)
    s_loc = jnp.where(valid[None, :, None, None], s_loc, NEG)
    sk = jnp.broadcast_to(sink.astype(jnp.float32).reshape(ATTN_KV_HEADS, grp)[None, None, :, :, None, None],
                          s_loc.shape[:-1] + (1,))
    probs = jax.nn.softmax(jnp.concatenate([s_loc, s_ctx, sk], axis=-1), axis=-1).astype(v.dtype)
    o = (jnp.einsum('bnkgqj,bnjkd->bnqkgd', probs[..., :3 * BLOCK], vb)
         + jnp.einsum('bnkgqc,bckd->bnqkgd', probs[..., 3 * BLOCK:3 * BLOCK + lc], vc))
    return o.reshape(b, n_pos, ATTN_WIDTH)


def context_attention(qc, kc, vc, sink):
    b, lc = qc.shape[0], qc.shape[1]
    grp = ATTN_HEADS // ATTN_KV_HEADS
    qg = qc.reshape(b, lc, ATTN_KV_HEADS, grp, HEAD_DIM)
    s = jnp.einsum('bqkgd,bckd->bkgqc', qg, kc).astype(jnp.float32) * SCALE
    sk = jnp.broadcast_to(sink.astype(jnp.float32).reshape(ATTN_KV_HEADS, grp)[None, :, :, None, None],
                          s.shape[:-1] + (1,))
    probs = jax.nn.softmax(jnp.concatenate([s, sk], axis=-1), axis=-1).astype(vc.dtype)
    o = jnp.einsum('bkgqc,bckd->bqkgd', probs[..., :lc], vc)
    return o.reshape(b, lc, ATTN_WIDTH)


def chunk_mlp(u, v, w_s, b_s):
    b, n_pos, _ = u.shape
    n_chunk = n_pos // CHUNK
    cg = MLP_WIDTH // MLP_GROUPS
    vf = v.reshape(b, n_chunk, CHUNK, MLP_GROUPS, cg).astype(jnp.float32)
    mu = jnp.mean(vf, axis=-1, keepdims=True)
    var = jnp.mean(jnp.square(vf - mu), axis=-1, keepdims=True)
    vn = ((vf - mu) * lax.rsqrt(var + EPS)).astype(v.dtype)
    mixed = jnp.einsum('gpq,bnqgc->bnpgc', w_s, vn) + b_s.T[None, None, :, :, None]
    return (u.reshape(b, n_chunk, CHUNK, MLP_GROUPS, cg) * mixed).reshape(b, n_pos, MLP_WIDTH)


def split_kv(pkv):
    b, n_pos = pkv.shape[0], pkv.shape[1]
    k = pkv[..., :KV_WIDTH].reshape(b, n_pos, ATTN_KV_HEADS, HEAD_DIM)
    v = pkv[..., KV_WIDTH:].reshape(b, n_pos, ATTN_KV_HEADS, HEAD_DIM)
    return k, v


def token_mixers(p, kc, vc, w_conv, w_s, b_s, sink, pos):
    b, n_pos = p.shape[0], p.shape[1]
    ya = short_conv(p[..., OFF_AX:OFF_AB], p[..., OFF_AB:OFF_AC], p[..., OFF_AC:OFF_F], w_conv)
    yb = fourier_mix(p[..., OFF_F:OFF_Q])
    q = p[..., OFF_Q:OFF_K].reshape(b, n_pos, ATTN_HEADS, HEAD_DIM)
    if pos is None:
        yc = context_attention(q, kc, vc, sink)
    else:
        row, col = pos
        k, v = split_kv(p[..., OFF_K:OFF_U])
        yc = latent_attention(axial_rope(q, row, col), axial_rope(k, row, col), v, kc, vc, sink)
    yd = chunk_mlp(jax.nn.gelu(p[..., OFF_U:OFF_MV]), jax.nn.gelu(p[..., OFF_MV:N_PROJ]), w_s, b_s)
    return jnp.concatenate([ya, yb, yc, yd], axis=-1)


def swiglu(h, w_gate, w_up, w_down):
    return (jax.nn.silu(h @ w_gate) * (h @ w_up)) @ w_down


def setup_inputs(seed: int = 0) -> dict:
    key = jax.random.key(seed)
    ks = jax.random.split(key, 18)
    f32 = jnp.float32
    nrm = lambda k, shape, s: jax.random.normal(k, shape, f32) * s
    return {
        'x': nrm(ks[0], (BATCH, SEQ, D_MODEL), 1.0),
        'c': nrm(ks[1], (BATCH, D_MODEL), 1.0),
        'ctx': nrm(ks[2], (BATCH, CTX_LEN, D_MODEL), 1.0),
        'c_ctx': nrm(ks[3], (D_MODEL,), 1.0),
        'w_ada': nrm(ks[4], (DEPTH, D_MODEL, 6 * D_MODEL), 0.5 * D_MODEL ** -0.5),
        'b_ada': nrm(ks[5], (DEPTH, 6 * D_MODEL), 0.02),
        'g_norm1': 1.0 + nrm(ks[6], (DEPTH, D_MODEL), 0.02),
        'w_in': nrm(ks[7], (DEPTH, D_MODEL, N_PROJ), D_MODEL ** -0.5),
        'w_conv': nrm(ks[8], (DEPTH, 3, CONV_WIDTH), 3 ** -0.5),
        'sink': nrm(ks[9], (DEPTH, ATTN_HEADS), 0.5),
        'w_s': nrm(ks[10], (DEPTH, MLP_GROUPS, CHUNK, CHUNK), CHUNK ** -0.5),
        'b_s': 1.0 + nrm(ks[11], (DEPTH, MLP_GROUPS, CHUNK), 0.1),
        'w_out': nrm(ks[12], (DEPTH, MIX_WIDTH, D_MODEL), MIX_WIDTH ** -0.5),
        'g_norm2': 1.0 + nrm(ks[13], (DEPTH, D_MODEL), 0.02),
        'w_gate': nrm(ks[14], (DEPTH, D_MODEL, D_FF), D_MODEL ** -0.5),
        'w_up': nrm(ks[15], (DEPTH, D_MODEL, D_FF), D_MODEL ** -0.5),
        'w_down': nrm(ks[16], (DEPTH, D_FF, D_MODEL), D_FF ** -0.5),
        'g_final': 1.0 + nrm(ks[17], (D_MODEL,), 0.02),
    }


def reference(x, c, ctx, c_ctx, w_ada, b_ada, g_norm1, w_in, w_conv, sink, w_s, b_s, w_out, g_norm2,
              w_gate, w_up, w_down, g_final):
    n_pos = x.shape[1]
    ROWS = n_pos // GRID_W
    row = jnp.repeat(jnp.arange(ROWS, dtype=jnp.int32), GRID_W)
    col = jnp.tile(jnp.arange(GRID_W, dtype=jnp.int32), ROWS)
    silu_c = jax.nn.silu(c)
    silu_cc = jax.nn.silu(c_ctx)
    xc = ctx
    for l in range(DEPTH):
        last = l == DEPTH - 1
        mod = (silu_c @ w_ada[l] + b_ada[l])[:, None, :]
        mod_c = silu_cc @ w_ada[l] + b_ada[l]
        sh1, sc1, gt1, sh2, sc2, gt2 = jnp.split(mod, 6, axis=-1)
        csh1, csc1, cgt1, csh2, csc2, cgt2 = jnp.split(mod_c, 6, axis=-1)
        h = rmsnorm(x, g_norm1[l]) * (1 + sc1) + sh1
        hc = rmsnorm(xc, g_norm1[l]) * (1 + csc1) + csh1
        if last:
            kc, vc = split_kv(hc @ w_in[l][:, OFF_K:OFF_U])
        else:
            pc = hc @ w_in[l]
            kc, vc = split_kv(pc[..., OFF_K:OFF_U])
            yc_ctx = token_mixers(pc, kc, vc, w_conv[l], w_s[l], b_s[l], sink[l], None)
            xc_new = xc + cgt1 * (yc_ctx @ w_out[l])
            hc2 = rmsnorm(xc_new, g_norm2[l]) * (1 + csc2) + csh2
            xc_next = xc_new + cgt2 * swiglu(hc2, w_gate[l], w_up[l], w_down[l])
        p = h @ w_in[l]
        y = token_mixers(p, kc, vc, w_conv[l], w_s[l], b_s[l], sink[l], (row, col))
        x = x + gt1 * (y @ w_out[l])
        h2 = rmsnorm(x, g_norm2[l]) * (1 + sc2) + sh2
        x = x + gt2 * swiglu(h2, w_gate[l], w_up[l], w_down[l])
        if not last:
            xc = xc_next
    return rmsnorm(x, g_final)
```

```cpp
#include <hip/hip_runtime.h>
#include <cstdio>
#include <cstdint>
namespace pg8 {
#define PG8_LAS __attribute__((address_space(3)))
typedef unsigned short bf16_t;
typedef short bf16x8 __attribute__((ext_vector_type(8)));
typedef float f32x4 __attribute__((ext_vector_type(4)));
typedef unsigned u32x4 __attribute__((ext_vector_type(4)));
constexpr int BM = 256, BK = 64, HALF = 128, HTB = HALF * BK * 2  , STAGE_BYTES = 8 * HTB, NXCD = 8, WGM = 8;

__host__ __device__ __forceinline__ int lds_byte(int r, int c) { const int st = (r >> 4) * 2 + (c >> 5), rr = r & 15, cc = c & 31, ob = rr * 64 + cc * 2; return st * 1024 + (ob ^ (((ob >> 9) & 1) << 5)); }
__host__ __device__ __forceinline__ void stage_rc(int b, int& R, int& C) { const int st = b / 1024, sb = b % 1024, swz = sb ^ (((sb >> 9) & 1) << 5); R = (st >> 1) * 16 + swz / 64; C = (st & 1) * 32 + (swz % 64) / 2; }
__host__ __device__ __forceinline__ int perm32(int rho) { const int n = rho >> 4, i = rho & 15; return 8 * (i >> 2) + 4 * n + (i & 3); }

struct Unit { int pm, pn; };
struct Gemm { const bf16_t* A; const bf16_t* Bt; int M, N, K, lda, ldb; };

struct StaticOrder {
    int nM, nN, nwg, G, c;
    __host__ __device__ void init(int M, int N, int G_, int c_) { nM = M / BM; nN = N / BM; nwg = nM * nN; G = G_; c = c_; }
    __host__ __device__ bool next(int i, Unit& u) const {
        const long L = (long)i * G + c; if (L >= nwg) return false;
        int wgid = (int)L; { const int q = nwg / NXCD, r = nwg % NXCD, xcd = wgid % NXCD, off = wgid / NXCD; wgid = (xcd < r ? xcd * (q + 1) : r * (q + 1) + (xcd - r) * q) + off; }
        const int nig = WGM * nN, gid = wgid / nig, fm = gid * WGM, gsz = (nM - fm) < WGM ? (nM - fm) : WGM;
        u.pm = fm + ((wgid % nig) % gsz); u.pn = (wgid % nig) / gsz; return true;
    }
    __device__ __forceinline__ void a_ready(const Unit&) const {}
    __device__ __forceinline__ void done(const Unit&) const {}
};

__device__ __forceinline__ unsigned cvt_pk_bf16(float lo, float hi) { unsigned r; asm volatile("v_cvt_pk_bf16_f32 %0, %1, %2" : "=v"(r) : "v"(lo), "v"(hi)); return r; }
typedef float f32x2 __attribute__((ext_vector_type(2)));
__device__ __forceinline__ float silu_f(float x) { return x * __builtin_amdgcn_rcpf(1.0f + __expf(-x)); }
struct EpiP {
    static constexpr bool PERM = true, AFTER_DRAIN = false;
    bf16_t* O; int ldc;
    __device__ __forceinline__ void operator()(const f32x4 (&acc)[2][2][4][2], const Unit& u, int wr, int wc, int fr, int fq) const {
        const int row0 = u.pm * BM + wr * 64 + fr, col0 = u.pn * BM + wc * 32 + 8 * fq;
#pragma unroll
        for (int ai = 0; ai < 2; ++ai)
#pragma unroll
            for (int m = 0; m < 4; ++m) { bf16_t* rowp = O + (size_t)(row0 + ai * HALF + m * 16) * ldc + col0;
#pragma unroll
                for (int bj = 0; bj < 2; ++bj) { const f32x4 v0 = acc[ai][bj][m][0], v1 = acc[ai][bj][m][1];
                    u32x4 w; w.x = cvt_pk_bf16(v0[0], v0[1]); w.y = cvt_pk_bf16(v0[2], v0[3]); w.z = cvt_pk_bf16(v1[0], v1[1]); w.w = cvt_pk_bf16(v1[2], v1[3]);
                    *(u32x4*)(rowp + bj * HALF) = w; } }
    }
};
struct EpiRes {
    static constexpr bool PERM = false, AFTER_DRAIN = false;
    float* X; const float* modl; int goff;
    __device__ __forceinline__ void operator()(const f32x4 (&acc)[2][2][4][2], const Unit& u, int wr, int wc, int fr, int fq) const {
        const int b = u.pm < 128 ? (u.pm >> 3) : 16;
        const float* gate = modl + (size_t)b * 12288 + goff;
        const int row0 = u.pm * BM + wr * 64 + fr, col0 = u.pn * BM + wc * 32 + 4 * fq;
        f32x4 gv[2][2];
#pragma unroll
        for (int bj = 0; bj < 2; ++bj)
#pragma unroll
            for (int n = 0; n < 2; ++n) gv[bj][n] = *(const f32x4*)(gate + col0 + bj * HALF + n * 16);
#pragma unroll
        for (int ai = 0; ai < 2; ++ai)
#pragma unroll
            for (int m = 0; m < 4; ++m) { float* rowp = X + (size_t)(row0 + ai * HALF + m * 16) * 2048 + col0;
#pragma unroll
                for (int bj = 0; bj < 2; ++bj)
#pragma unroll
                    for (int n = 0; n < 2; ++n) { f32x4 v = *(const f32x4*)(rowp + bj * HALF + n * 16); v = v + gv[bj][n] * acc[ai][bj][m][n]; *(f32x4*)(rowp + bj * HALF + n * 16) = v; } }
    }
};
struct EpiGU {
    static constexpr bool PERM = true, AFTER_DRAIN = false;
    bf16_t* O;
    __device__ __forceinline__ void operator()(const f32x4 (&acc)[2][2][4][2], const Unit& u, int wr, int wc, int fr, int fq) const {
        const int row0 = u.pm * BM + wr * 64 + fr, col0 = u.pn * HALF + wc * 32 + 8 * fq;
#pragma unroll
        for (int ai = 0; ai < 2; ++ai)
#pragma unroll
            for (int m = 0; m < 4; ++m) { bf16_t* rowp = O + (size_t)(row0 + ai * HALF + m * 16) * 5632 + col0;
                const f32x4 g0 = acc[ai][0][m][0], g1 = acc[ai][0][m][1], u0 = acc[ai][1][m][0], u1 = acc[ai][1][m][1];
                u32x4 w;
                w.x = cvt_pk_bf16(silu_f(g0[0]) * u0[0], silu_f(g0[1]) * u0[1]); w.y = cvt_pk_bf16(silu_f(g0[2]) * u0[2], silu_f(g0[3]) * u0[3]);
                w.z = cvt_pk_bf16(silu_f(g1[0]) * u1[0], silu_f(g1[1]) * u1[1]); w.w = cvt_pk_bf16(silu_f(g1[2]) * u1[2], silu_f(g1[3]) * u1[3]);
                *(u32x4*)rowp = w; }
    }
};
struct EpiFour {
    static constexpr bool PERM = true, AFTER_DRAIN = false;
    bf16_t* Y; float scale; int row_base, rows_per_batch;
    __device__ __forceinline__ void operator()(const f32x4 (&acc)[2][2][4][2], const Unit& u, int wr, int wc, int fr, int fq) const {
        const int row0 = row_base + (u.pn >> 1) * rows_per_batch + u.pm * BM + wr * 64 + fr, col0 = 512 + (u.pn & 1) * BM + wc * 32 + 8 * fq;
#pragma unroll
        for (int ai = 0; ai < 2; ++ai)
#pragma unroll
            for (int m = 0; m < 4; ++m) { bf16_t* rowp = Y + (size_t)(row0 + ai * HALF + m * 16) * 2048 + col0;
#pragma unroll
                for (int bj = 0; bj < 2; ++bj) { const f32x4 v0 = acc[ai][bj][m][0] * scale, v1 = acc[ai][bj][m][1] * scale;
                    u32x4 w; w.x = cvt_pk_bf16(v0[0], v0[1]); w.y = cvt_pk_bf16(v0[2], v0[3]); w.z = cvt_pk_bf16(v1[0], v1[1]); w.w = cvt_pk_bf16(v1[2], v1[3]);
                    *(u32x4*)(rowp + bj * HALF) = w; } }
    }
};
struct EpiFour1 {
    static constexpr bool PERM = true, AFTER_DRAIN = false;
    bf16_t* TT; bf16_t* TTC;
    __device__ __forceinline__ void operator()(const f32x4 (&acc)[2][2][4][2], const Unit& u, int wr, int wc, int fr, int fq) const {
        const int g = u.pm; bf16_t* base; size_t chs, half;
        if (u.pn < 128) { const int b = u.pn >> 3, n0 = (u.pn & 7) * BM + wc * 32 + 8 * fq; base = TT + (size_t)(b * 512 + g * 128) * 4096 + n0; chs = 4096; half = 2048; }
        else { const int b = u.pn - 128, n0 = wc * 32 + 8 * fq; base = TTC + (size_t)(b * 512 + g * 128) * 512 + n0; chs = 512; half = 256; }
#pragma unroll
        for (int ai = 0; ai < 2; ++ai)
#pragma unroll
            for (int m = 0; m < 4; ++m) { bf16_t* rowp = base + (size_t)(wr * 64 + m * 16 + fr) * chs + ai * half;
#pragma unroll
                for (int bj = 0; bj < 2; ++bj) { const f32x4 v0 = acc[ai][bj][m][0], v1 = acc[ai][bj][m][1];
                    u32x4 w; w.x = cvt_pk_bf16(v0[0], v0[1]); w.y = cvt_pk_bf16(v0[2], v0[3]); w.z = cvt_pk_bf16(v1[0], v1[1]); w.w = cvt_pk_bf16(v1[2], v1[3]);
                    *(u32x4*)(rowp + bj * HALF) = w; } }
    }
};
template <class Epi, class Sched, bool ALIGN_EPI = false, bool SP2 = false>
__device__ __forceinline__ void gemm_phase(PG8_LAS unsigned char* lds, const Gemm g, const Sched& S, const Epi& E) {
    int tid_ = threadIdx.x; asm volatile("" : "+v"(tid_));
    const int tid = tid_, wid = __builtin_amdgcn_readfirstlane(tid >> 6), lane = tid & 63, wr = wid >> 2, wc = wid & 3, fr = lane & 15, fq = lane >> 4;
    const int K = g.K, nt = K / BK;
    unsigned voffA[2], voffB[2];
#pragma unroll
    for (int i = 0; i < 2; ++i) { int R, C; stage_rc(tid * 16 + i * 8192, R, C); const int Rb = Epi::PERM ? ((R & ~31) + perm32(R & 31)) : R;
        voffA[i] = (unsigned)(R * g.lda + C) * 2u; voffB[i] = (unsigned)(Rb * g.ldb + C) * 2u; }
    const size_t kstep = (size_t)(BK * 2);
    const size_t hstepA = (size_t)HALF * g.lda * 2, hstepB = (size_t)HALF * g.ldb * 2;
    const size_t tstepA = 2 * hstepA, tstepB = 2 * hstepB;
    const unsigned ldsw = (unsigned)wid * 1024u;
    const int aoff = lds_byte(wr * 64 + fr, fq * 8), boff = lds_byte(wc * 32 + fr, fq * 8);
#define PG8_SA(b, h) (((b) * 2 + (h)) * HTB)
#define PG8_SB(b, h) ((4 + (b) * 2 + (h)) * HTB)
#define PG8_STAGE(bufoff, gbase, voff) do { _Pragma("unroll") for (int _i = 0; _i < 2; ++_i) \
        __builtin_amdgcn_global_load_lds((const unsigned*)((const char*)(gbase) + (voff)[_i]), (PG8_LAS unsigned*)(lds + (bufoff) + ldsw + _i * 8192), 16, 0, 0); } while (0)
#define PG8_LDA(dst, b, h) do { _Pragma("unroll") for (int m = 0; m < 4; ++m) _Pragma("unroll") for (int k = 0; k < 2; ++k) dst[m][k] = *(const PG8_LAS bf16x8*)(lds + PG8_SA(b, h) + aoff + m * 2048 + k * 1024); } while (0)
#define PG8_LDB(dst, b, h) do { _Pragma("unroll") for (int n = 0; n < 2; ++n) _Pragma("unroll") for (int k = 0; k < 2; ++k) dst[n][k] = *(const PG8_LAS bf16x8*)(lds + PG8_SB(b, h) + boff + n * 2048 + k * 1024); } while (0)
#define PG8_MMA(ai, bj, At, Bt) do { __builtin_amdgcn_s_setprio(1); _Pragma("unroll") for (int m = 0; m < 4; ++m) _Pragma("unroll") for (int n = 0; n < 2; ++n) _Pragma("unroll") for (int k = 0; k < 2; ++k) \
        acc[ai][bj][m][n] = __builtin_amdgcn_mfma_f32_16x16x32_bf16(Bt[n][k], At[m][k], acc[ai][bj][m][n], 0, 0, 0); __builtin_amdgcn_s_setprio(0); } while (0)
#define PG8_WAIT_V(n) asm volatile("s_waitcnt vmcnt(" #n ")" ::: "memory")
#define PG8_WAIT_L(n) asm volatile("s_waitcnt lgkmcnt(" #n ")" ::: "memory")
#define PG8_BAR __builtin_amdgcn_s_barrier()
#define PG8_SCHED __builtin_amdgcn_sched_barrier(0)
    Unit cur, nxt; int ui = 0;
    if (!S.next(0, cur)) return;
    f32x4 acc[2][2][4][2];
#pragma unroll
    for (int a = 0; a < 2; ++a)
#pragma unroll
        for (int b = 0; b < 2; ++b)
#pragma unroll
            for (int m = 0; m < 4; ++m)
#pragma unroll
                for (int n = 0; n < 2; ++n) acc[a][b][m][n] = (f32x4){0.f, 0.f, 0.f, 0.f};
    bf16x8 At[4][2], B0[2][2], B1[2][2];
    const char* cA = (const char*)g.A + (size_t)cur.pm * tstepA; const char* cB = (const char*)g.Bt + (size_t)cur.pn * tstepB;
    S.a_ready(cur);
    if constexpr (SP2) {
        PG8_STAGE(PG8_SB(0, 0), cB, voffB); PG8_STAGE(PG8_SB(0, 1), cB + hstepB, voffB); PG8_STAGE(PG8_SA(0, 0), cA, voffA); PG8_STAGE(PG8_SA(0, 1), cA + hstepA, voffA);
        if (wr == 1) PG8_BAR;
        PG8_WAIT_V(2); PG8_BAR;
        PG8_STAGE(PG8_SB(1, 0), cB + kstep, voffB); PG8_STAGE(PG8_SA(1, 0), cA + kstep, voffA); PG8_STAGE(PG8_SB(1, 1), cB + hstepB + kstep, voffB);
        PG8_WAIT_V(6); PG8_BAR;
    } else {
        PG8_STAGE(PG8_SB(0, 0), cB, voffB); PG8_STAGE(PG8_SA(0, 0), cA, voffA); PG8_STAGE(PG8_SB(0, 1), cB + hstepB, voffB); PG8_STAGE(PG8_SA(0, 1), cA + hstepA, voffA);
        if (wr == 1) PG8_BAR;
        PG8_WAIT_V(4); PG8_BAR;
        PG8_STAGE(PG8_SB(1, 0), cB + kstep, voffB); PG8_STAGE(PG8_SA(1, 0), cA + kstep, voffA); PG8_STAGE(PG8_SB(1, 1), cB + hstepB + kstep, voffB);
        PG8_WAIT_V(6); PG8_BAR;
    }
    for (;;) {
        const bool has_next = S.next(ui + 1, nxt);
        const char* nA = has_next ? (const char*)g.A + (size_t)nxt.pm * tstepA : cA; const char* nB = has_next ? (const char*)g.Bt + (size_t)nxt.pn * tstepB : cB;
        for (int t = 0; t < nt; t += 2) {
            const bool last = (t == nt - 2);
            const char* a1 = cA + (size_t)(t + 1) * kstep;
            const char* a2 = last ? nA : cA + (size_t)(t + 2) * kstep; const char* b2 = last ? nB : cB + (size_t)(t + 2) * kstep;
            const char* a3 = a2 + kstep; const char* b3 = b2 + kstep;
            if (last && has_next) S.a_ready(nxt);
            if constexpr (SP2) {
            PG8_LDB(B0, 0, 0); PG8_LDB(B1, 0, 1); PG8_SCHED; PG8_LDA(At, 0, 0); PG8_STAGE(PG8_SA(1, 1), a1 + hstepA, voffA);
            PG8_WAIT_V(8); PG8_WAIT_L(0); PG8_BAR; PG8_MMA(0, 0, At, B0); PG8_MMA(0, 1, At, B1); PG8_BAR; PG8_SCHED;
            PG8_LDA(At, 0, 1); PG8_STAGE(PG8_SB(0, 0), b2, voffB); PG8_STAGE(PG8_SB(0, 1), b2 + hstepB, voffB); PG8_STAGE(PG8_SA(0, 0), a2, voffA);
            PG8_WAIT_V(8); PG8_WAIT_L(0); PG8_BAR; PG8_MMA(1, 0, At, B0); PG8_MMA(1, 1, At, B1); PG8_BAR; PG8_SCHED;
            PG8_LDB(B0, 1, 0); PG8_LDB(B1, 1, 1); PG8_SCHED; PG8_LDA(At, 1, 0); PG8_STAGE(PG8_SA(0, 1), a2 + hstepA, voffA);
            PG8_WAIT_V(8); PG8_WAIT_L(0); PG8_BAR; PG8_MMA(0, 0, At, B0); PG8_MMA(0, 1, At, B1); PG8_BAR; PG8_SCHED;
            PG8_LDA(At, 1, 1); PG8_STAGE(PG8_SB(1, 0), b3, voffB); PG8_STAGE(PG8_SB(1, 1), b3 + hstepB, voffB); PG8_STAGE(PG8_SA(1, 0), a3, voffA);
            PG8_WAIT_V(8); PG8_WAIT_L(0); PG8_BAR; PG8_MMA(1, 0, At, B0); PG8_MMA(1, 1, At, B1); PG8_BAR; PG8_SCHED;
            } else {
            PG8_LDB(B0, 0, 0); PG8_SCHED; PG8_LDA(At, 0, 0); PG8_STAGE(PG8_SA(1, 1), a1 + hstepA, voffA);
            PG8_WAIT_L(8); PG8_BAR; PG8_WAIT_L(0); PG8_MMA(0, 0, At, B0); PG8_BAR; PG8_SCHED;
            PG8_LDB(B1, 0, 1); PG8_STAGE(PG8_SB(0, 0), b2, voffB);
            PG8_BAR; PG8_WAIT_L(0); PG8_MMA(0, 1, At, B1); PG8_BAR;
            PG8_LDA(At, 0, 1); PG8_STAGE(PG8_SA(0, 0), a2, voffA);
            PG8_BAR; PG8_WAIT_L(0); PG8_MMA(1, 0, At, B0); PG8_BAR; PG8_SCHED;
            PG8_STAGE(PG8_SB(0, 1), b2 + hstepB, voffB);
            PG8_WAIT_V(6); PG8_BAR; PG8_MMA(1, 1, At, B1); PG8_BAR;
            PG8_LDB(B0, 1, 0); PG8_SCHED; PG8_LDA(At, 1, 0); PG8_STAGE(PG8_SA(0, 1), a2 + hstepA, voffA);
            PG8_WAIT_L(8); PG8_BAR; PG8_WAIT_L(0); PG8_MMA(0, 0, At, B0); PG8_BAR; PG8_SCHED;
            PG8_LDB(B1, 1, 1); PG8_STAGE(PG8_SB(1, 0), b3, voffB);
            PG8_BAR; PG8_WAIT_L(0); PG8_MMA(0, 1, At, B1); PG8_BAR;
            PG8_LDA(At, 1, 1); PG8_STAGE(PG8_SA(1, 0), a3, voffA);
            PG8_BAR; PG8_WAIT_L(0); PG8_MMA(1, 0, At, B0); PG8_BAR; PG8_SCHED;
            PG8_STAGE(PG8_SB(1, 1), b3 + hstepB, voffB);
            PG8_WAIT_V(6); PG8_BAR; PG8_MMA(1, 1, At, B1); PG8_BAR;
            }
        }
        if constexpr (ALIGN_EPI) { if (wr == 0) PG8_BAR; }
        if constexpr (!Epi::AFTER_DRAIN) { E(acc, cur, wr, wc, fr, fq); S.done(cur); }
        if (!has_next) break;
#pragma unroll
        for (int a = 0; a < 2; ++a)
#pragma unroll
            for (int b = 0; b < 2; ++b)
#pragma unroll
                for (int m = 0; m < 4; ++m)
#pragma unroll
                    for (int n = 0; n < 2; ++n) acc[a][b][m][n] = (f32x4){0.f, 0.f, 0.f, 0.f};
        cur = nxt; cA = nA; cB = nB; ++ui;
        if constexpr (ALIGN_EPI) { if (wr == 1) PG8_BAR; }
    }
    PG8_WAIT_V(0);
    if constexpr (!ALIGN_EPI) { if (wr == 0) PG8_BAR; }
    PG8_BAR;
    if constexpr (Epi::AFTER_DRAIN) { E.fused(acc, cur, wr, wc, fr, fq, lds, wid, lane); S.done(cur); }
#undef PG8_SA
#undef PG8_SB
#undef PG8_STAGE
#undef PG8_LDA
#undef PG8_LDB
#undef PG8_MMA
#undef PG8_WAIT_V
#undef PG8_WAIT_L
#undef PG8_BAR
#undef PG8_SCHED
}
}
#define GAS __attribute__((address_space(1)))
#define LAS __attribute__((address_space(3)))
typedef unsigned short bf16_t;
typedef unsigned u32x4 __attribute__((ext_vector_type(4)));
typedef unsigned u32x2 __attribute__((ext_vector_type(2)));
typedef float f32x4 __attribute__((ext_vector_type(4)));
typedef float f32x2 __attribute__((ext_vector_type(2)));

constexpr int D = 2048, NBATCH = 16, SEQ = 2048, DEPTH = 4, CTXL = 256;
constexpr int ML = NBATCH * SEQ, MC = NBATCH * CTXL, MT = ML + MC;
constexpr int NPROJ = 3840, DFF = 5632, NGU = 2 * DFF, MODW = 6 * D;
constexpr int OFF_AX = 0, OFF_AB = 512, OFF_AC = 1024, OFF_F = 1536, OFF_Q = 2048, OFF_K = 2560, OFF_V = 2688, OFF_U = 2816, OFF_MV = 3328;
constexpr float EPS = 1e-6f;
constexpr int NWAVES = 8, NTHREADS = 512;

constexpr size_t al256(size_t x) { return (x + 255) & ~(size_t)255; }
constexpr size_t WS_CTL = 0, CTL_ZERO_BYTES = 1u << 20;
constexpr size_t WS_WIN = CTL_ZERO_BYTES;
constexpr size_t WS_WOUT = WS_WIN + (size_t)DEPTH * NPROJ * D * 2;
constexpr size_t WS_WGU = WS_WOUT + (size_t)DEPTH * D * D * 2;
constexpr size_t WS_WDN = WS_WGU + (size_t)DEPTH * NGU * D * 2;
constexpr size_t WS_MOD = WS_WDN + (size_t)DEPTH * D * DFF * 2;
constexpr size_t WS_MODP = al256(WS_MOD + (size_t)DEPTH * 17 * MODW * 4);
constexpr size_t WS_XS = al256(WS_MODP + (size_t)DEPTH * 8 * 17 * MODW * 4);
constexpr size_t WS_H = WS_XS + (size_t)MT * D * 4;
constexpr size_t WS_P = WS_H + (size_t)MT * D * 2;
constexpr size_t WS_Y = WS_P + (size_t)MT * NPROJ * 2;
constexpr size_t WS_HF = WS_P;
constexpr size_t WS_TT = WS_Y + (size_t)MT * D * 2;
static_assert(WS_HF + (size_t)MT * DFF * 2 <= WS_TT, "hf overlay");
constexpr size_t WS_TTC = WS_TT + (size_t)NBATCH * 512 * 4096 * 2;
constexpr size_t WS_DFTN = WS_TTC + (size_t)NBATCH * 512 * 512 * 2;
constexpr size_t WS_DFTC = WS_DFTN + (size_t)2048 * 4096 * 2;
constexpr size_t WS_ROPE = WS_DFTC + (size_t)256 * 512 * 2;
constexpr size_t WS_CSBD = WS_ROPE + (size_t)2048 * 32 * 8;
constexpr size_t WS_END = WS_CSBD + (size_t)1024 * 512 * 2;
constexpr int CW_BAR = 4096;

constexpr int LDS_BYTES = 147456;
constexpr int LDSCTL_OFF = 146432, MISC_OFF = LDSCTL_OFF;

#define LDS_WAIT() asm volatile("s_waitcnt lgkmcnt(0)" ::: "memory")
__device__ __forceinline__ float bf2f(unsigned b) { return __uint_as_float(b << 16); }
__device__ __forceinline__ unsigned f2bf(float f) { unsigned u = __float_as_uint(f); return (u + 0x7fffu + ((u >> 16) & 1u)) >> 16; }
__device__ __forceinline__ unsigned pk2(float lo, float hi) { return f2bf(lo) | (f2bf(hi) << 16); }
__device__ __forceinline__ void unpack8(const u32x4 w, float* o) {
    o[0] = __uint_as_float(w.x << 16); o[1] = __uint_as_float(w.x & 0xffff0000u); o[2] = __uint_as_float(w.y << 16); o[3] = __uint_as_float(w.y & 0xffff0000u);
    o[4] = __uint_as_float(w.z << 16); o[5] = __uint_as_float(w.z & 0xffff0000u); o[6] = __uint_as_float(w.w << 16); o[7] = __uint_as_float(w.w & 0xffff0000u);
}
__device__ __forceinline__ float wave_sum(float v) {
#pragma unroll
    for (int o = 1; o < 64; o <<= 1) v += __shfl_xor(v, o);
    return v;
}
__device__ __forceinline__ float gelu_tanh(float x) {
    const float u = 0.7978845608028654f * (x + 0.044715f * x * x * x);
    const float e = __expf(2.0f * u);
    const float t = 1.0f - 2.0f * __builtin_amdgcn_rcpf(1.0f + e);
    return 0.5f * x * (1.0f + t);
}
#define XB_TMO      128
#define XB_XCNT(j)  (256  + 64 * (j))
#define XB_XSUB(j)  (1280 + 64 * (j))
#define XB_XGEN(j)  (2304 + 64 * (j))
#define XB_TOP      3328
#define XB_TOPGEN   3392
#define XCD_BAR_WORDS 3456
#define XB_SPIN_CAP (1u << 18)

__device__ __forceinline__ unsigned xb_ld(unsigned* p)              { return __hip_atomic_load(p, __ATOMIC_RELAXED, __HIP_MEMORY_SCOPE_AGENT); }
__device__ __forceinline__ unsigned xb_add(unsigned* p, unsigned v) { return __hip_atomic_fetch_add(p, v, __ATOMIC_RELAXED, __HIP_MEMORY_SCOPE_AGENT); }
__device__ __forceinline__ unsigned xb_xcc_id() { return (unsigned)__builtin_amdgcn_s_getreg((3 << 11) | 20) & 0xFu; }
#define XB_SPIN(cond, bar) do { unsigned _sp = 0; while (cond) { __builtin_amdgcn_s_sleep(1); \
    if ((++_sp & 255u) == 0u) { if (xb_ld(&(bar)[XB_TMO])) break; if (_sp > XB_SPIN_CAP) { atomicAdd(&(bar)[XB_TMO], 1u); break; } } } } while (0)

struct XcdBarrier {
    unsigned* bar; unsigned x;
    volatile LAS unsigned* st;
};

__device__ __forceinline__ XcdBarrier xcd_barrier_post(unsigned* bar, volatile LAS unsigned* st) {
    XcdBarrier b; b.bar = bar; b.x = xb_xcc_id(); b.st = st;
    if (threadIdx.x == 0) (void)xb_add(&bar[XB_XCNT(b.x)], 1u);
    return b;
}
__device__ __forceinline__ void xcd_barrier_complete(unsigned* bar, unsigned x, unsigned& nloc, unsigned& nx) {
    const unsigned G = gridDim.x * gridDim.y * gridDim.z;
    unsigned sum, cnt, mine, sp = 0u;
    for (;;) {
        sum = 0u; cnt = 0u; mine = 0u;
#pragma unroll
        for (unsigned j = 0; j < 16; ++j) { const unsigned c = xb_ld(&bar[XB_XCNT(j)]); sum += c; cnt += (c > 0u) ? 1u : 0u; mine = (j == x) ? c : mine; }
        if (sum == G) break;
        __builtin_amdgcn_s_sleep(1);
        if ((++sp & 255u) == 0u) { if (xb_ld(&bar[XB_TMO])) break; if (sp > XB_SPIN_CAP) { atomicAdd(&bar[XB_TMO], 1u); break; } }
    }
    nloc = mine > 0u ? mine : 1u; nx = cnt > 0u ? cnt : 1u;
}

__device__ __forceinline__ void xcd_barrier(const XcdBarrier& b) {
    asm volatile("s_waitcnt vmcnt(0)" ::: "memory");
    __syncthreads();
    if (threadIdx.x == 0) {
        unsigned* bar = b.bar;
        __builtin_amdgcn_s_waitcnt(0);
        unsigned nloc = b.st[0], nx = b.st[1];
        if (nloc == 0u) { xcd_barrier_complete(bar, b.x, nloc, nx); b.st[0] = nloc; b.st[1] = nx; }
        const unsigned old = xb_add(&bar[XB_XSUB(b.x)], 1u);
        const unsigned gen = old / nloc;
        if (old + 1u == (gen + 1u) * nloc) {
            __builtin_amdgcn_fence(__ATOMIC_RELEASE, "agent");
            asm volatile("s_waitcnt vmcnt(0)" ::: "memory");
            const unsigned og = xb_add(&bar[XB_TOP], 1u);
            const unsigned tg = og / nx;
            if (og + 1u == (tg + 1u) * nx) xb_add(&bar[XB_TOPGEN], 1u);
            else XB_SPIN(xb_ld(&bar[XB_TOPGEN]) == tg, bar);
            __builtin_amdgcn_fence(__ATOMIC_ACQUIRE, "agent");
            xb_add(&bar[XB_XGEN(b.x)], 1u);
            asm volatile("s_waitcnt vmcnt(0)" ::: "memory");
        } else {
            XB_SPIN(xb_ld(&bar[XB_XGEN(b.x)]) == gen, bar);
            __builtin_amdgcn_fence(__ATOMIC_ACQUIRE, "agent");
            asm volatile("s_waitcnt vmcnt(0)" ::: "memory");
        }
    }
    __syncthreads();
}
__device__ __forceinline__ void tr_item(const float* __restrict__ W, int K, int N, bf16_t* __restrict__ WT, int k0, int n0, int drow0, LAS float* scr, int lane) {
#pragma unroll 8
    for (int i = 0; i < 32; ++i) { const int kk = 2 * i + (lane >> 5); scr[kk * 33 + (lane & 31)] = W[(size_t)(k0 + kk) * N + n0 + (lane & 31)]; }
    LDS_WAIT(); asm volatile("" ::: "memory");
    const int c = lane & 7;
#pragma unroll
    for (int j = 0; j < 4; ++j) { const int n = (lane >> 3) + 8 * j; const LAS float* s = scr + (8 * c) * 33 + n;
        u32x4 o; o.x = pk2(s[0 * 33], s[1 * 33]); o.y = pk2(s[2 * 33], s[3 * 33]); o.z = pk2(s[4 * 33], s[5 * 33]); o.w = pk2(s[6 * 33], s[7 * 33]);
        *(u32x4*)(WT + (size_t)(drow0 + n) * K + k0 + 8 * c) = o; }
    LDS_WAIT(); asm volatile("" ::: "memory");
}
constexpr int TR_IN = 32 * 120, TR_OUT = 32 * 64, TR_G = 32 * 176, TR_DN = 88 * 64, TR_LAYER = TR_IN + TR_OUT + 2 * TR_G + TR_DN;
__device__ __forceinline__ void p0_transposes(const float* w_in, const float* w_out, const float* w_gate, const float* w_up, const float* w_down,
                                              bf16_t* WIN, bf16_t* WOUT, bf16_t* WGU, bf16_t* WDN, LAS float* scr, int gw, int NGW, int lane) {
    for (int it = gw; it < DEPTH * TR_LAYER; it += NGW) {
        const int l = it / TR_LAYER; int r = it % TR_LAYER;
        if (r < TR_IN) { const int kb = r / 120, nb = r % 120; tr_item(w_in + (size_t)l * D * NPROJ, D, NPROJ, WIN + (size_t)l * NPROJ * D, kb * 64, nb * 32, nb * 32, scr, lane); continue; } r -= TR_IN;
        if (r < TR_OUT) { const int kb = r / 64, nb = r % 64; tr_item(w_out + (size_t)l * D * D, D, D, WOUT + (size_t)l * D * D, kb * 64, nb * 32, nb * 32, scr, lane); continue; } r -= TR_OUT;
        if (r < TR_G) { const int kb = r / 176, nb = r % 176, n0 = nb * 32; tr_item(w_gate + (size_t)l * D * DFF, D, DFF, WGU + (size_t)l * NGU * D, kb * 64, n0, (n0 >> 7) * 256 + (n0 & 127), scr, lane); continue; } r -= TR_G;
        if (r < TR_G) { const int kb = r / 176, nb = r % 176, n0 = nb * 32; tr_item(w_up + (size_t)l * D * DFF, D, DFF, WGU + (size_t)l * NGU * D, kb * 64, n0, (n0 >> 7) * 256 + 128 + (n0 & 127), scr, lane); continue; } r -= TR_G;
        { const int kb = r / 64, nb = r % 64; tr_item(w_down + (size_t)l * DFF * D, DFF, D, WDN + (size_t)l * D * DFF, kb * 64, nb * 32, nb * 32, scr, lane); }
    }
}
__device__ __forceinline__ void p0_modp(const float* __restrict__ c, const float* __restrict__ c_ctx, const float* __restrict__ w_ada, float* __restrict__ modp, LAS float* scr  , int gw, int NGW, int lane) {
    for (int it = gw; it < DEPTH * 48 * 8; it += NGW) {
        const int l = it / 384, rem = it % 384, cc = rem >> 3, ks = rem & 7, k0 = ks * 256;
#pragma unroll
        for (int r = 0; r < 17; ++r)
#pragma unroll
            for (int j = 0; j < 4; ++j) { const int idx = j * 64 + lane; const float v = (r < 16) ? c[r * D + k0 + idx] : c_ctx[k0 + idx]; scr[r * 256 + idx] = v * (1.0f / (1.0f + __expf(-v))); }
        LDS_WAIT(); asm volatile("" ::: "memory");
        f32x4 acc[17];
#pragma unroll
        for (int r = 0; r < 17; ++r) acc[r] = (f32x4){0.f, 0.f, 0.f, 0.f};
        const float* wp = w_ada + ((size_t)l * D + k0) * MODW + cc * 256 + lane * 4;
#pragma unroll 2
        for (int k4 = 0; k4 < 64; ++k4) {
            const f32x4 w0 = *(const f32x4*)(wp + (size_t)(4 * k4 + 0) * MODW), w1 = *(const f32x4*)(wp + (size_t)(4 * k4 + 1) * MODW);
            const f32x4 w2 = *(const f32x4*)(wp + (size_t)(4 * k4 + 2) * MODW), w3 = *(const f32x4*)(wp + (size_t)(4 * k4 + 3) * MODW);
#pragma unroll
            for (int r = 0; r < 17; ++r) { const f32x4 s = *(const LAS f32x4*)(scr + r * 256 + 4 * k4); acc[r] = acc[r] + w0 * s.x + w1 * s.y + w2 * s.z + w3 * s.w; }
        }
#pragma unroll
        for (int r = 0; r < 17; ++r) *(f32x4*)(modp + ((size_t)((l * 8 + ks) * 17 + r)) * MODW + cc * 256 + lane * 4) = acc[r];
        LDS_WAIT(); asm volatile("" ::: "memory");
    }
}
__device__ __forceinline__ void p0_tables(bf16_t* DFTN, bf16_t* DFTC, bf16_t* CSBD, f32x2* ROPE, size_t gtid, size_t NT) {
    for (size_t i = gtid; i < (size_t)1024 * 512 / 8; i += NT) {
        const int r = (int)(i >> 6), c0 = (int)(i & 63) * 8, g = r >> 8, t = (r >> 7) & 1, m = r & 127; float v[8];
#pragma unroll
        for (int e = 0; e < 8; ++e) { const int cp = c0 + e, c = cp & 127, j = (m * c) & 127; const float x = (float)j * (1.0f / 64.0f); v[e] = (cp >> 7) == g ? (t == 0 ? cospif(x) : sinpif(x)) : 0.f; }
        u32x4 o; o.x = pk2(v[0], v[1]); o.y = pk2(v[2], v[3]); o.z = pk2(v[4], v[5]); o.w = pk2(v[6], v[7]);
        *(u32x4*)(CSBD + i * 8) = o;
    }
    for (size_t i = gtid; i < (size_t)2048 * 4096 / 8; i += NT) {
        const int k = (int)(i >> 9), n0 = (int)(i & 511) * 8; float v[8];
#pragma unroll
        for (int e = 0; e < 8; ++e) { const int np = n0 + e, n = np & 2047, j = (k * n) & 2047; const float x = (float)j * (1.0f / 1024.0f); v[e] = np < 2048 ? cospif(x) : -sinpif(x); }
        u32x4 o; o.x = pk2(v[0], v[1]); o.y = pk2(v[2], v[3]); o.z = pk2(v[4], v[5]); o.w = pk2(v[6], v[7]);
        *(u32x4*)(DFTN + i * 8) = o;
    }
    for (size_t i = gtid; i < (size_t)256 * 512 / 8; i += NT) {
        const int k = (int)(i >> 6), n0 = (int)(i & 63) * 8; float v[8];
#pragma unroll
        for (int e = 0; e < 8; ++e) { const int np = n0 + e, n = np & 255, j = (k * n) & 255; const float x = (float)j * (1.0f / 128.0f); v[e] = np < 256 ? cospif(x) : -sinpif(x); }
        u32x4 o; o.x = pk2(v[0], v[1]); o.y = pk2(v[2], v[3]); o.z = pk2(v[4], v[5]); o.w = pk2(v[6], v[7]);
        *(u32x4*)(DFTC + i * 8) = o;
    }
    for (size_t i = gtid; i < (size_t)2048 * 32; i += NT) {
        const int pos = (int)(i >> 5), ii = (int)(i & 31), half = ii >> 4, fi = ii & 15;
        const float inv = exp2f(-(float)fi * (13.287712379549449f / 16.0f));
        const float ang = (float)(half ? (pos & 63) : (pos >> 6)) * inv;
        const float xr = ang * 0.3183098861837907f;
        ROPE[i] = (f32x2){cospif(xr), sinpif(xr)};
    }
}
__device__ __forceinline__ void p0_xs_init(const float* x, const float* ctx, float* xs, size_t gtid, size_t NT) {
    const size_t nl = (size_t)ML * D / 4, nt = (size_t)MT * D / 4;
    for (size_t i = gtid; i < nt; i += NT) { const f32x4 v = i < nl ? ((const f32x4*)x)[i] : ((const f32x4*)ctx)[i - nl]; ((f32x4*)xs)[i] = v; }
}
__device__ __forceinline__ void p1_mod(const float* __restrict__ modp, const float* __restrict__ b_ada, float* __restrict__ mod, size_t gtid, size_t NT) {
    for (size_t i = gtid; i < (size_t)DEPTH * 17 * MODW; i += NT) {
        const int l = (int)(i / (17 * MODW)), rn = (int)(i % (17 * MODW)), n = rn % MODW;
        float s = b_ada[l * MODW + n];
#pragma unroll
        for (int ks = 0; ks < 8; ++ks) s += modp[(size_t)(l * 8 + ks) * 17 * MODW + rn];
        mod[i] = s;
    }
}
__device__ __forceinline__ void norm_mod_rows(const float* __restrict__ xs, const float* __restrict__ gvec, const float* __restrict__ modl, int shoff, int scoff, bf16_t* __restrict__ H, int nrows, int gw, int NGW, int lane) {
    for (int row = gw; row < nrows; row += NGW) {
        const int b = row < ML ? (row >> 11) : 16;
        const f32x4* xr = (const f32x4*)(xs + (size_t)row * D) + lane;
        f32x4 v[8]; float ss = 0.f;
#pragma unroll
        for (int j = 0; j < 8; ++j) { v[j] = xr[64 * j]; ss += (v[j].x * v[j].x + v[j].y * v[j].y) + (v[j].z * v[j].z + v[j].w * v[j].w); }
        const float rstd = 1.0f / sqrtf(wave_sum(ss) * (1.0f / D) + EPS);
        const float* mrow = modl + (size_t)b * MODW;
#pragma unroll
        for (int j = 0; j < 8; ++j) { const int col = 4 * lane + 256 * j;
            const f32x4 g4 = *(const f32x4*)(gvec + col), sc4 = *(const f32x4*)(mrow + scoff + col), sh4 = *(const f32x4*)(mrow + shoff + col);
            const f32x4 o = (v[j] * rstd) * g4 * (sc4 + 1.0f) + sh4;
            u32x2 w; w.x = pk2(o.x, o.y); w.y = pk2(o.z, o.w);
            *(u32x2*)(H + (size_t)row * D + col) = w; }
    }
}
__device__ __forceinline__ void final_norm_rows(const float* __restrict__ xs, const float* __restrict__ gvec, float* __restrict__ out, int gw, int NGW, int lane) {
    for (int row = gw; row < ML; row += NGW) {
        const f32x4* xr = (const f32x4*)(xs + (size_t)row * D) + lane;
        f32x4 v[8]; float ss = 0.f;
#pragma unroll
        for (int j = 0; j < 8; ++j) { v[j] = xr[64 * j]; ss += (v[j].x * v[j].x + v[j].y * v[j].y) + (v[j].z * v[j].z + v[j].w * v[j].w); }
        const float rstd = 1.0f / sqrtf(wave_sum(ss) * (1.0f / D) + EPS);
#pragma unroll
        for (int j = 0; j < 8; ++j) { const int col = 4 * lane + 256 * j; const f32x4 g4 = *(const f32x4*)(gvec + col);
            *(f32x4*)(out + (size_t)row * D + col) = (v[j] * rstd) * g4; }
    }
}
__device__ __forceinline__ void mix_conv(const bf16_t* __restrict__ P, const float* __restrict__ wc  , bf16_t* __restrict__ Y, size_t gtid, size_t NT) {
    for (size_t it = gtid; it < (size_t)MT * 64; it += NT) {
        const int row = (int)(it >> 6), c0 = (int)(it & 63) * 8;
        int n, L; if (row < ML) { n = row & 2047; L = 2048; } else { n = (row - ML) & 255; L = 256; }
        const bf16_t* pr = P + (size_t)row * NPROJ;
        float xc[8], gc[8], gb[8], zp[8], zn[8], t0[8], t1[8];
        unpack8(*(const u32x4*)(pr + OFF_AX + c0), xc); unpack8(*(const u32x4*)(pr + OFF_AC + c0), gc); unpack8(*(const u32x4*)(pr + OFF_AB + c0), gb);
        if (n > 0) { unpack8(*(const u32x4*)(pr - NPROJ + OFF_AX + c0), t0); unpack8(*(const u32x4*)(pr - NPROJ + OFF_AC + c0), t1);
#pragma unroll
            for (int e = 0; e < 8; ++e) zp[e] = t0[e] * t1[e]; }
        else {
#pragma unroll
            for (int e = 0; e < 8; ++e) zp[e] = 0.f; }
        if (n < L - 1) { unpack8(*(const u32x4*)(pr + NPROJ + OFF_AX + c0), t0); unpack8(*(const u32x4*)(pr + NPROJ + OFF_AC + c0), t1);
#pragma unroll
            for (int e = 0; e < 8; ++e) zn[e] = t0[e] * t1[e]; }
        else {
#pragma unroll
            for (int e = 0; e < 8; ++e) zn[e] = 0.f; }
        float o[8];
#pragma unroll
        for (int e = 0; e < 8; ++e) o[e] = gb[e] * (zp[e] * wc[c0 + e] + (gc[e] * xc[e]) * wc[512 + c0 + e] + zn[e] * wc[1024 + c0 + e]);
        u32x4 w; w.x = pk2(o[0], o[1]); w.y = pk2(o[2], o[3]); w.z = pk2(o[4], o[5]); w.w = pk2(o[6], o[7]);
        *(u32x4*)(Y + (size_t)row * D + c0) = w;
    }
}
typedef short bf16x8_t __attribute__((ext_vector_type(8)));
typedef short bf16x4_t __attribute__((ext_vector_type(4)));
constexpr int ATT_KS = 0, ATT_VT = 9216, ATT_LD = 72;
__device__ __forceinline__ void attn_item(const bf16_t* __restrict__ P, bf16_t* __restrict__ Y, const f32x2* __restrict__ rope, const float* __restrict__ sinkl, int b, int kvh, int qb, bool isctx, LAS unsigned char* lds, int tid) {
    LAS bf16_t* Ks = (LAS bf16_t*)(lds + ATT_KS); LAS bf16_t* Vt = (LAS bf16_t*)(lds + ATT_VT);
    const int lane = tid & 63, wave = __builtin_amdgcn_readfirstlane(tid >> 6), fr = lane & 15, fq = lane >> 4;
    const int g = wave >> 1, h = kvh * 4 + g, p0 = qb * 128 + (wave & 1) * 64;
    const float L2E = 1.4426950408889634f, QS = 0.125f * L2E;
    bf16x8_t Qf[4][2];
#pragma unroll
    for (int qblk = 0; qblk < 4; ++qblk) {
        const int qpos = p0 + qblk * 16 + fr;
        const size_t rowq = isctx ? (size_t)ML + b * 256 + qpos : (size_t)b * 2048 + qpos;
        const bf16_t* qp = P + rowq * NPROJ + OFF_Q + h * 64;
#pragma unroll
        for (int s = 0; s < 2; ++s) {
            if (isctx) Qf[qblk][s] = *(const bf16x8_t*)(qp + 32 * s + 8 * fq);
            else { const int which = fq >> 1, sub = fq & 1; float t1[8], t2[8];
                unpack8(*(const u32x4*)(qp + 32 * s + 8 * sub), t1); unpack8(*(const u32x4*)(qp + 32 * s + 16 + 8 * sub), t2);
                float o[8];
#pragma unroll
                for (int i = 0; i < 8; ++i) { const f32x2 cs = rope[qpos * 32 + s * 16 + sub * 8 + i]; o[i] = which == 0 ? (t1[i] * cs.x - t2[i] * cs.y) : (t2[i] * cs.x + t1[i] * cs.y); }
                u32x4 w; w.x = pk2(o[0], o[1]); w.y = pk2(o[2], o[3]); w.z = pk2(o[4], o[5]); w.w = pk2(o[6], o[7]);
                Qf[qblk][s] = __builtin_bit_cast(bf16x8_t, w); }
        }
    }
    f32x4 O[4][4]; float mrun[4], lsum[4];
    const float sk = sinkl[h] * L2E;
#pragma unroll
    for (int qblk = 0; qblk < 4; ++qblk) { mrun[qblk] = sk; lsum[qblk] = fq == 0 ? 1.0f : 0.0f;
#pragma unroll
        for (int db = 0; db < 4; ++db) O[qblk][db] = (f32x4){0.f, 0.f, 0.f, 0.f}; }
    const int ntiles = isctx ? 4 : 10;
#pragma unroll 1
    for (int t = 0; t < ntiles; ++t) {
        bool local; int k0;
        if (isctx) { local = false; k0 = t * 64; } else if (t < 6) { local = true; k0 = (qb - 1) * 128 + t * 64; } else { local = false; k0 = (t - 6) * 64; }
        if (local && (k0 < 0 || k0 >= 2048)) continue;
        __syncthreads();
        { const int j = tid >> 3, part = tid & 7, half = part >> 2, which = (part >> 1) & 1, sub = part & 1;
          const size_t rowk = local ? (size_t)b * 2048 + k0 + j : (size_t)ML + b * 256 + k0 + j;
          const bf16_t* kp = P + rowk * NPROJ + OFF_K + kvh * 64; const bf16_t* vp = P + rowk * NPROJ + OFF_V + kvh * 64 + part * 8;
          const u32x4 vraw = *(const u32x4*)vp;
          u32x4 kw;
          if (local) { float t1[8], t2[8], ko[8]; const int kpos = k0 + j;
              unpack8(*(const u32x4*)(kp + half * 32 + sub * 8), t1); unpack8(*(const u32x4*)(kp + half * 32 + 16 + sub * 8), t2);
#pragma unroll
              for (int i = 0; i < 8; ++i) { const f32x2 cs = rope[kpos * 32 + half * 16 + sub * 8 + i]; ko[i] = which == 0 ? (t1[i] * cs.x - t2[i] * cs.y) : (t2[i] * cs.x + t1[i] * cs.y); }
              kw.x = pk2(ko[0], ko[1]); kw.y = pk2(ko[2], ko[3]); kw.z = pk2(ko[4], ko[5]); kw.w = pk2(ko[6], ko[7]); }
          else kw = *(const u32x4*)(kp + part * 8);
          *(LAS u32x4*)(Ks + j * ATT_LD + part * 8) = kw;
          const unsigned vw[4] = {vraw.x, vraw.y, vraw.z, vraw.w};
#pragma unroll
          for (int i = 0; i < 4; ++i) { Vt[(part * 8 + 2 * i) * ATT_LD + j] = (bf16_t)(vw[i] & 0xffffu); Vt[(part * 8 + 2 * i + 1) * ATT_LD + j] = (bf16_t)(vw[i] >> 16); }
        }
        __syncthreads();
#pragma unroll 1
        for (int kb = 0; kb < 64; kb += 32) {
            const int kmin = k0 + kb;
            if (local && (kmin + 31 < p0 - 128 || kmin > p0 + 63 + 128)) continue;
            bf16x8_t Kf[2][2];
#pragma unroll
            for (int blk = 0; blk < 2; ++blk)
#pragma unroll
                for (int s = 0; s < 2; ++s) Kf[blk][s] = *(const LAS bf16x8_t*)(Ks + (kb + 16 * blk + fr) * ATT_LD + 32 * s + 8 * fq);
            bf16x8_t Vf[4];
#pragma unroll
            for (int db = 0; db < 4; ++db) { const LAS bf16_t* vp = Vt + (16 * db + fr) * ATT_LD + kb + 4 * fq;
                const bf16x4_t lo = *(const LAS bf16x4_t*)vp, hi = *(const LAS bf16x4_t*)(vp + 16);
                Vf[db] = __builtin_shufflevector(lo, hi, 0, 1, 2, 3, 4, 5, 6, 7); }
#pragma unroll
            for (int qblk = 0; qblk < 4; ++qblk) {
                f32x4 S0 = (f32x4){0.f, 0.f, 0.f, 0.f}, S1 = S0;
                S0 = __builtin_amdgcn_mfma_f32_16x16x32_bf16(Kf[0][0], Qf[qblk][0], S0, 0, 0, 0); S0 = __builtin_amdgcn_mfma_f32_16x16x32_bf16(Kf[0][1], Qf[qblk][1], S0, 0, 0, 0);
                S1 = __builtin_amdgcn_mfma_f32_16x16x32_bf16(Kf[1][0], Qf[qblk][0], S1, 0, 0, 0); S1 = __builtin_amdgcn_mfma_f32_16x16x32_bf16(Kf[1][1], Qf[qblk][1], S1, 0, 0, 0);
                float sv[8]; bool valid[8];
                const int qpos = p0 + qblk * 16 + fr;
#pragma unroll
                for (int r = 0; r < 4; ++r) { sv[r] = S0[r] * QS; sv[4 + r] = S1[r] * QS;
                    int d0 = qpos - (kmin + 4 * fq + r); d0 = d0 < 0 ? -d0 : d0; int d1 = qpos - (kmin + 16 + 4 * fq + r); d1 = d1 < 0 ? -d1 : d1;
                    valid[r] = !local || d0 <= 128; valid[4 + r] = !local || d1 <= 128; }
                float cm = -3.0e38f;
#pragma unroll
                for (int r = 0; r < 8; ++r) cm = fmaxf(cm, valid[r] ? sv[r] : -3.0e38f);
                cm = fmaxf(cm, __shfl_xor(cm, 16)); cm = fmaxf(cm, __shfl_xor(cm, 32));
                const float mnew = fmaxf(mrun[qblk], cm), sc = exp2f(mrun[qblk] - mnew);
                float pp[8], ps = 0.f;
#pragma unroll
                for (int r = 0; r < 8; ++r) { pp[r] = valid[r] ? exp2f(sv[r] - mnew) : 0.f; ps += pp[r]; }
                lsum[qblk] = lsum[qblk] * sc + ps; mrun[qblk] = mnew;
                u32x4 pw; pw.x = pk2(pp[0], pp[1]); pw.y = pk2(pp[2], pp[3]); pw.z = pk2(pp[4], pp[5]); pw.w = pk2(pp[6], pp[7]);
                const bf16x8_t Pf = __builtin_bit_cast(bf16x8_t, pw);
#pragma unroll
                for (int db = 0; db < 4; ++db) { O[qblk][db] = O[qblk][db] * sc; O[qblk][db] = __builtin_amdgcn_mfma_f32_16x16x32_bf16(Vf[db], Pf, O[qblk][db], 0, 0, 0); }
            }
        }
    }
#pragma unroll
    for (int qblk = 0; qblk < 4; ++qblk) {
        float l = lsum[qblk]; l += __shfl_xor(l, 16); l += __shfl_xor(l, 32);
        const float rl = 1.0f / l;
        const int qpos = p0 + qblk * 16 + fr;
        const size_t rowq = isctx ? (size_t)ML + b * 256 + qpos : (size_t)b * 2048 + qpos;
        bf16_t* yp = Y + rowq * D + 1024 + h * 64 + 4 * fq;
#pragma unroll
        for (int db = 0; db < 4; ++db) { const f32x4 o = O[qblk][db] * rl; u32x2 w; w.x = pk2(o[0], o[1]); w.y = pk2(o[2], o[3]); *(u32x2*)(yp + 16 * db) = w; }
    }
}
__device__ __forceinline__ void mix_attn(const bf16_t* P, bf16_t* Y, const f32x2* rope, const float* sinkl, LAS unsigned char* lds, int vcu, int G, int tid) {
    for (int it = vcu; it < 512 + 64; it += G) {
        if (it < 512) { const int b = it >> 5, kvh = (it >> 4) & 1, qb = it & 15; attn_item(P, Y, rope, sinkl, b, kvh, qb, false, lds, tid); }
        else { const int r = it - 512, b = r >> 2, kvh = (r >> 1) & 1, qb = r & 1; attn_item(P, Y, rope, sinkl, b, kvh, qb, true, lds, tid); }
    }
    __syncthreads();
}
__device__ __forceinline__ void mix_mlp(const bf16_t* __restrict__ P, const float* __restrict__ w_s  , const float* __restrict__ b_s  , bf16_t* __restrict__ Y, LAS unsigned char* lds, int vcu, int G, int tid) {
    LAS float* vn = (LAS float*)lds; LAS float* wsm = vn + 128 * 128;
    for (int it = vcu; it < (MT / 128) * 4; it += G) {
        const int ch = it >> 2, g = it & 3; const size_t row0 = (size_t)ch * 128;
        __syncthreads();
        for (int i = tid; i < 128 * 128; i += NTHREADS) wsm[(i >> 7) * 129 + (i & 127)] = w_s[g * 16384 + i];
        const int p = tid >> 2, cp = tid & 3;
        const bf16_t* pr = P + (row0 + p) * NPROJ;
        { float vv[32];
#pragma unroll
          for (int j = 0; j < 4; ++j) unpack8(*(const u32x4*)(pr + OFF_MV + g * 128 + cp * 32 + 8 * j), vv + 8 * j);
          float s = 0.f;
#pragma unroll
          for (int i = 0; i < 32; ++i) { vv[i] = gelu_tanh(vv[i]); s += vv[i]; }
          s += __shfl_xor(s, 1); s += __shfl_xor(s, 2);
          const float mean = s * (1.0f / 128.0f); float qq = 0.f;
#pragma unroll
          for (int i = 0; i < 32; ++i) { vv[i] -= mean; qq += vv[i] * vv[i]; }
          qq += __shfl_xor(qq, 1); qq += __shfl_xor(qq, 2);
          const float rstd = 1.0f / sqrtf(qq * (1.0f / 128.0f) + EPS);
#pragma unroll
          for (int i = 0; i < 32; i += 4) *(LAS f32x4*)(vn + p * 128 + cp * 32 + i) = (f32x4){vv[i] * rstd, vv[i + 1] * rstd, vv[i + 2] * rstd, vv[i + 3] * rstd}; }
        __syncthreads();
        float acc[32];
#pragma unroll
        for (int i = 0; i < 32; ++i) acc[i] = 0.f;
        for (int qi = 0; qi < 128; ++qi) { const float w = wsm[p * 129 + qi];
#pragma unroll
            for (int i = 0; i < 32; i += 4) { const f32x4 x = *(const LAS f32x4*)(vn + qi * 128 + cp * 32 + i); acc[i] += w * x.x; acc[i + 1] += w * x.y; acc[i + 2] += w * x.z; acc[i + 3] += w * x.w; } }
        const float bias = b_s[g * 128 + p];
        float uu[32];
#pragma unroll
        for (int j = 0; j < 4; ++j) unpack8(*(const u32x4*)(pr + OFF_U + g * 128 + cp * 32 + 8 * j), uu + 8 * j);
        bf16_t* yp = Y + (row0 + p) * D + 1536 + g * 128 + cp * 32;
#pragma unroll
        for (int i = 0; i < 32; i += 8) { float o[8];
#pragma unroll
            for (int e = 0; e < 8; ++e) o[e] = gelu_tanh(uu[i + e]) * (acc[i + e] + bias);
            u32x4 w; w.x = pk2(o[0], o[1]); w.y = pk2(o[2], o[3]); w.z = pk2(o[4], o[5]); w.w = pk2(o[6], o[7]);
            *(u32x4*)(yp + i) = w; }
    }
    __syncthreads();
}
constexpr int PH_LAYER0 = 2, PH_PER_LAYER = 8, PH_FINAL = PH_LAYER0 + DEPTH * PH_PER_LAYER, NPH = PH_FINAL + 1;
#ifndef MK_ONE_LAUNCH
#define MK_ONE_LAUNCH 0
#endif
struct Args { const float* in[18]; float* out; unsigned char* ws; int ph_lo, ph_hi, use_bar, pad; };
__global__ void __launch_bounds__(NTHREADS, 2) fwd(Args a) {
    extern __shared__ __attribute__((aligned(16))) unsigned char lds_raw[];
    LAS unsigned char* lds = (LAS unsigned char*)lds_raw;
    volatile LAS unsigned* MISC = (volatile LAS unsigned*)(lds + MISC_OFF);
    const int G = gridDim.x, bx = blockIdx.x, vcu = (G % 8 == 0) ? (bx % 8) * (G / 8) + bx / 8 : bx;
    const int NGW = G * NWAVES; const size_t NT = (size_t)G * NTHREADS;
#define TID_VARS int tid = threadIdx.x; asm volatile("" : "+v"(tid)); const int lane = tid & 63, wave = __builtin_amdgcn_readfirstlane(tid >> 6), gw = vcu * NWAVES + wave; const size_t gtid = (size_t)vcu * NTHREADS + tid; (void)lane; (void)gw; (void)gtid
    unsigned char* ws = a.ws;
    unsigned* ctl = (unsigned*)(ws + WS_CTL);
    for (int u = threadIdx.x; u < (LDS_BYTES - LDSCTL_OFF) / 4; u += NTHREADS) ((LAS unsigned*)(lds + LDSCTL_OFF))[u] = 0u;
    __syncthreads();
    XcdBarrier bar; bar.bar = ctl + CW_BAR; bar.x = 0; bar.st = nullptr;
    if (a.use_bar) bar = xcd_barrier_post(ctl + CW_BAR, MISC + 8);
    const int lo = a.ph_lo, hi = a.ph_hi;
#define IN(k) (lo <= (k) && (k) < hi)
#define SEAM(k) do { if (IN(k) && IN((k) + 1)) xcd_barrier(bar); } while (0)
    const float* x = a.in[0]; const float* cvec = a.in[1]; const float* ctx = a.in[2]; const float* c_ctx = a.in[3]; const float* w_ada = a.in[4]; const float* b_ada = a.in[5];
    const float* g_norm1 = a.in[6]; const float* w_in = a.in[7]; const float* w_conv = a.in[8]; const float* sink = a.in[9]; const float* w_s = a.in[10]; const float* b_s = a.in[11];
    const float* w_out = a.in[12]; const float* g_norm2 = a.in[13]; const float* w_gate = a.in[14]; const float* w_up = a.in[15]; const float* w_down = a.in[16]; const float* g_final = a.in[17];
    bf16_t* WIN = (bf16_t*)(ws + WS_WIN); bf16_t* WOUT = (bf16_t*)(ws + WS_WOUT); bf16_t* WGU = (bf16_t*)(ws + WS_WGU); bf16_t* WDN = (bf16_t*)(ws + WS_WDN);
    float* MOD = (float*)(ws + WS_MOD); float* MODP = (float*)(ws + WS_MODP); float* XS = (float*)(ws + WS_XS);
    bf16_t* H = (bf16_t*)(ws + WS_H); bf16_t* P = (bf16_t*)(ws + WS_P); bf16_t* Y = (bf16_t*)(ws + WS_Y); bf16_t* HF = (bf16_t*)(ws + WS_HF);
    bf16_t* TT = (bf16_t*)(ws + WS_TT); bf16_t* TTC = (bf16_t*)(ws + WS_TTC); bf16_t* DFTN = (bf16_t*)(ws + WS_DFTN); bf16_t* DFTC = (bf16_t*)(ws + WS_DFTC);
    f32x2* ROPE = (f32x2*)(ws + WS_ROPE); bf16_t* CSBD = (bf16_t*)(ws + WS_CSBD);

    if (IN(0)) { TID_VARS;
        LAS float* scr = (LAS float*)(lds + wave * 17408);
        p0_modp(cvec, c_ctx, w_ada, MODP, scr, gw, NGW, lane);
        p0_transposes(w_in, w_out, w_gate, w_up, w_down, WIN, WOUT, WGU, WDN, scr, gw, NGW, lane);
        p0_tables(DFTN, DFTC, CSBD, ROPE, gtid, NT);
        p0_xs_init(x, ctx, XS, gtid, NT);
        SEAM(0);
    }
    if (IN(1)) { TID_VARS; p1_mod(MODP, b_ada, MOD, gtid, NT); SEAM(1); }

    for (int l = 0; l < DEPTH; ++l) {
        const int pb = PH_LAYER0 + l * PH_PER_LAYER;
        const float* modl = MOD + (size_t)l * 17 * MODW;
        if (IN(pb + 0)) { TID_VARS; norm_mod_rows(XS, g_norm1 + l * D, modl, 0, D, H, MT, gw, NGW, lane); SEAM(pb + 0); }
        if (IN(pb + 1)) {
            pg8::Gemm g{H, WIN + (size_t)l * NPROJ * D, MT, NPROJ, D, D, D}; pg8::StaticOrder S; S.init(MT, NPROJ, G, bx);
            pg8::EpiP E{P, NPROJ};
            pg8::gemm_phase<pg8::EpiP, pg8::StaticOrder, true, true>(lds, g, S, E);
            SEAM(pb + 1);
        }
        if (IN(pb + 2)) {
            { pg8::Gemm g{CSBD, P + OFF_F, 1024, MT, 512, 512, NPROJ}; pg8::StaticOrder S; S.init(1024, MT, G, bx);
              pg8::EpiFour1 E{TT, TTC};
              pg8::gemm_phase<pg8::EpiFour1, pg8::StaticOrder, true, true>(lds, g, S, E); }
            TID_VARS;
            mix_conv(P, w_conv + (size_t)l * 3 * 512, Y, gtid, NT);
            mix_attn(P, Y, ROPE, sink + l * 8, lds, vcu, G, tid);
            mix_mlp(P, w_s + (size_t)l * 4 * 128 * 128, b_s + (size_t)l * 4 * 128, Y, lds, vcu, G, tid);
            SEAM(pb + 2);
        }
        if (IN(pb + 3)) {
            { pg8::Gemm g{DFTN, TT, 2048, 8192, 4096, 4096, 4096}; pg8::StaticOrder S; S.init(2048, 8192, G, bx);
              pg8::EpiFour E{Y, 1.0f / 512.0f, 0, 2048};
              pg8::gemm_phase<pg8::EpiFour, pg8::StaticOrder, true, true>(lds, g, S, E); }
            { pg8::Gemm g{DFTC, TTC, 256, 8192, 512, 512, 512}; pg8::StaticOrder S; S.init(256, 8192, G, bx);
              pg8::EpiFour E{Y, 0.005524271728019903f  , ML, 256};
              pg8::gemm_phase<pg8::EpiFour, pg8::StaticOrder, true, true>(lds, g, S, E); }
            SEAM(pb + 3);
        }
        if (IN(pb + 4)) {
            pg8::Gemm g{Y, WOUT + (size_t)l * D * D, MT, D, D, D, D}; pg8::StaticOrder S; S.init(MT, D, G, bx);
            pg8::EpiRes E{XS, modl, 2 * D};
            pg8::gemm_phase<pg8::EpiRes, pg8::StaticOrder, true, true>(lds, g, S, E);
            SEAM(pb + 4);
        }
        if (IN(pb + 5)) { TID_VARS; norm_mod_rows(XS, g_norm2 + l * D, modl, 3 * D, 4 * D, H, MT, gw, NGW, lane); SEAM(pb + 5); }
        if (IN(pb + 6)) {
            pg8::Gemm g{H, WGU + (size_t)l * NGU * D, MT, NGU, D, D, D}; pg8::StaticOrder S; S.init(MT, NGU, G, bx);
            pg8::EpiGU E{HF};
            pg8::gemm_phase<pg8::EpiGU, pg8::StaticOrder, true, true>(lds, g, S, E);
            SEAM(pb + 6);
        }
        if (IN(pb + 7)) {
            pg8::Gemm g{HF, WDN + (size_t)l * D * DFF, MT, D, DFF, DFF, DFF}; pg8::StaticOrder S; S.init(MT, D, G, bx);
            pg8::EpiRes E{XS, modl, 5 * D};
            pg8::gemm_phase<pg8::EpiRes, pg8::StaticOrder, true, true>(lds, g, S, E);
            SEAM(pb + 7);
        }
    }
    if (IN(PH_FINAL)) { TID_VARS; final_norm_rows(XS, g_final, a.out, gw, NGW, lane); }
#undef IN
#undef SEAM
}

extern "C" void kernel_launch(void* const* d_in, const int* in_sizes, int n_in, void* d_out, int out_size, void* d_ws, size_t ws_size, hipStream_t stream) {
    static int grid = 0;
    if (grid == 0) {
        if (n_in != 18 || in_sizes[0] != ML * D || out_size != ML * D || ws_size < WS_END) { fprintf(stderr, "kernel_launch: unexpected shapes: n_in %d in0 %d out %d ws %zu (need %zu)\n", n_in, n_in > 0 ? in_sizes[0] : -1, out_size, ws_size, (size_t)WS_END); grid = -1; return; }
        int dev = 0, cus = 0, per_cu = 0;
        if (hipGetDevice(&dev) != hipSuccess || hipDeviceGetAttribute(&cus, hipDeviceAttributeMultiprocessorCount, dev) != hipSuccess) { fprintf(stderr, "kernel_launch: device query failed\n"); grid = -1; return; }
        if (hipFuncSetAttribute((const void*)fwd, hipFuncAttributeMaxDynamicSharedMemorySize, LDS_BYTES) != hipSuccess) { fprintf(stderr, "kernel_launch: hipFuncSetAttribute failed\n"); grid = -1; return; }
        if (hipOccupancyMaxActiveBlocksPerMultiprocessor(&per_cu, (const void*)fwd, NTHREADS, LDS_BYTES) != hipSuccess || per_cu < 1) fprintf(stderr, "kernel_launch: note: occupancy query reports %d workgroups per CU\n", per_cu);
        (void)hipGetLastError();
        grid = cus;
    }
    if (grid < 0) return;
    if (hipMemsetAsync((char*)d_ws + WS_CTL, 0, CTL_ZERO_BYTES, stream) != hipSuccess) { fprintf(stderr, "kernel_launch: memset failed\n"); return; }
    Args a{};
    for (int i = 0; i < 18; ++i) a.in[i] = (const float*)d_in[i];
    a.out = (float*)d_out; a.ws = (unsigned char*)d_ws; a.pad = 0;
#if MK_ONE_LAUNCH
    a.ph_lo = 0; a.ph_hi = NPH; a.use_bar = 1;
    hipLaunchKernelGGL(fwd, dim3(grid), dim3(NTHREADS), LDS_BYTES, stream, a);
#else
    for (int ph = 0; ph < NPH; ++ph) { a.ph_lo = ph; a.ph_hi = ph + 1; a.use_bar = 0; hipLaunchKernelGGL(fwd, dim3(grid), dim3(NTHREADS), LDS_BYTES, stream, a); }
#endif
    const hipError_t le = hipPeekAtLastError();
    if (le != hipSuccess) fprintf(stderr, "kernel_launch: launch failed: %s\n", hipGetErrorName(le));
}
```

```cpp
#include <hip/hip_runtime.h>
#include <cstdio>
#include <cstdint>
namespace pg8 {
#define PG8_LAS __attribute__((address_space(3)))
typedef unsigned short bf16_t;
typedef short bf16x8 __attribute__((ext_vector_type(8)));
typedef float f32x4 __attribute__((ext_vector_type(4)));
typedef unsigned u32x4 __attribute__((ext_vector_type(4)));
constexpr int BM = 256, BK = 64, HALF = 128, HTB = HALF * BK * 2  , STAGE_BYTES = 8 * HTB, NXCD = 8, WGM = 8;

__host__ __device__ __forceinline__ int lds_byte(int r, int c) { const int st = (r >> 4) * 2 + (c >> 5), rr = r & 15, cc = c & 31, ob = rr * 64 + cc * 2; return st * 1024 + (ob ^ (((ob >> 9) & 1) << 5)); }
__host__ __device__ __forceinline__ void stage_rc(int b, int& R, int& C) { const int st = b / 1024, sb = b % 1024, swz = sb ^ (((sb >> 9) & 1) << 5); R = (st >> 1) * 16 + swz / 64; C = (st & 1) * 32 + (swz % 64) / 2; }
__host__ __device__ __forceinline__ int perm32(int rho) { const int n = rho >> 4, i = rho & 15; return 8 * (i >> 2) + 4 * n + (i & 3); }

struct Unit { int pm, pn; };
struct Gemm { const bf16_t* A; const bf16_t* Bt; int M, N, K, lda, ldb; };

struct StaticOrder {
    int nM, nN, nwg, G, c;
    __host__ __device__ void init(int M, int N, int G_, int c_) { nM = M / BM; nN = N / BM; nwg = nM * nN; G = G_; c = c_; }
    __host__ __device__ bool next(int i, Unit& u) const {
        const long L = (long)i * G + c; if (L >= nwg) return false;
        int wgid = (int)L; { const int q = nwg / NXCD, r = nwg % NXCD, xcd = wgid % NXCD, off = wgid / NXCD; wgid = (xcd < r ? xcd * (q + 1) : r * (q + 1) + (xcd - r) * q) + off; }
        const int nig = WGM * nN, gid = wgid / nig, fm = gid * WGM, gsz = (nM - fm) < WGM ? (nM - fm) : WGM;
        u.pm = fm + ((wgid % nig) % gsz); u.pn = (wgid % nig) / gsz; return true;
    }
    __device__ __forceinline__ void a_ready(const Unit&) const {}
    __device__ __forceinline__ void done(const Unit&) const {}
};

__device__ __forceinline__ unsigned cvt_pk_bf16(float lo, float hi) { unsigned r; asm volatile("v_cvt_pk_bf16_f32 %0, %1, %2" : "=v"(r) : "v"(lo), "v"(hi)); return r; }
typedef float f32x2 __attribute__((ext_vector_type(2)));
__device__ __forceinline__ float silu_f(float x) { return x * __builtin_amdgcn_rcpf(1.0f + __expf(-x)); }
struct EpiP {
    static constexpr bool PERM = true, AFTER_DRAIN = false;
    bf16_t* O; int ldc;
    __device__ __forceinline__ void operator()(const f32x4 (&acc)[2][2][4][2], const Unit& u, int wr, int wc, int fr, int fq) const {
        const int row0 = u.pm * BM + wr * 64 + fr, col0 = u.pn * BM + wc * 32 + 8 * fq;
#pragma unroll
        for (int ai = 0; ai < 2; ++ai)
#pragma unroll
            for (int m = 0; m < 4; ++m) { bf16_t* rowp = O + (size_t)(row0 + ai * HALF + m * 16) * ldc + col0;
#pragma unroll
                for (int bj = 0; bj < 2; ++bj) { const f32x4 v0 = acc[ai][bj][m][0], v1 = acc[ai][bj][m][1];
                    u32x4 w; w.x = cvt_pk_bf16(v0[0], v0[1]); w.y = cvt_pk_bf16(v0[2], v0[3]); w.z = cvt_pk_bf16(v1[0], v1[1]); w.w = cvt_pk_bf16(v1[2], v1[3]);
                    *(u32x4*)(rowp + bj * HALF) = w; } }
    }
};
struct EpiRes {
    static constexpr bool PERM = false, AFTER_DRAIN = false;
    float* X; const float* modl; int goff;
    __device__ __forceinline__ void operator()(const f32x4 (&acc)[2][2][4][2], const Unit& u, int wr, int wc, int fr, int fq) const {
        const int b = u.pm < 128 ? (u.pm >> 3) : 16;
        const float* gate = modl + (size_t)b * 12288 + goff;
        const int row0 = u.pm * BM + wr * 64 + fr, col0 = u.pn * BM + wc * 32 + 4 * fq;
        f32x4 gv[2][2];
#pragma unroll
        for (int bj = 0; bj < 2; ++bj)
#pragma unroll
            for (int n = 0; n < 2; ++n) gv[bj][n] = *(const f32x4*)(gate + col0 + bj * HALF + n * 16);
#pragma unroll
        for (int ai = 0; ai < 2; ++ai)
#pragma unroll
            for (int m = 0; m < 4; ++m) { float* rowp = X + (size_t)(row0 + ai * HALF + m * 16) * 2048 + col0;
#pragma unroll
                for (int bj = 0; bj < 2; ++bj)
#pragma unroll
                    for (int n = 0; n < 2; ++n) { f32x4 v = *(const f32x4*)(rowp + bj * HALF + n * 16); v = v + gv[bj][n] * acc[ai][bj][m][n]; *(f32x4*)(rowp + bj * HALF + n * 16) = v; } }
    }
};
struct EpiGU {
    static constexpr bool PERM = true, AFTER_DRAIN = false;
    bf16_t* O;
    __device__ __forceinline__ void operator()(const f32x4 (&acc)[2][2][4][2], const Unit& u, int wr, int wc, int fr, int fq) const {
        const int row0 = u.pm * BM + wr * 64 + fr, col0 = u.pn * HALF + wc * 32 + 8 * fq;
#pragma unroll
        for (int ai = 0; ai < 2; ++ai)
#pragma unroll
            for (int m = 0; m < 4; ++m) { bf16_t* rowp = O + (size_t)(row0 + ai * HALF + m * 16) * 5632 + col0;
                const f32x4 g0 = acc[ai][0][m][0], g1 = acc[ai][0][m][1], u0 = acc[ai][1][m][0], u1 = acc[ai][1][m][1];
                u32x4 w;
                w.x = cvt_pk_bf16(silu_f(g0[0]) * u0[0], silu_f(g0[1]) * u0[1]); w.y = cvt_pk_bf16(silu_f(g0[2]) * u0[2], silu_f(g0[3]) * u0[3]);
                w.z = cvt_pk_bf16(silu_f(g1[0]) * u1[0], silu_f(g1[1]) * u1[1]); w.w = cvt_pk_bf16(silu_f(g1[2]) * u1[2], silu_f(g1[3]) * u1[3]);
                *(u32x4*)rowp = w; }
    }
};
struct EpiFour {
    static constexpr bool PERM = true, AFTER_DRAIN = false;
    bf16_t* Y; float scale; int row_base, rows_per_batch;
    __device__ __forceinline__ void operator()(const f32x4 (&acc)[2][2][4][2], const Unit& u, int wr, int wc, int fr, int fq) const {
        const int row0 = row_base + (u.pn >> 1) * rows_per_batch + u.pm * BM + wr * 64 + fr, col0 = 512 + (u.pn & 1) * BM + wc * 32 + 8 * fq;
#pragma unroll
        for (int ai = 0; ai < 2; ++ai)
#pragma unroll
            for (int m = 0; m < 4; ++m) { bf16_t* rowp = Y + (size_t)(row0 + ai * HALF + m * 16) * 2048 + col0;
#pragma unroll
                for (int bj = 0; bj < 2; ++bj) { const f32x4 v0 = acc[ai][bj][m][0] * scale, v1 = acc[ai][bj][m][1] * scale;
                    u32x4 w; w.x = cvt_pk_bf16(v0[0], v0[1]); w.y = cvt_pk_bf16(v0[2], v0[3]); w.z = cvt_pk_bf16(v1[0], v1[1]); w.w = cvt_pk_bf16(v1[2], v1[3]);
                    *(u32x4*)(rowp + bj * HALF) = w; } }
    }
};
struct EpiFour1 {
    static constexpr bool PERM = true, AFTER_DRAIN = false;
    bf16_t* TT; bf16_t* TTC;
    __device__ __forceinline__ void operator()(const f32x4 (&acc)[2][2][4][2], const Unit& u, int wr, int wc, int fr, int fq) const {
        const int g = u.pm; bf16_t* base; size_t chs, half;
        if (u.pn < 128) { const int b = u.pn >> 3, n0 = (u.pn & 7) * BM + wc * 32 + 8 * fq; base = TT + (size_t)(b * 512 + g * 128) * 4096 + n0; chs = 4096; half = 2048; }
        else { const int b = u.pn - 128, n0 = wc * 32 + 8 * fq; base = TTC + (size_t)(b * 512 + g * 128) * 512 + n0; chs = 512; half = 256; }
#pragma unroll
        for (int ai = 0; ai < 2; ++ai)
#pragma unroll
            for (int m = 0; m < 4; ++m) { bf16_t* rowp = base + (size_t)(wr * 64 + m * 16 + fr) * chs + ai * half;
#pragma unroll
                for (int bj = 0; bj < 2; ++bj) { const f32x4 v0 = acc[ai][bj][m][0], v1 = acc[ai][bj][m][1];
                    u32x4 w; w.x = cvt_pk_bf16(v0[0], v0[1]); w.y = cvt_pk_bf16(v0[2], v0[3]); w.z = cvt_pk_bf16(v1[0], v1[1]); w.w = cvt_pk_bf16(v1[2], v1[3]);
                    *(u32x4*)(rowp + bj * HALF) = w; } }
    }
};
template <class Epi, class Sched, bool ALIGN_EPI = false, bool SP2 = false>
__device__ __forceinline__ void gemm_phase(PG8_LAS unsigned char* lds, const Gemm g, const Sched& S, const Epi& E) {
    int tid_ = threadIdx.x; asm volatile("" : "+v"(tid_));
    const int tid = tid_, wid = __builtin_amdgcn_readfirstlane(tid >> 6), lane = tid & 63, wr = wid >> 2, wc = wid & 3, fr = lane & 15, fq = lane >> 4;
    const int K = g.K, nt = K / BK;
    unsigned voffA[2], voffB[2];
#pragma unroll
    for (int i = 0; i < 2; ++i) { int R, C; stage_rc(tid * 16 + i * 8192, R, C); const int Rb = Epi::PERM ? ((R & ~31) + perm32(R & 31)) : R;
        voffA[i] = (unsigned)(R * g.lda + C) * 2u; voffB[i] = (unsigned)(Rb * g.ldb + C) * 2u; }
    const size_t kstep = (size_t)(BK * 2);
    const size_t hstepA = (size_t)HALF * g.lda * 2, hstepB = (size_t)HALF * g.ldb * 2;
    const size_t tstepA = 2 * hstepA, tstepB = 2 * hstepB;
    const unsigned ldsw = (unsigned)wid * 1024u;
    const int aoff = lds_byte(wr * 64 + fr, fq * 8), boff = lds_byte(wc * 32 + fr, fq * 8);
#define PG8_SA(b, h) (((b) * 2 + (h)) * HTB)
#define PG8_SB(b, h) ((4 + (b) * 2 + (h)) * HTB)
#define PG8_STAGE(bufoff, gbase, voff) do { _Pragma("unroll") for (int _i = 0; _i < 2; ++_i) \
        __builtin_amdgcn_global_load_lds((const unsigned*)((const char*)(gbase) + (voff)[_i]), (PG8_LAS unsigned*)(lds + (bufoff) + ldsw + _i * 8192), 16, 0, 0); } while (0)
#define PG8_LDA(dst, b, h) do { _Pragma("unroll") for (int m = 0; m < 4; ++m) _Pragma("unroll") for (int k = 0; k < 2; ++k) dst[m][k] = *(const PG8_LAS bf16x8*)(lds + PG8_SA(b, h) + aoff + m * 2048 + k * 1024); } while (0)
#define PG8_LDB(dst, b, h) do { _Pragma("unroll") for (int n = 0; n < 2; ++n) _Pragma("unroll") for (int k = 0; k < 2; ++k) dst[n][k] = *(const PG8_LAS bf16x8*)(lds + PG8_SB(b, h) + boff + n * 2048 + k * 1024); } while (0)
#define PG8_MMA(ai, bj, At, Bt) do { __builtin_amdgcn_s_setprio(1); _Pragma("unroll") for (int m = 0; m < 4; ++m) _Pragma("unroll") for (int n = 0; n < 2; ++n) _Pragma("unroll") for (int k = 0; k < 2; ++k) \
        acc[ai][bj][m][n] = __builtin_amdgcn_mfma_f32_16x16x32_bf16(Bt[n][k], At[m][k], acc[ai][bj][m][n], 0, 0, 0); __builtin_amdgcn_s_setprio(0); } while (0)
#define PG8_WAIT_V(n) asm volatile("s_waitcnt vmcnt(" #n ")" ::: "memory")
#define PG8_WAIT_L(n) asm volatile("s_waitcnt lgkmcnt(" #n ")" ::: "memory")
#define PG8_BAR __builtin_amdgcn_s_barrier()
#define PG8_SCHED __builtin_amdgcn_sched_barrier(0)
    Unit cur, nxt; int ui = 0;
    if (!S.next(0, cur)) return;
    f32x4 acc[2][2][4][2];
#pragma unroll
    for (int a = 0; a < 2; ++a)
#pragma unroll
        for (int b = 0; b < 2; ++b)
#pragma unroll
            for (int m = 0; m < 4; ++m)
#pragma unroll
                for (int n = 0; n < 2; ++n) acc[a][b][m][n] = (f32x4){0.f, 0.f, 0.f, 0.f};
    bf16x8 At[4][2], B0[2][2], B1[2][2];
    const char* cA = (const char*)g.A + (size_t)cur.pm * tstepA; const char* cB = (const char*)g.Bt + (size_t)cur.pn * tstepB;
    S.a_ready(cur);
    if constexpr (SP2) {
        PG8_STAGE(PG8_SB(0, 0), cB, voffB); PG8_STAGE(PG8_SB(0, 1), cB + hstepB, voffB); PG8_STAGE(PG8_SA(0, 0), cA, voffA); PG8_STAGE(PG8_SA(0, 1), cA + hstepA, voffA);
        if (wr == 1) PG8_BAR;
        PG8_WAIT_V(2); PG8_BAR;
        PG8_STAGE(PG8_SB(1, 0), cB + kstep, voffB); PG8_STAGE(PG8_SA(1, 0), cA + kstep, voffA); PG8_STAGE(PG8_SB(1, 1), cB + hstepB + kstep, voffB);
        PG8_WAIT_V(6); PG8_BAR;
    } else {
        PG8_STAGE(PG8_SB(0, 0), cB, voffB); PG8_STAGE(PG8_SA(0, 0), cA, voffA); PG8_STAGE(PG8_SB(0, 1), cB + hstepB, voffB); PG8_STAGE(PG8_SA(0, 1), cA + hstepA, voffA);
        if (wr == 1) PG8_BAR;
        PG8_WAIT_V(4); PG8_BAR;
        PG8_STAGE(PG8_SB(1, 0), cB + kstep, voffB); PG8_STAGE(PG8_SA(1, 0), cA + kstep, voffA); PG8_STAGE(PG8_SB(1, 1), cB + hstepB + kstep, voffB);
        PG8_WAIT_V(6); PG8_BAR;
    }
    for (;;) {
        const bool has_next = S.next(ui + 1, nxt);
        const char* nA = has_next ? (const char*)g.A + (size_t)nxt.pm * tstepA : cA; const char* nB = has_next ? (const char*)g.Bt + (size_t)nxt.pn * tstepB : cB;
        for (int t = 0; t < nt; t += 2) {
            const bool last = (t == nt - 2);
            const char* a1 = cA + (size_t)(t + 1) * kstep;
            const char* a2 = last ? nA : cA + (size_t)(t + 2) * kstep; const char* b2 = last ? nB : cB + (size_t)(t + 2) * kstep;
            const char* a3 = a2 + kstep; const char* b3 = b2 + kstep;
            if (last && has_next) S.a_ready(nxt);
            if constexpr (SP2) {
            PG8_LDB(B0, 0, 0); PG8_LDB(B1, 0, 1); PG8_SCHED; PG8_LDA(At, 0, 0); PG8_STAGE(PG8_SA(1, 1), a1 + hstepA, voffA);
            PG8_WAIT_V(8); PG8_WAIT_L(0); PG8_BAR; PG8_MMA(0, 0, At, B0); PG8_MMA(0, 1, At, B1); PG8_BAR; PG8_SCHED;
            PG8_LDA(At, 0, 1); PG8_STAGE(PG8_SB(0, 0), b2, voffB); PG8_STAGE(PG8_SB(0, 1), b2 + hstepB, voffB); PG8_STAGE(PG8_SA(0, 0), a2, voffA);
            PG8_WAIT_V(8); PG8_WAIT_L(0); PG8_BAR; PG8_MMA(1, 0, At, B0); PG8_MMA(1, 1, At, B1); PG8_BAR; PG8_SCHED;
            PG8_LDB(B0, 1, 0); PG8_LDB(B1, 1, 1); PG8_SCHED; PG8_LDA(At, 1, 0); PG8_STAGE(PG8_SA(0, 1), a2 + hstepA, voffA);
            PG8_WAIT_V(8); PG8_WAIT_L(0); PG8_BAR; PG8_MMA(0, 0, At, B0); PG8_MMA(0, 1, At, B1); PG8_BAR; PG8_SCHED;
            PG8_LDA(At, 1, 1); PG8_STAGE(PG8_SB(1, 0), b3, voffB); PG8_STAGE(PG8_SB(1, 1), b3 + hstepB, voffB); PG8_STAGE(PG8_SA(1, 0), a3, voffA);
            PG8_WAIT_V(8); PG8_WAIT_L(0); PG8_BAR; PG8_MMA(1, 0, At, B0); PG8_MMA(1, 1, At, B1); PG8_BAR; PG8_SCHED;
            } else {
            PG8_LDB(B0, 0, 0); PG8_SCHED; PG8_LDA(At, 0, 0); PG8_STAGE(PG8_SA(1, 1), a1 + hstepA, voffA);
            PG8_WAIT_L(8); PG8_BAR; PG8_WAIT_L(0); PG8_MMA(0, 0, At, B0); PG8_BAR; PG8_SCHED;
            PG8_LDB(B1, 0, 1); PG8_STAGE(PG8_SB(0, 0), b2, voffB);
            PG8_BAR; PG8_WAIT_L(0); PG8_MMA(0, 1, At, B1); PG8_BAR;
            PG8_LDA(At, 0, 1); PG8_STAGE(PG8_SA(0, 0), a2, voffA);
            PG8_BAR; PG8_WAIT_L(0); PG8_MMA(1, 0, At, B0); PG8_BAR; PG8_SCHED;
            PG8_STAGE(PG8_SB(0, 1), b2 + hstepB, voffB);
            PG8_WAIT_V(6); PG8_BAR; PG8_MMA(1, 1, At, B1); PG8_BAR;
            PG8_LDB(B0, 1, 0); PG8_SCHED; PG8_LDA(At, 1, 0); PG8_STAGE(PG8_SA(0, 1), a2 + hstepA, voffA);
            PG8_WAIT_L(8); PG8_BAR; PG8_WAIT_L(0); PG8_MMA(0, 0, At, B0); PG8_BAR; PG8_SCHED;
            PG8_LDB(B1, 1, 1); PG8_STAGE(PG8_SB(1, 0), b3, voffB);
            PG8_BAR; PG8_WAIT_L(0); PG8_MMA(0, 1, At, B1); PG8_BAR;
            PG8_LDA(At, 1, 1); PG8_STAGE(PG8_SA(1, 0), a3, voffA);
            PG8_BAR; PG8_WAIT_L(0); PG8_MMA(1, 0, At, B0); PG8_BAR; PG8_SCHED;
            PG8_STAGE(PG8_SB(1, 1), b3 + hstepB, voffB);
            PG8_WAIT_V(6); PG8_BAR; PG8_MMA(1, 1, At, B1); PG8_BAR;
            }
        }
        if constexpr (ALIGN_EPI) { if (wr == 0) PG8_BAR; }
        if constexpr (!Epi::AFTER_DRAIN) { E(acc, cur, wr, wc, fr, fq); S.done(cur); }
        if (!has_next) break;
#pragma unroll
        for (int a = 0; a < 2; ++a)
#pragma unroll
            for (int b = 0; b < 2; ++b)
#pragma unroll
                for (int m = 0; m < 4; ++m)
#pragma unroll
                    for (int n = 0; n < 2; ++n) acc[a][b][m][n] = (f32x4){0.f, 0.f, 0.f, 0.f};
        cur = nxt; cA = nA; cB = nB; ++ui;
        if constexpr (ALIGN_EPI) { if (wr == 1) PG8_BAR; }
    }
    PG8_WAIT_V(0);
    if constexpr (!ALIGN_EPI) { if (wr == 0) PG8_BAR; }
    PG8_BAR;
    if constexpr (Epi::AFTER_DRAIN) { E.fused(acc, cur, wr, wc, fr, fq, lds, wid, lane); S.done(cur); }
#undef PG8_SA
#undef PG8_SB
#undef PG8_STAGE
#undef PG8_LDA
#undef PG8_LDB
#undef PG8_MMA
#undef PG8_WAIT_V
#undef PG8_WAIT_L
#undef PG8_BAR
#undef PG8_SCHED
}
}
#define GAS __attribute__((address_space(1)))
#define LAS __attribute__((address_space(3)))
typedef unsigned short bf16_t;
typedef unsigned u32x4 __attribute__((ext_vector_type(4)));
typedef unsigned u32x2 __attribute__((ext_vector_type(2)));
typedef float f32x4 __attribute__((ext_vector_type(4)));
typedef float f32x2 __attribute__((ext_vector_type(2)));

constexpr int D = 2048, NBATCH = 16, SEQ = 2048, DEPTH = 4, CTXL = 256;
constexpr int ML = NBATCH * SEQ, MC = NBATCH * CTXL, MT = ML + MC;
constexpr int NPROJ = 3840, DFF = 5632, NGU = 2 * DFF, MODW = 6 * D;
constexpr int OFF_AX = 0, OFF_AB = 512, OFF_AC = 1024, OFF_F = 1536, OFF_Q = 2048, OFF_K = 2560, OFF_V = 2688, OFF_U = 2816, OFF_MV = 3328;
constexpr float EPS = 1e-6f;
constexpr int NWAVES = 8, NTHREADS = 512;

constexpr size_t al256(size_t x) { return (x + 255) & ~(size_t)255; }
constexpr size_t WS_CTL = 0, CTL_ZERO_BYTES = 1u << 20;
constexpr size_t WS_WIN = CTL_ZERO_BYTES;
constexpr size_t WS_WOUT = WS_WIN + (size_t)DEPTH * NPROJ * D * 2;
constexpr size_t WS_WGU = WS_WOUT + (size_t)DEPTH * D * D * 2;
constexpr size_t WS_WDN = WS_WGU + (size_t)DEPTH * NGU * D * 2;
constexpr size_t WS_MOD = WS_WDN + (size_t)DEPTH * D * DFF * 2;
constexpr size_t WS_MODP = al256(WS_MOD + (size_t)DEPTH * 17 * MODW * 4);
constexpr size_t WS_XS = al256(WS_MODP + (size_t)DEPTH * 8 * 17 * MODW * 4);
constexpr size_t WS_H = WS_XS + (size_t)MT * D * 4;
constexpr size_t WS_P = WS_H + (size_t)MT * D * 2;
constexpr size_t WS_Y = WS_P + (size_t)MT * NPROJ * 2;
constexpr size_t WS_HF = WS_P;
constexpr size_t WS_TT = WS_Y + (size_t)MT * D * 2;
static_assert(WS_HF + (size_t)MT * DFF * 2 <= WS_TT, "hf overlay");
constexpr size_t WS_TTC = WS_TT + (size_t)NBATCH * 512 * 4096 * 2;
constexpr size_t WS_DFTN = WS_TTC + (size_t)NBATCH * 512 * 512 * 2;
constexpr size_t WS_DFTC = WS_DFTN + (size_t)2048 * 4096 * 2;
constexpr size_t WS_ROPE = WS_DFTC + (size_t)256 * 512 * 2;
constexpr size_t WS_CSBD = WS_ROPE + (size_t)2048 * 32 * 8;
constexpr size_t WS_END = WS_CSBD + (size_t)1024 * 512 * 2;
constexpr int CW_BAR = 4096;

constexpr int LDS_BYTES = 147456;
constexpr int LDSCTL_OFF = 146432, MISC_OFF = LDSCTL_OFF;

#define LDS_WAIT() asm volatile("s_waitcnt lgkmcnt(0)" ::: "memory")
__device__ __forceinline__ float bf2f(unsigned b) { return __uint_as_float(b << 16); }
__device__ __forceinline__ unsigned f2bf(float f) { unsigned u = __float_as_uint(f); return (u + 0x7fffu + ((u >> 16) & 1u)) >> 16; }
__device__ __forceinline__ unsigned pk2(float lo, float hi) { return f2bf(lo) | (f2bf(hi) << 16); }
__device__ __forceinline__ void unpack8(const u32x4 w, float* o) {
    o[0] = __uint_as_float(w.x << 16); o[1] = __uint_as_float(w.x & 0xffff0000u); o[2] = __uint_as_float(w.y << 16); o[3] = __uint_as_float(w.y & 0xffff0000u);
    o[4] = __uint_as_float(w.z << 16); o[5] = __uint_as_float(w.z & 0xffff0000u); o[6] = __uint_as_float(w.w << 16); o[7] = __uint_as_float(w.w & 0xffff0000u);
}
__device__ __forceinline__ float wave_sum(float v) {
#pragma unroll
    for (int o = 1; o < 64; o <<= 1) v += __shfl_xor(v, o);
    return v;
}
__device__ __forceinline__ float gelu_tanh(float x) {
    const float u = 0.7978845608028654f * (x + 0.044715f * x * x * x);
    const float e = __expf(2.0f * u);
    const float t = 1.0f - 2.0f * __builtin_amdgcn_rcpf(1.0f + e);
    return 0.5f * x * (1.0f + t);
}
#define XB_TMO      128
#define XB_XCNT(j)  (256  + 64 * (j))
#define XB_XSUB(j)  (1280 + 64 * (j))
#define XB_XGEN(j)  (2304 + 64 * (j))
#define XB_TOP      3328
#define XB_TOPGEN   3392
#define XCD_BAR_WORDS 3456
#define XB_SPIN_CAP (1u << 18)

__device__ __forceinline__ unsigned xb_ld(unsigned* p)              { return __hip_atomic_load(p, __ATOMIC_RELAXED, __HIP_MEMORY_SCOPE_AGENT); }
__device__ __forceinline__ unsigned xb_add(unsigned* p, unsigned v) { return __hip_atomic_fetch_add(p, v, __ATOMIC_RELAXED, __HIP_MEMORY_SCOPE_AGENT); }
__device__ __forceinline__ unsigned xb_xcc_id() { return (unsigned)__builtin_amdgcn_s_getreg((3 << 11) | 20) & 0xFu; }
#define XB_SPIN(cond, bar) do { unsigned _sp = 0; while (cond) { __builtin_amdgcn_s_sleep(1); \
    if ((++_sp & 255u) == 0u) { if (xb_ld(&(bar)[XB_TMO])) break; if (_sp > XB_SPIN_CAP) { atomicAdd(&(bar)[XB_TMO], 1u); break; } } } } while (0)

struct XcdBarrier {
    unsigned* bar; unsigned x;
    volatile LAS unsigned* st;
};

__device__ __forceinline__ XcdBarrier xcd_barrier_post(unsigned* bar, volatile LAS unsigned* st) {
    XcdBarrier b; b.bar = bar; b.x = xb_xcc_id(); b.st = st;
    if (threadIdx.x == 0) (void)xb_add(&bar[XB_XCNT(b.x)], 1u);
    return b;
}
__device__ __forceinline__ void xcd_barrier_complete(unsigned* bar, unsigned x, unsigned& nloc, unsigned& nx) {
    const unsigned G = gridDim.x * gridDim.y * gridDim.z;
    unsigned sum, cnt, mine, sp = 0u;
    for (;;) {
        sum = 0u; cnt = 0u; mine = 0u;
#pragma unroll
        for (unsigned j = 0; j < 16; ++j) { const unsigned c = xb_ld(&bar[XB_XCNT(j)]); sum += c; cnt += (c > 0u) ? 1u : 0u; mine = (j == x) ? c : mine; }
        if (sum == G) break;
        __builtin_amdgcn_s_sleep(1);
        if ((++sp & 255u) == 0u) { if (xb_ld(&bar[XB_TMO])) break; if (sp > XB_SPIN_CAP) { atomicAdd(&bar[XB_TMO], 1u); break; } }
    }
    nloc = mine > 0u ? mine : 1u; nx = cnt > 0u ? cnt : 1u;
}

__device__ __forceinline__ void xcd_barrier(const XcdBarrier& b) {
    asm volatile("s_waitcnt vmcnt(0)" ::: "memory");
    __syncthreads();
    if (threadIdx.x == 0) {
        unsigned* bar = b.bar;
        __builtin_amdgcn_s_waitcnt(0);
        unsigned nloc = b.st[0], nx = b.st[1];
        if (nloc == 0u) { xcd_barrier_complete(bar, b.x, nloc, nx); b.st[0] = nloc; b.st[1] = nx; }
        const unsigned old = xb_add(&bar[XB_XSUB(b.x)], 1u);
        const unsigned gen = old / nloc;
        if (old + 1u == (gen + 1u) * nloc) {
            __builtin_amdgcn_fence(__ATOMIC_RELEASE, "agent");
            asm volatile("s_waitcnt vmcnt(0)" ::: "memory");
            const unsigned og = xb_add(&bar[XB_TOP], 1u);
            const unsigned tg = og / nx;
            if (og + 1u == (tg + 1u) * nx) xb_add(&bar[XB_TOPGEN], 1u);
            else XB_SPIN(xb_ld(&bar[XB_TOPGEN]) == tg, bar);
            __builtin_amdgcn_fence(__ATOMIC_ACQUIRE, "agent");
            xb_add(&bar[XB_XGEN(b.x)], 1u);
            asm volatile("s_waitcnt vmcnt(0)" ::: "memory");
        } else {
            XB_SPIN(xb_ld(&bar[XB_XGEN(b.x)]) == gen, bar);
            __builtin_amdgcn_fence(__ATOMIC_ACQUIRE, "agent");
            asm volatile("s_waitcnt vmcnt(0)" ::: "memory");
        }
    }
    __syncthreads();
}
__device__ __forceinline__ void tr_item(const float* __restrict__ W, int K, int N, bf16_t* __restrict__ WT, int k0, int n0, int drow0, LAS float* scr, int lane) {
#pragma unroll 8
    for (int i = 0; i < 32; ++i) { const int kk = 2 * i + (lane >> 5); scr[kk * 33 + (lane & 31)] = W[(size_t)(k0 + kk) * N + n0 + (lane & 31)]; }
    LDS_WAIT(); asm volatile("" ::: "memory");
    const int c = lane & 7;
#pragma unroll
    for (int j = 0; j < 4; ++j) { const int n = (lane >> 3) + 8 * j; const LAS float* s = scr + (8 * c) * 33 + n;
        u32x4 o; o.x = pk2(s[0 * 33], s[1 * 33]); o.y = pk2(s[2 * 33], s[3 * 33]); o.z = pk2(s[4 * 33], s[5 * 33]); o.w = pk2(s[6 * 33], s[7 * 33]);
        *(u32x4*)(WT + (size_t)(drow0 + n) * K + k0 + 8 * c) = o; }
    LDS_WAIT(); asm volatile("" ::: "memory");
}
constexpr int TR_IN = 32 * 120, TR_OUT = 32 * 64, TR_G = 32 * 176, TR_DN = 88 * 64, TR_LAYER = TR_IN + TR_OUT + 2 * TR_G + TR_DN;
__device__ __forceinline__ void p0_transposes(const float* w_in, const float* w_out, const float* w_gate, const float* w_up, const float* w_down,
                                              bf16_t* WIN, bf16_t* WOUT, bf16_t* WGU, bf16_t* WDN, LAS float* scr, int gw, int NGW, int lane) {
    for (int it = gw; it < DEPTH * TR_LAYER; it += NGW) {
        const int l = it / TR_LAYER; int r = it % TR_LAYER;
        if (r < TR_IN) { const int kb = r / 120, nb = r % 120; tr_item(w_in + (size_t)l * D * NPROJ, D, NPROJ, WIN + (size_t)l * NPROJ * D, kb * 64, nb * 32, nb * 32, scr, lane); continue; } r -= TR_IN;
        if (r < TR_OUT) { const int kb = r / 64, nb = r % 64; tr_item(w_out + (size_t)l * D * D, D, D, WOUT + (size_t)l * D * D, kb * 64, nb * 32, nb * 32, scr, lane); continue; } r -= TR_OUT;
        if (r < TR_G) { const int kb = r / 176, nb = r % 176, n0 = nb * 32; tr_item(w_gate + (size_t)l * D * DFF, D, DFF, WGU + (size_t)l * NGU * D, kb * 64, n0, (n0 >> 7) * 256 + (n0 & 127), scr, lane); continue; } r -= TR_G;
        if (r < TR_G) { const int kb = r / 176, nb = r % 176, n0 = nb * 32; tr_item(w_up + (size_t)l * D * DFF, D, DFF, WGU + (size_t)l * NGU * D, kb * 64, n0, (n0 >> 7) * 256 + 128 + (n0 & 127), scr, lane); continue; } r -= TR_G;
        { const int kb = r / 64, nb = r % 64; tr_item(w_down + (size_t)l * DFF * D, DFF, D, WDN + (size_t)l * D * DFF, kb * 64, nb * 32, nb * 32, scr, lane); }
    }
}
__device__ __forceinline__ void p0_modp(const float* __restrict__ c, const float* __restrict__ c_ctx, const float* __restrict__ w_ada, float* __restrict__ modp, LAS float* scr  , int gw, int NGW, int lane) {
    for (int it = gw; it < DEPTH * 48 * 8; it += NGW) {
        const int l = it / 384, rem = it % 384, cc = rem >> 3, ks = rem & 7, k0 = ks * 256;
#pragma unroll
        for (int r = 0; r < 17; ++r)
#pragma unroll
            for (int j = 0; j < 4; ++j) { const int idx = j * 64 + lane; const float v = (r < 16) ? c[r * D + k0 + idx] : c_ctx[k0 + idx]; scr[r * 256 + idx] = v * (1.0f / (1.0f + __expf(-v))); }
        LDS_WAIT(); asm volatile("" ::: "memory");
        f32x4 acc[17];
#pragma unroll
        for (int r = 0; r < 17; ++r) acc[r] = (f32x4){0.f, 0.f, 0.f, 0.f};
        const float* wp = w_ada + ((size_t)l * D + k0) * MODW + cc * 256 + lane * 4;
#pragma unroll 2
        for (int k4 = 0; k4 < 64; ++k4) {
            const f32x4 w0 = *(const f32x4*)(wp + (size_t)(4 * k4 + 0) * MODW), w1 = *(const f32x4*)(wp + (size_t)(4 * k4 + 1) * MODW);
            const f32x4 w2 = *(const f32x4*)(wp + (size_t)(4 * k4 + 2) * MODW), w3 = *(const f32x4*)(wp + (size_t)(4 * k4 + 3) * MODW);
#pragma unroll
            for (int r = 0; r < 17; ++r) { const f32x4 s = *(const LAS f32x4*)(scr + r * 256 + 4 * k4); acc[r] = acc[r] + w0 * s.x + w1 * s.y + w2 * s.z + w3 * s.w; }
        }
#pragma unroll
        for (int r = 0; r < 17; ++r) *(f32x4*)(modp + ((size_t)((l * 8 + ks) * 17 + r)) * MODW + cc * 256 + lane * 4) = acc[r];
        LDS_WAIT(); asm volatile("" ::: "memory");
    }
}
__device__ __forceinline__ void p0_tables(bf16_t* DFTN, bf16_t* DFTC, bf16_t* CSBD, f32x2* ROPE, size_t gtid, size_t NT) {
    for (size_t i = gtid; i < (size_t)1024 * 512 / 8; i += NT) {
        const int r = (int)(i >> 6), c0 = (int)(i & 63) * 8, g = r >> 8, t = (r >> 7) & 1, m = r & 127; float v[8];
#pragma unroll
        for (int e = 0; e < 8; ++e) { const int cp = c0 + e, c = cp & 127, j = (m * c) & 127; const float x = (float)j * (1.0f / 64.0f); v[e] = (cp >> 7) == g ? (t == 0 ? cospif(x) : sinpif(x)) : 0.f; }
        u32x4 o; o.x = pk2(v[0], v[1]); o.y = pk2(v[2], v[3]); o.z = pk2(v[4], v[5]); o.w = pk2(v[6], v[7]);
        *(u32x4*)(CSBD + i * 8) = o;
    }
    for (size_t i = gtid; i < (size_t)2048 * 4096 / 8; i += NT) {
        const int k = (int)(i >> 9), n0 = (int)(i & 511) * 8; float v[8];
#pragma unroll
        for (int e = 0; e < 8; ++e) { const int np = n0 + e, n = np & 2047, j = (k * n) & 2047; const float x = (float)j * (1.0f / 1024.0f); v[e] = np < 2048 ? cospif(x) : -sinpif(x); }
        u32x4 o; o.x = pk2(v[0], v[1]); o.y = pk2(v[2], v[3]); o.z = pk2(v[4], v[5]); o.w = pk2(v[6], v[7]);
        *(u32x4*)(DFTN + i * 8) = o;
    }
    for (size_t i = gtid; i < (size_t)256 * 512 / 8; i += NT) {
        const int k = (int)(i >> 6), n0 = (int)(i & 63) * 8; float v[8];
#pragma unroll
        for (int e = 0; e < 8; ++e) { const int np = n0 + e, n = np & 255, j = (k * n) & 255; const float x = (float)j * (1.0f / 128.0f); v[e] = np < 256 ? cospif(x) : -sinpif(x); }
        u32x4 o; o.x = pk2(v[0], v[1]); o.y = pk2(v[2], v[3]); o.z = pk2(v[4], v[5]); o.w = pk2(v[6], v[7]);
        *(u32x4*)(DFTC + i * 8) = o;
    }
    for (size_t i = gtid; i < (size_t)2048 * 32; i += NT) {
        const int pos = (int)(i >> 5), ii = (int)(i & 31), half = ii >> 4, fi = ii & 15;
        const float inv = exp2f(-(float)fi * (13.287712379549449f / 16.0f));
        const float ang = (float)(half ? (pos & 63) : (pos >> 6)) * inv;
        const float xr = ang * 0.3183098861837907f;
        ROPE[i] = (f32x2){cospif(xr), sinpif(xr)};
    }
}
__device__ __forceinline__ void p0_xs_init(const float* x, const float* ctx, float* xs, size_t gtid, size_t NT) {
    const size_t nl = (size_t)ML * D / 4, nt = (size_t)MT * D / 4;
    for (size_t i = gtid; i < nt; i += NT) { const f32x4 v = i < nl ? ((const f32x4*)x)[i] : ((const f32x4*)ctx)[i - nl]; ((f32x4*)xs)[i] = v; }
}
__device__ __forceinline__ void p1_mod(const float* __restrict__ modp, const float* __restrict__ b_ada, float* __restrict__ mod, size_t gtid, size_t NT) {
    for (size_t i = gtid; i < (size_t)DEPTH * 17 * MODW; i += NT) {
        const int l = (int)(i / (17 * MODW)), rn = (int)(i % (17 * MODW)), n = rn % MODW;
        float s = b_ada[l * MODW + n];
#pragma unroll
        for (int ks = 0; ks < 8; ++ks) s += modp[(size_t)(l * 8 + ks) * 17 * MODW + rn];
        mod[i] = s;
    }
}
__device__ __forceinline__ void norm_mod_rows(const float* __restrict__ xs, const float* __restrict__ gvec, const float* __restrict__ modl, int shoff, int scoff, bf16_t* __restrict__ H, int nrows, int gw, int NGW, int lane) {
    for (int row = gw; row < nrows; row += NGW) {
        const int b = row < ML ? (row >> 11) : 16;
        const f32x4* xr = (const f32x4*)(xs + (size_t)row * D) + lane;
        f32x4 v[8]; float ss = 0.f;
#pragma unroll
        for (int j = 0; j < 8; ++j) { v[j] = xr[64 * j]; ss += (v[j].x * v[j].x + v[j].y * v[j].y) + (v[j].z * v[j].z + v[j].w * v[j].w); }
        const float rstd = 1.0f / sqrtf(wave_sum(ss) * (1.0f / D) + EPS);
        const float* mrow = modl + (size_t)b * MODW;
#pragma unroll
        for (int j = 0; j < 8; ++j) { const int col = 4 * lane + 256 * j;
            const f32x4 g4 = *(const f32x4*)(gvec + col), sc4 = *(const f32x4*)(mrow + scoff + col), sh4 = *(const f32x4*)(mrow + shoff + col);
            const f32x4 o = (v[j] * rstd) * g4 * (sc4 + 1.0f) + sh4;
            u32x2 w; w.x = pk2(o.x, o.y); w.y = pk2(o.z, o.w);
            *(u32x2*)(H + (size_t)row * D + col) = w; }
    }
}
__device__ __forceinline__ void final_norm_rows(const float* __restrict__ xs, const float* __restrict__ gvec, float* __restrict__ out, int gw, int NGW, int lane) {
    for (int row = gw; row < ML; row += NGW) {
        const f32x4* xr = (const f32x4*)(xs + (size_t)row * D) + lane;
        f32x4 v[8]; float ss = 0.f;
#pragma unroll
        for (int j = 0; j < 8; ++j) { v[j] = xr[64 * j]; ss += (v[j].x * v[j].x + v[j].y * v[j].y) + (v[j].z * v[j].z + v[j].w * v[j].w); }
        const float rstd = 1.0f / sqrtf(wave_sum(ss) * (1.0f / D) + EPS);
#pragma unroll
        for (int j = 0; j < 8; ++j) { const int col = 4 * lane + 256 * j; const f32x4 g4 = *(const f32x4*)(gvec + col);
            *(f32x4*)(out + (size_t)row * D + col) = (v[j] * rstd) * g4; }
    }
}
__device__ __forceinline__ void mix_conv(const bf16_t* __restrict__ P, const float* __restrict__ wc  , bf16_t* __restrict__ Y, size_t gtid, size_t NT) {
    for (size_t it = gtid; it < (size_t)MT * 64; it += NT) {
        const int row = (int)(it >> 6), c0 = (int)(it & 63) * 8;
        int n, L; if (row < ML) { n = row & 2047; L = 2048; } else { n = (row - ML) & 255; L = 256; }
        const bf16_t* pr = P + (size_t)row * NPROJ;
        float xc[8], gc[8], gb[8], zp[8], zn[8], t0[8], t1[8];
        unpack8(*(const u32x4*)(pr + OFF_AX + c0), xc); unpack8(*(const u32x4*)(pr + OFF_AC + c0), gc); unpack8(*(const u32x4*)(pr + OFF_AB + c0), gb);
        if (n > 0) { unpack8(*(const u32x4*)(pr - NPROJ + OFF_AX + c0), t0); unpack8(*(const u32x4*)(pr - NPROJ + OFF_AC + c0), t1);
#pragma unroll
            for (int e = 0; e < 8; ++e) zp[e] = t0[e] * t1[e]; }
        else {
#pragma unroll
            for (int e = 0; e < 8; ++e) zp[e] = 0.f; }
        if (n < L - 1) { unpack8(*(const u32x4*)(pr + NPROJ + OFF_AX + c0), t0); unpack8(*(const u32x4*)(pr + NPROJ + OFF_AC + c0), t1);
#pragma unroll
            for (int e = 0; e < 8; ++e) zn[e] = t0[e] * t1[e]; }
        else {
#pragma unroll
            for (int e = 0; e < 8; ++e) zn[e] = 0.f; }
        float o[8];
#pragma unroll
        for (int e = 0; e < 8; ++e) o[e] = gb[e] * (zp[e] * wc[c0 + e] + (gc[e] * xc[e]) * wc[512 + c0 + e] + zn[e] * wc[1024 + c0 + e]);
        u32x4 w; w.x = pk2(o[0], o[1]); w.y = pk2(o[2], o[3]); w.z = pk2(o[4], o[5]); w.w = pk2(o[6], o[7]);
        *(u32x4*)(Y + (size_t)row * D + c0) = w;
    }
}
typedef short bf16x8_t __attribute__((ext_vector_type(8)));
typedef short bf16x4_t __attribute__((ext_vector_type(4)));
constexpr int ATT_KS = 0, ATT_VT = 9216, ATT_LD = 72;
__device__ __forceinline__ void attn_item(const bf16_t* __restrict__ P, bf16_t* __restrict__ Y, const f32x2* __restrict__ rope, const float* __restrict__ sinkl, int b, int kvh, int qb, bool isctx, LAS unsigned char* lds, int tid) {
    LAS bf16_t* Ks = (LAS bf16_t*)(lds + ATT_KS); LAS bf16_t* Vt = (LAS bf16_t*)(lds + ATT_VT);
    const int lane = tid & 63, wave = __builtin_amdgcn_readfirstlane(tid >> 6), fr = lane & 15, fq = lane >> 4;
    const int g = wave >> 1, h = kvh * 4 + g, p0 = qb * 128 + (wave & 1) * 64;
    const float L2E = 1.4426950408889634f, QS = 0.125f * L2E;
    bf16x8_t Qf[4][2];
#pragma unroll
    for (int qblk = 0; qblk < 4; ++qblk) {
        const int qpos = p0 + qblk * 16 + fr;
        const size_t rowq = isctx ? (size_t)ML + b * 256 + qpos : (size_t)b * 2048 + qpos;
        const bf16_t* qp = P + rowq * NPROJ + OFF_Q + h * 64;
#pragma unroll
        for (int s = 0; s < 2; ++s) {
            if (isctx) Qf[qblk][s] = *(const bf16x8_t*)(qp + 32 * s + 8 * fq);
            else { const int which = fq >> 1, sub = fq & 1; float t1[8], t2[8];
                unpack8(*(const u32x4*)(qp + 32 * s + 8 * sub), t1); unpack8(*(const u32x4*)(qp + 32 * s + 16 + 8 * sub), t2);
                float o[8];
#pragma unroll
                for (int i = 0; i < 8; ++i) { const f32x2 cs = rope[qpos * 32 + s * 16 + sub * 8 + i]; o[i] = which == 0 ? (t1[i] * cs.x - t2[i] * cs.y) : (t2[i] * cs.x + t1[i] * cs.y); }
                u32x4 w; w.x = pk2(o[0], o[1]); w.y = pk2(o[2], o[3]); w.z = pk2(o[4], o[5]); w.w = pk2(o[6], o[7]);
                Qf[qblk][s] = __builtin_bit_cast(bf16x8_t, w); }
        }
    }
    f32x4 O[4][4]; float mrun[4], lsum[4];
    const float sk = sinkl[h] * L2E;
#pragma unroll
    for (int qblk = 0; qblk < 4; ++qblk) { mrun[qblk] = sk; lsum[qblk] = fq == 0 ? 1.0f : 0.0f;
#pragma unroll
        for (int db = 0; db < 4; ++db) O[qblk][db] = (f32x4){0.f, 0.f, 0.f, 0.f}; }
    const int ntiles = isctx ? 4 : 10;
#pragma unroll 1
    for (int t = 0; t < ntiles; ++t) {
        bool local; int k0;
        if (isctx) { local = false; k0 = t * 64; } else if (t < 6) { local = true; k0 = (qb - 1) * 128 + t * 64; } else { local = false; k0 = (t - 6) * 64; }
        if (local && (k0 < 0 || k0 >= 2048)) continue;
        __syncthreads();
        { const int j = tid >> 3, part = tid & 7, half = part >> 2, which = (part >> 1) & 1, sub = part & 1;
          const size_t rowk = local ? (size_t)b * 2048 + k0 + j : (size_t)ML + b * 256 + k0 + j;
          const bf16_t* kp = P + rowk * NPROJ + OFF_K + kvh * 64; const bf16_t* vp = P + rowk * NPROJ + OFF_V + kvh * 64 + part * 8;
          const u32x4 vraw = *(const u32x4*)vp;
          u32x4 kw;
          if (local) { float t1[8], t2[8], ko[8]; const int kpos = k0 + j;
              unpack8(*(const u32x4*)(kp + half * 32 + sub * 8), t1); unpack8(*(const u32x4*)(kp + half * 32 + 16 + sub * 8), t2);
#pragma unroll
              for (int i = 0; i < 8; ++i) { const f32x2 cs = rope[kpos * 32 + half * 16 + sub * 8 + i]; ko[i] = which == 0 ? (t1[i] * cs.x - t2[i] * cs.y) : (t2[i] * cs.x + t1[i] * cs.y); }
              kw.x = pk2(ko[0], ko[1]); kw.y = pk2(ko[2], ko[3]); kw.z = pk2(ko[4], ko[5]); kw.w = pk2(ko[6], ko[7]); }
          else kw = *(const u32x4*)(kp + part * 8);
          *(LAS u32x4*)(Ks + j * ATT_LD + part * 8) = kw;
          const unsigned vw[4] = {vraw.x, vraw.y, vraw.z, vraw.w};
#pragma unroll
          for (int i = 0; i < 4; ++i) { Vt[(part * 8 + 2 * i) * ATT_LD + j] = (bf16_t)(vw[i] & 0xffffu); Vt[(part * 8 + 2 * i + 1) * ATT_LD + j] = (bf16_t)(vw[i] >> 16); }
        }
        __syncthreads();
#pragma unroll 1
        for (int kb = 0; kb < 64; kb += 32) {
            const int kmin = k0 + kb;
            if (local && (kmin + 31 < p0 - 128 || kmin > p0 + 63 + 128)) continue;
            bf16x8_t Kf[2][2];
#pragma unroll
            for (int blk = 0; blk < 2; ++blk)
#pragma unroll
                for (int s = 0; s < 2; ++s) Kf[blk][s] = *(const LAS bf16x8_t*)(Ks + (kb + 16 * blk + fr) * ATT_LD + 32 * s + 8 * fq);
            bf16x8_t Vf[4];
#pragma unroll
            for (int db = 0; db < 4; ++db) { const LAS bf16_t* vp = Vt + (16 * db + fr) * ATT_LD + kb + 4 * fq;
                const bf16x4_t lo = *(const LAS bf16x4_t*)vp, hi = *(const LAS bf16x4_t*)(vp + 16);
                Vf[db] = __builtin_shufflevector(lo, hi, 0, 1, 2, 3, 4, 5, 6, 7); }
#pragma unroll
            for (int qblk = 0; qblk < 4; ++qblk) {
                f32x4 S0 = (f32x4){0.f, 0.f, 0.f, 0.f}, S1 = S0;
                S0 = __builtin_amdgcn_mfma_f32_16x16x32_bf16(Kf[0][0], Qf[qblk][0], S0, 0, 0, 0); S0 = __builtin_amdgcn_mfma_f32_16x16x32_bf16(Kf[0][1], Qf[qblk][1], S0, 0, 0, 0);
                S1 = __builtin_amdgcn_mfma_f32_16x16x32_bf16(Kf[1][0], Qf[qblk][0], S1, 0, 0, 0); S1 = __builtin_amdgcn_mfma_f32_16x16x32_bf16(Kf[1][1], Qf[qblk][1], S1, 0, 0, 0);
                float sv[8]; bool valid[8];
                const int qpos = p0 + qblk * 16 + fr;
#pragma unroll
                for (int r = 0; r < 4; ++r) { sv[r] = S0[r] * QS; sv[4 + r] = S1[r] * QS;
                    int d0 = qpos - (kmin + 4 * fq + r); d0 = d0 < 0 ? -d0 : d0; int d1 = qpos - (kmin + 16 + 4 * fq + r); d1 = d1 < 0 ? -d1 : d1;
                    valid[r] = !local || d0 <= 128; valid[4 + r] = !local || d1 <= 128; }
                float cm = -3.0e38f;
#pragma unroll
                for (int r = 0; r < 8; ++r) cm = fmaxf(cm, valid[r] ? sv[r] : -3.0e38f);
                cm = fmaxf(cm, __shfl_xor(cm, 16)); cm = fmaxf(cm, __shfl_xor(cm, 32));
                const float mnew = fmaxf(mrun[qblk], cm), sc = exp2f(mrun[qblk] - mnew);
                float pp[8], ps = 0.f;
#pragma unroll
                for (int r = 0; r < 8; ++r) { pp[r] = valid[r] ? exp2f(sv[r] - mnew) : 0.f; ps += pp[r]; }
                lsum[qblk] = lsum[qblk] * sc + ps; mrun[qblk] = mnew;
                u32x4 pw; pw.x = pk2(pp[0], pp[1]); pw.y = pk2(pp[2], pp[3]); pw.z = pk2(pp[4], pp[5]); pw.w = pk2(pp[6], pp[7]);
                const bf16x8_t Pf = __builtin_bit_cast(bf16x8_t, pw);
#pragma unroll
                for (int db = 0; db < 4; ++db) { O[qblk][db] = O[qblk][db] * sc; O[qblk][db] = __builtin_amdgcn_mfma_f32_16x16x32_bf16(Vf[db], Pf, O[qblk][db], 0, 0, 0); }
            }
        }
    }
#pragma unroll
    for (int qblk = 0; qblk < 4; ++qblk) {
        float l = lsum[qblk]; l += __shfl_xor(l, 16); l += __shfl_xor(l, 32);
        const float rl = 1.0f / l;
        const int qpos = p0 + qblk * 16 + fr;
        const size_t rowq = isctx ? (size_t)ML + b * 256 + qpos : (size_t)b * 2048 + qpos;
        bf16_t* yp = Y + rowq * D + 1024 + h * 64 + 4 * fq;
#pragma unroll
        for (int db = 0; db < 4; ++db) { const f32x4 o = O[qblk][db] * rl; u32x2 w; w.x = pk2(o[0], o[1]); w.y = pk2(o[2], o[3]); *(u32x2*)(yp + 16 * db) = w; }
    }
}
__device__ __forceinline__ void mix_attn(const bf16_t* P, bf16_t* Y, const f32x2* rope, const float* sinkl, LAS unsigned char* lds, int vcu, int G, int tid) {
    for (int it = vcu; it < 512 + 64; it += G) {
        if (it < 512) { const int b = it >> 5, kvh = (it >> 4) & 1, qb = it & 15; attn_item(P, Y, rope, sinkl, b, kvh, qb, false, lds, tid); }
        else { const int r = it - 512, b = r >> 2, kvh = (r >> 1) & 1, qb = r & 1; attn_item(P, Y, rope, sinkl, b, kvh, qb, true, lds, tid); }
    }
    __syncthreads();
}
__device__ __forceinline__ void mix_mlp(const bf16_t* __restrict__ P, const float* __restrict__ w_s  , const float* __restrict__ b_s  , bf16_t* __restrict__ Y, LAS unsigned char* lds, int vcu, int G, int tid) {
    LAS float* vn = (LAS float*)lds; LAS float* wsm = vn + 128 * 128;
    for (int it = vcu; it < (MT / 128) * 4; it += G) {
        const int ch = it >> 2, g = it & 3; const size_t row0 = (size_t)ch * 128;
        __syncthreads();
        for (int i = tid; i < 128 * 128; i += NTHREADS) wsm[(i >> 7) * 129 + (i & 127)] = w_s[g * 16384 + i];
        const int p = tid >> 2, cp = tid & 3;
        const bf16_t* pr = P + (row0 + p) * NPROJ;
        { float vv[32];
#pragma unroll
          for (int j = 0; j < 4; ++j) unpack8(*(const u32x4*)(pr + OFF_MV + g * 128 + cp * 32 + 8 * j), vv + 8 * j);
          float s = 0.f;
#pragma unroll
          for (int i = 0; i < 32; ++i) { vv[i] = gelu_tanh(vv[i]); s += vv[i]; }
          s += __shfl_xor(s, 1); s += __shfl_xor(s, 2);
          const float mean = s * (1.0f / 128.0f); float qq = 0.f;
#pragma unroll
          for (int i = 0; i < 32; ++i) { vv[i] -= mean; qq += vv[i] * vv[i]; }
          qq += __shfl_xor(qq, 1); qq += __shfl_xor(qq, 2);
          const float rstd = 1.0f / sqrtf(qq * (1.0f / 128.0f) + EPS);
#pragma unroll
          for (int i = 0; i < 32; i += 4) *(LAS f32x4*)(vn + p * 128 + cp * 32 + i) = (f32x4){vv[i] * rstd, vv[i + 1] * rstd, vv[i + 2] * rstd, vv[i + 3] * rstd}; }
        __syncthreads();
        float acc[32];
#pragma unroll
        for (int i = 0; i < 32; ++i) acc[i] = 0.f;
        for (int qi = 0; qi < 128; ++qi) { const float w = wsm[p * 129 + qi];
#pragma unroll
            for (int i = 0; i < 32; i += 4) { const f32x4 x = *(const LAS f32x4*)(vn + qi * 128 + cp * 32 + i); acc[i] += w * x.x; acc[i + 1] += w * x.y; acc[i + 2] += w * x.z; acc[i + 3] += w * x.w; } }
        const float bias = b_s[g * 128 + p];
        float uu[32];
#pragma unroll
        for (int j = 0; j < 4; ++j) unpack8(*(const u32x4*)(pr + OFF_U + g * 128 + cp * 32 + 8 * j), uu + 8 * j);
        bf16_t* yp = Y + (row0 + p) * D + 1536 + g * 128 + cp * 32;
#pragma unroll
        for (int i = 0; i < 32; i += 8) { float o[8];
#pragma unroll
            for (int e = 0; e < 8; ++e) o[e] = gelu_tanh(uu[i + e]) * (acc[i + e] + bias);
            u32x4 w; w.x = pk2(o[0], o[1]); w.y = pk2(o[2], o[3]); w.z = pk2(o[4], o[5]); w.w = pk2(o[6], o[7]);
            *(u32x4*)(yp + i) = w; }
    }
    __syncthreads();
}
constexpr int PH_LAYER0 = 2, PH_PER_LAYER = 8, PH_FINAL = PH_LAYER0 + DEPTH * PH_PER_LAYER, NPH = PH_FINAL + 1;
#ifndef MK_ONE_LAUNCH
#define MK_ONE_LAUNCH 1
#endif
struct Args { const float* in[18]; float* out; unsigned char* ws; int ph_lo, ph_hi, use_bar, pad; };
__global__ void __launch_bounds__(NTHREADS, 2) fwd(Args a) {
    extern __shared__ __attribute__((aligned(16))) unsigned char lds_raw[];
    LAS unsigned char* lds = (LAS unsigned char*)lds_raw;
    volatile LAS unsigned* MISC = (volatile LAS unsigned*)(lds + MISC_OFF);
    const int G = gridDim.x, bx = blockIdx.x, vcu = (G % 8 == 0) ? (bx % 8) * (G / 8) + bx / 8 : bx;
    const int NGW = G * NWAVES; const size_t NT = (size_t)G * NTHREADS;
#define TID_VARS int tid = threadIdx.x; asm volatile("" : "+v"(tid)); const int lane = tid & 63, wave = __builtin_amdgcn_readfirstlane(tid >> 6), gw = vcu * NWAVES + wave; const size_t gtid = (size_t)vcu * NTHREADS + tid; (void)lane; (void)gw; (void)gtid
    unsigned char* ws = a.ws;
    unsigned* ctl = (unsigned*)(ws + WS_CTL);
    for (int u = threadIdx.x; u < (LDS_BYTES - LDSCTL_OFF) / 4; u += NTHREADS) ((LAS unsigned*)(lds + LDSCTL_OFF))[u] = 0u;
    __syncthreads();
    XcdBarrier bar; bar.bar = ctl + CW_BAR; bar.x = 0; bar.st = nullptr;
    if (a.use_bar) bar = xcd_barrier_post(ctl + CW_BAR, MISC + 8);
    const int lo = a.ph_lo, hi = a.ph_hi;
#define IN(k) (lo <= (k) && (k) < hi)
#define SEAM(k) do { if (IN(k) && IN((k) + 1)) xcd_barrier(bar); } while (0)
    const float* x = a.in[0]; const float* cvec = a.in[1]; const float* ctx = a.in[2]; const float* c_ctx = a.in[3]; const float* w_ada = a.in[4]; const float* b_ada = a.in[5];
    const float* g_norm1 = a.in[6]; const float* w_in = a.in[7]; const float* w_conv = a.in[8]; const float* sink = a.in[9]; const float* w_s = a.in[10]; const float* b_s = a.in[11];
    const float* w_out = a.in[12]; const float* g_norm2 = a.in[13]; const float* w_gate = a.in[14]; const float* w_up = a.in[15]; const float* w_down = a.in[16]; const float* g_final = a.in[17];
    bf16_t* WIN = (bf16_t*)(ws + WS_WIN); bf16_t* WOUT = (bf16_t*)(ws + WS_WOUT); bf16_t* WGU = (bf16_t*)(ws + WS_WGU); bf16_t* WDN = (bf16_t*)(ws + WS_WDN);
    float* MOD = (float*)(ws + WS_MOD); float* MODP = (float*)(ws + WS_MODP); float* XS = (float*)(ws + WS_XS);
    bf16_t* H = (bf16_t*)(ws + WS_H); bf16_t* P = (bf16_t*)(ws + WS_P); bf16_t* Y = (bf16_t*)(ws + WS_Y); bf16_t* HF = (bf16_t*)(ws + WS_HF);
    bf16_t* TT = (bf16_t*)(ws + WS_TT); bf16_t* TTC = (bf16_t*)(ws + WS_TTC); bf16_t* DFTN = (bf16_t*)(ws + WS_DFTN); bf16_t* DFTC = (bf16_t*)(ws + WS_DFTC);
    f32x2* ROPE = (f32x2*)(ws + WS_ROPE); bf16_t* CSBD = (bf16_t*)(ws + WS_CSBD);

    if (IN(0)) { TID_VARS;
        LAS float* scr = (LAS float*)(lds + wave * 17408);
        p0_modp(cvec, c_ctx, w_ada, MODP, scr, gw, NGW, lane);
        p0_transposes(w_in, w_out, w_gate, w_up, w_down, WIN, WOUT, WGU, WDN, scr, gw, NGW, lane);
        p0_tables(DFTN, DFTC, CSBD, ROPE, gtid, NT);
        p0_xs_init(x, ctx, XS, gtid, NT);
        SEAM(0);
    }
    if (IN(1)) { TID_VARS; p1_mod(MODP, b_ada, MOD, gtid, NT); SEAM(1); }

    for (int l = 0; l < DEPTH; ++l) {
        const int pb = PH_LAYER0 + l * PH_PER_LAYER;
        const float* modl = MOD + (size_t)l * 17 * MODW;
        if (IN(pb + 0)) { TID_VARS; norm_mod_rows(XS, g_norm1 + l * D, modl, 0, D, H, MT, gw, NGW, lane); SEAM(pb + 0); }
        if (IN(pb + 1)) {
            pg8::Gemm g{H, WIN + (size_t)l * NPROJ * D, MT, NPROJ, D, D, D}; pg8::StaticOrder S; S.init(MT, NPROJ, G, bx);
            pg8::EpiP E{P, NPROJ};
            pg8::gemm_phase<pg8::EpiP, pg8::StaticOrder, true, true>(lds, g, S, E);
            SEAM(pb + 1);
        }
        if (IN(pb + 2)) {
            { pg8::Gemm g{CSBD, P + OFF_F, 1024, MT, 512, 512, NPROJ}; pg8::StaticOrder S; S.init(1024, MT, G, bx);
              pg8::EpiFour1 E{TT, TTC};
              pg8::gemm_phase<pg8::EpiFour1, pg8::StaticOrder, true, true>(lds, g, S, E); }
            TID_VARS;
            mix_conv(P, w_conv + (size_t)l * 3 * 512, Y, gtid, NT);
            mix_attn(P, Y, ROPE, sink + l * 8, lds, vcu, G, tid);
            mix_mlp(P, w_s + (size_t)l * 4 * 128 * 128, b_s + (size_t)l * 4 * 128, Y, lds, vcu, G, tid);
            SEAM(pb + 2);
        }
        if (IN(pb + 3)) {
            { pg8::Gemm g{DFTN, TT, 2048, 8192, 4096, 4096, 4096}; pg8::StaticOrder S; S.init(2048, 8192, G, bx);
              pg8::EpiFour E{Y, 1.0f / 512.0f, 0, 2048};
              pg8::gemm_phase<pg8::EpiFour, pg8::StaticOrder, true, true>(lds, g, S, E); }
            { pg8::Gemm g{DFTC, TTC, 256, 8192, 512, 512, 512}; pg8::StaticOrder S; S.init(256, 8192, G, bx);
              pg8::EpiFour E{Y, 0.005524271728019903f  , ML, 256};
              pg8::gemm_phase<pg8::EpiFour, pg8::StaticOrder, true, true>(lds, g, S, E); }
            SEAM(pb + 3);
        }
        if (IN(pb + 4)) {
            pg8::Gemm g{Y, WOUT + (size_t)l * D * D, MT, D, D, D, D}; pg8::StaticOrder S; S.init(MT, D, G, bx);
            pg8::EpiRes E{XS, modl, 2 * D};
            pg8::gemm_phase<pg8::EpiRes, pg8::StaticOrder, true, true>(lds, g, S, E);
            SEAM(pb + 4);
        }
        if (IN(pb + 5)) { TID_VARS; norm_mod_rows(XS, g_norm2 + l * D, modl, 3 * D, 4 * D, H, MT, gw, NGW, lane); SEAM(pb + 5); }
        if (IN(pb + 6)) {
            pg8::Gemm g{H, WGU + (size_t)l * NGU * D, MT, NGU, D, D, D}; pg8::StaticOrder S; S.init(MT, NGU, G, bx);
            pg8::EpiGU E{HF};
            pg8::gemm_phase<pg8::EpiGU, pg8::StaticOrder, true, true>(lds, g, S, E);
            SEAM(pb + 6);
        }
        if (IN(pb + 7)) {
            pg8::Gemm g{HF, WDN + (size_t)l * D * DFF, MT, D, DFF, DFF, DFF}; pg8::StaticOrder S; S.init(MT, D, G, bx);
            pg8::EpiRes E{XS, modl, 5 * D};
            pg8::gemm_phase<pg8::EpiRes, pg8::StaticOrder, true, true>(lds, g, S, E);
            SEAM(pb + 7);
        }
    }
    if (IN(PH_FINAL)) { TID_VARS; final_norm_rows(XS, g_final, a.out, gw, NGW, lane); }
#undef IN
#undef SEAM
}

extern "C" void kernel_launch(void* const* d_in, const int* in_sizes, int n_in, void* d_out, int out_size, void* d_ws, size_t ws_size, hipStream_t stream) {
    static int grid = 0;
    if (grid == 0) {
        if (n_in != 18 || in_sizes[0] != ML * D || out_size != ML * D || ws_size < WS_END) { fprintf(stderr, "kernel_launch: unexpected shapes: n_in %d in0 %d out %d ws %zu (need %zu)\n", n_in, n_in > 0 ? in_sizes[0] : -1, out_size, ws_size, (size_t)WS_END); grid = -1; return; }
        int dev = 0, cus = 0, per_cu = 0;
        if (hipGetDevice(&dev) != hipSuccess || hipDeviceGetAttribute(&cus, hipDeviceAttributeMultiprocessorCount, dev) != hipSuccess) { fprintf(stderr, "kernel_launch: device query failed\n"); grid = -1; return; }
        if (hipFuncSetAttribute((const void*)fwd, hipFuncAttributeMaxDynamicSharedMemorySize, LDS_BYTES) != hipSuccess) { fprintf(stderr, "kernel_launch: hipFuncSetAttribute failed\n"); grid = -1; return; }
        if (hipOccupancyMaxActiveBlocksPerMultiprocessor(&per_cu, (const void*)fwd, NTHREADS, LDS_BYTES) != hipSuccess || per_cu < 1) fprintf(stderr, "kernel_launch: note: occupancy query reports %d workgroups per CU\n", per_cu);
        (void)hipGetLastError();
        grid = cus;
    }
    if (grid < 0) return;
    if (hipMemsetAsync((char*)d_ws + WS_CTL, 0, CTL_ZERO_BYTES, stream) != hipSuccess) { fprintf(stderr, "kernel_launch: memset failed\n"); return; }
    Args a{};
    for (int i = 0; i < 18; ++i) a.in[i] = (const float*)d_in[i];
    a.out = (float*)d_out; a.ws = (unsigned char*)d_ws; a.pad = 0;
#if MK_ONE_LAUNCH
    a.ph_lo = 0; a.ph_hi = NPH; a.use_bar = 1;
    hipLaunchKernelGGL(fwd, dim3(grid), dim3(NTHREADS), LDS_BYTES, stream, a);
#else
    for (int ph = 0; ph < NPH; ++ph) { a.ph_lo = ph; a.ph_hi = ph + 1; a.use_bar = 0; hipLaunchKernelGGL(fwd, dim3(grid), dim3(NTHREADS), LDS_BYTES, stream, a); }
#endif
    const hipError_t le = hipPeekAtLastError();
    if (le != hipSuccess) fprintf(stderr, "kernel_launch: launch failed: %s\n", hipGetErrorName(le));
}
```

```cpp
#include <hip/hip_runtime.h>
#include <cstdio>
#include <cstdint>
namespace pg8 {
#define PG8_LAS __attribute__((address_space(3)))
typedef unsigned short bf16_t;
typedef short bf16x8 __attribute__((ext_vector_type(8)));
typedef float f32x4 __attribute__((ext_vector_type(4)));
typedef unsigned u32x4 __attribute__((ext_vector_type(4)));
constexpr int BM = 256, BK = 64, HALF = 128, HTB = HALF * BK * 2  , STAGE_BYTES = 8 * HTB, NXCD = 8, WGM = 8;

__host__ __device__ __forceinline__ int lds_byte(int r, int c) { const int st = (r >> 4) * 2 + (c >> 5), rr = r & 15, cc = c & 31, ob = rr * 64 + cc * 2; return st * 1024 + (ob ^ (((ob >> 9) & 1) << 5)); }
__host__ __device__ __forceinline__ void stage_rc(int b, int& R, int& C) { const int st = b / 1024, sb = b % 1024, swz = sb ^ (((sb >> 9) & 1) << 5); R = (st >> 1) * 16 + swz / 64; C = (st & 1) * 32 + (swz % 64) / 2; }
__host__ __device__ __forceinline__ int perm32(int rho) { const int n = rho >> 4, i = rho & 15; return 8 * (i >> 2) + 4 * n + (i & 3); }

struct Unit { int pm, pn; };
struct Gemm { const bf16_t* A; const bf16_t* Bt; int M, N, K, lda, ldb; };

struct StaticOrder {
    int nM, nN, nwg, G, c;
    __host__ __device__ void init(int M, int N, int G_, int c_) { nM = M / BM; nN = N / BM; nwg = nM * nN; G = G_; c = c_; }
    __host__ __device__ bool next(int i, Unit& u) const {
        const long L = (long)i * G + c; if (L >= nwg) return false;
        int wgid = (int)L; { const int q = nwg / NXCD, r = nwg % NXCD, xcd = wgid % NXCD, off = wgid / NXCD; wgid = (xcd < r ? xcd * (q + 1) : r * (q + 1) + (xcd - r) * q) + off; }
        const int nig = WGM * nN, gid = wgid / nig, fm = gid * WGM, gsz = (nM - fm) < WGM ? (nM - fm) : WGM;
        u.pm = fm + ((wgid % nig) % gsz); u.pn = (wgid % nig) / gsz; return true;
    }
    __device__ __forceinline__ void a_ready(const Unit&) const {}
    __device__ __forceinline__ void done(const Unit&) const {}
};

struct OrderIn : StaticOrder {
    int extra;
    __host__ __device__ bool next(int i, Unit& u) const {
        const long L = (long)i * G + c; if (L < nwg) return StaticOrder::next(i, u);
        const long j = L - nwg; if (j >= extra) return false;
        u.pm = 128 + (int)j; u.pn = 10; return true;
    }
};
__device__ __forceinline__ unsigned cvt_pk_bf16(float lo, float hi) { unsigned r; asm volatile("v_cvt_pk_bf16_f32 %0, %1, %2" : "=v"(r) : "v"(lo), "v"(hi)); return r; }
typedef float f32x2 __attribute__((ext_vector_type(2)));
__device__ __forceinline__ float silu_f(float x) { return x * __builtin_amdgcn_rcpf(1.0f + __expf(-x)); }
struct EpiP {
    static constexpr bool PERM = true, AFTER_DRAIN = false;
    bf16_t* O; int ldc;
    __device__ __forceinline__ void operator()(const f32x4 (&acc)[2][2][4][2], const Unit& u, int wr, int wc, int fr, int fq) const {
        const int row0 = u.pm * BM + wr * 64 + fr, col0 = u.pn * BM + wc * 32 + 8 * fq;
#pragma unroll
        for (int ai = 0; ai < 2; ++ai)
#pragma unroll
            for (int m = 0; m < 4; ++m) { bf16_t* rowp = O + (size_t)(row0 + ai * HALF + m * 16) * ldc + col0;
#pragma unroll
                for (int bj = 0; bj < 2; ++bj) { const f32x4 v0 = acc[ai][bj][m][0], v1 = acc[ai][bj][m][1];
                    u32x4 w; w.x = cvt_pk_bf16(v0[0], v0[1]); w.y = cvt_pk_bf16(v0[2], v0[3]); w.z = cvt_pk_bf16(v1[0], v1[1]); w.w = cvt_pk_bf16(v1[2], v1[3]);
                    *(u32x4*)(rowp + bj * HALF) = w; } }
    }
};
struct EpiDelta {
    static constexpr bool PERM = true, AFTER_DRAIN = false;
    bf16_t* O; const float* modl; int goff;
    __device__ __forceinline__ void operator()(const f32x4 (&acc)[2][2][4][2], const Unit& u, int wr, int wc, int fr, int fq) const {
        const int b = u.pm < 128 ? (u.pm >> 3) : 16;
        const float* gate = modl + (size_t)b * 12288 + goff;
        const int row0 = u.pm * BM + wr * 64 + fr, col0 = u.pn * BM + wc * 32 + 8 * fq;
        f32x4 gv[2][2];
#pragma unroll
        for (int bj = 0; bj < 2; ++bj)
#pragma unroll
            for (int n = 0; n < 2; ++n) gv[bj][n] = *(const f32x4*)(gate + col0 + bj * HALF + 4 * n);
#pragma unroll
        for (int ai = 0; ai < 2; ++ai)
#pragma unroll
            for (int m = 0; m < 4; ++m) { bf16_t* rowp = O + (size_t)(row0 + ai * HALF + m * 16) * 2048 + col0;
#pragma unroll
                for (int bj = 0; bj < 2; ++bj) { const f32x4 v0 = acc[ai][bj][m][0] * gv[bj][0], v1 = acc[ai][bj][m][1] * gv[bj][1];
                    u32x4 w; w.x = cvt_pk_bf16(v0[0], v0[1]); w.y = cvt_pk_bf16(v0[2], v0[3]); w.z = cvt_pk_bf16(v1[0], v1[1]); w.w = cvt_pk_bf16(v1[2], v1[3]);
                    *(u32x4*)(rowp + bj * HALF) = w; } }
    }
};
struct EpiGU {
    static constexpr bool PERM = true, AFTER_DRAIN = false;
    bf16_t* O;
    __device__ __forceinline__ void operator()(const f32x4 (&acc)[2][2][4][2], const Unit& u, int wr, int wc, int fr, int fq) const {
        const int row0 = u.pm * BM + wr * 64 + fr, col0 = u.pn * HALF + wc * 32 + 8 * fq;
#pragma unroll
        for (int ai = 0; ai < 2; ++ai)
#pragma unroll
            for (int m = 0; m < 4; ++m) { bf16_t* rowp = O + (size_t)(row0 + ai * HALF + m * 16) * 5632 + col0;
                const f32x4 g0 = acc[ai][0][m][0], g1 = acc[ai][0][m][1], u0 = acc[ai][1][m][0], u1 = acc[ai][1][m][1];
                u32x4 w;
                w.x = cvt_pk_bf16(silu_f(g0[0]) * u0[0], silu_f(g0[1]) * u0[1]); w.y = cvt_pk_bf16(silu_f(g0[2]) * u0[2], silu_f(g0[3]) * u0[3]);
                w.z = cvt_pk_bf16(silu_f(g1[0]) * u1[0], silu_f(g1[1]) * u1[1]); w.w = cvt_pk_bf16(silu_f(g1[2]) * u1[2], silu_f(g1[3]) * u1[3]);
                *(u32x4*)rowp = w; }
    }
};
struct EpiFour {
    static constexpr bool PERM = true, AFTER_DRAIN = false;
    bf16_t* Y; float scale; int row_base, rows_per_batch;
    __device__ __forceinline__ void operator()(const f32x4 (&acc)[2][2][4][2], const Unit& u, int wr, int wc, int fr, int fq) const {
        const int row0 = row_base + (u.pn >> 1) * rows_per_batch + u.pm * BM + wr * 64 + fr, col0 = 512 + (u.pn & 1) * BM + wc * 32 + 8 * fq;
#pragma unroll
        for (int ai = 0; ai < 2; ++ai)
#pragma unroll
            for (int m = 0; m < 4; ++m) { bf16_t* rowp = Y + (size_t)(row0 + ai * HALF + m * 16) * 2048 + col0;
#pragma unroll
                for (int bj = 0; bj < 2; ++bj) { const f32x4 v0 = acc[ai][bj][m][0] * scale, v1 = acc[ai][bj][m][1] * scale;
                    u32x4 w; w.x = cvt_pk_bf16(v0[0], v0[1]); w.y = cvt_pk_bf16(v0[2], v0[3]); w.z = cvt_pk_bf16(v1[0], v1[1]); w.w = cvt_pk_bf16(v1[2], v1[3]);
                    *(u32x4*)(rowp + bj * HALF) = w; } }
    }
};
struct EpiFour1 {
    static constexpr bool PERM = true, AFTER_DRAIN = false;
    bf16_t* TT; bf16_t* TTC;
    __device__ __forceinline__ void operator()(const f32x4 (&acc)[2][2][4][2], const Unit& u, int wr, int wc, int fr, int fq) const {
        const int g = u.pm; bf16_t* base; size_t chs, half;
        if (u.pn < 128) { const int b = u.pn >> 3, n0 = (u.pn & 7) * BM + wc * 32 + 8 * fq; base = TT + (size_t)(b * 512 + g * 128) * 4096 + n0; chs = 4096; half = 2048; }
        else { const int b = u.pn - 128, n0 = wc * 32 + 8 * fq; base = TTC + (size_t)(b * 512 + g * 128) * 512 + n0; chs = 512; half = 256; }
#pragma unroll
        for (int ai = 0; ai < 2; ++ai)
#pragma unroll
            for (int m = 0; m < 4; ++m) { bf16_t* rowp = base + (size_t)(wr * 64 + m * 16 + fr) * chs + ai * half;
#pragma unroll
                for (int bj = 0; bj < 2; ++bj) { const f32x4 v0 = acc[ai][bj][m][0], v1 = acc[ai][bj][m][1];
                    u32x4 w; w.x = cvt_pk_bf16(v0[0], v0[1]); w.y = cvt_pk_bf16(v0[2], v0[3]); w.z = cvt_pk_bf16(v1[0], v1[1]); w.w = cvt_pk_bf16(v1[2], v1[3]);
                    *(u32x4*)(rowp + bj * HALF) = w; } }
    }
};
template <class Epi, class Sched, bool ALIGN_EPI = false, bool SP2 = false>
__device__ __forceinline__ void gemm_phase(PG8_LAS unsigned char* lds, const Gemm g, const Sched& S, const Epi& E) {
    int tid_ = threadIdx.x; asm volatile("" : "+v"(tid_));
    const int tid = tid_, wid = __builtin_amdgcn_readfirstlane(tid >> 6), lane = tid & 63, wr = wid >> 2, wc = wid & 3, fr = lane & 15, fq = lane >> 4;
    const int K = g.K, nt = K / BK;
    unsigned voffA[2], voffB[2];
#pragma unroll
    for (int i = 0; i < 2; ++i) { int R, C; stage_rc(tid * 16 + i * 8192, R, C); const int Rb = Epi::PERM ? ((R & ~31) + perm32(R & 31)) : R;
        voffA[i] = (unsigned)(R * g.lda + C) * 2u; voffB[i] = (unsigned)(Rb * g.ldb + C) * 2u; }
    const size_t kstep = (size_t)(BK * 2);
    const size_t hstepA = (size_t)HALF * g.lda * 2, hstepB = (size_t)HALF * g.ldb * 2;
    const size_t tstepA = 2 * hstepA, tstepB = 2 * hstepB;
    const unsigned ldsw = (unsigned)wid * 1024u;
    const int aoff = lds_byte(wr * 64 + fr, fq * 8), boff = lds_byte(wc * 32 + fr, fq * 8);
#define PG8_SA(b, h) (((b) * 2 + (h)) * HTB)
#define PG8_SB(b, h) ((4 + (b) * 2 + (h)) * HTB)
#define PG8_STAGE(bufoff, gbase, voff) do { _Pragma("unroll") for (int _i = 0; _i < 2; ++_i) \
        __builtin_amdgcn_global_load_lds((const unsigned*)((const char*)(gbase) + (voff)[_i]), (PG8_LAS unsigned*)(lds + (bufoff) + ldsw + _i * 8192), 16, 0, 0); } while (0)
#define PG8_LDA(dst, b, h) do { _Pragma("unroll") for (int m = 0; m < 4; ++m) _Pragma("unroll") for (int k = 0; k < 2; ++k) dst[m][k] = *(const PG8_LAS bf16x8*)(lds + PG8_SA(b, h) + aoff + m * 2048 + k * 1024); } while (0)
#define PG8_LDB(dst, b, h) do { _Pragma("unroll") for (int n = 0; n < 2; ++n) _Pragma("unroll") for (int k = 0; k < 2; ++k) dst[n][k] = *(const PG8_LAS bf16x8*)(lds + PG8_SB(b, h) + boff + n * 2048 + k * 1024); } while (0)
#define PG8_MMA(ai, bj, At, Bt) do { __builtin_amdgcn_s_setprio(1); _Pragma("unroll") for (int m = 0; m < 4; ++m) _Pragma("unroll") for (int n = 0; n < 2; ++n) _Pragma("unroll") for (int k = 0; k < 2; ++k) \
        acc[ai][bj][m][n] = __builtin_amdgcn_mfma_f32_16x16x32_bf16(Bt[n][k], At[m][k], acc[ai][bj][m][n], 0, 0, 0); __builtin_amdgcn_s_setprio(0); } while (0)
#define PG8_WAIT_V(n) asm volatile("s_waitcnt vmcnt(" #n ")" ::: "memory")
#define PG8_WAIT_L(n) asm volatile("s_waitcnt lgkmcnt(" #n ")" ::: "memory")
#define PG8_BAR __builtin_amdgcn_s_barrier()
#define PG8_SCHED __builtin_amdgcn_sched_barrier(0)
    Unit cur, nxt; int ui = 0;
    if (!S.next(0, cur)) return;
    f32x4 acc[2][2][4][2];
#pragma unroll
    for (int a = 0; a < 2; ++a)
#pragma unroll
        for (int b = 0; b < 2; ++b)
#pragma unroll
            for (int m = 0; m < 4; ++m)
#pragma unroll
                for (int n = 0; n < 2; ++n) acc[a][b][m][n] = (f32x4){0.f, 0.f, 0.f, 0.f};
    bf16x8 At[4][2], B0[2][2], B1[2][2];
    const char* cA = (const char*)g.A + (size_t)cur.pm * tstepA; const char* cB = (const char*)g.Bt + (size_t)cur.pn * tstepB;
    S.a_ready(cur);
    if constexpr (SP2) {
        PG8_STAGE(PG8_SB(0, 0), cB, voffB); PG8_STAGE(PG8_SB(0, 1), cB + hstepB, voffB); PG8_STAGE(PG8_SA(0, 0), cA, voffA); PG8_STAGE(PG8_SA(0, 1), cA + hstepA, voffA);
        if (wr == 1) PG8_BAR;
        PG8_WAIT_V(2); PG8_BAR;
        PG8_STAGE(PG8_SB(1, 0), cB + kstep, voffB); PG8_STAGE(PG8_SA(1, 0), cA + kstep, voffA); PG8_STAGE(PG8_SB(1, 1), cB + hstepB + kstep, voffB);
        PG8_WAIT_V(6); PG8_BAR;
    } else {
        PG8_STAGE(PG8_SB(0, 0), cB, voffB); PG8_STAGE(PG8_SA(0, 0), cA, voffA); PG8_STAGE(PG8_SB(0, 1), cB + hstepB, voffB); PG8_STAGE(PG8_SA(0, 1), cA + hstepA, voffA);
        if (wr == 1) PG8_BAR;
        PG8_WAIT_V(4); PG8_BAR;
        PG8_STAGE(PG8_SB(1, 0), cB + kstep, voffB); PG8_STAGE(PG8_SA(1, 0), cA + kstep, voffA); PG8_STAGE(PG8_SB(1, 1), cB + hstepB + kstep, voffB);
        PG8_WAIT_V(6); PG8_BAR;
    }
    for (;;) {
        const bool has_next = S.next(ui + 1, nxt);
        const char* nA = has_next ? (const char*)g.A + (size_t)nxt.pm * tstepA : cA; const char* nB = has_next ? (const char*)g.Bt + (size_t)nxt.pn * tstepB : cB;
        for (int t = 0; t < nt; t += 2) {
            const bool last = (t == nt - 2);
            const char* a1 = cA + (size_t)(t + 1) * kstep;
            const char* a2 = last ? nA : cA + (size_t)(t + 2) * kstep; const char* b2 = last ? nB : cB + (size_t)(t + 2) * kstep;
            const char* a3 = a2 + kstep; const char* b3 = b2 + kstep;
            if (last && has_next) S.a_ready(nxt);
            if constexpr (SP2) {
            PG8_LDB(B0, 0, 0); PG8_LDB(B1, 0, 1); PG8_SCHED; PG8_LDA(At, 0, 0); PG8_STAGE(PG8_SA(1, 1), a1 + hstepA, voffA);
            PG8_WAIT_V(8); PG8_WAIT_L(0); PG8_BAR; PG8_MMA(0, 0, At, B0); PG8_MMA(0, 1, At, B1); PG8_BAR; PG8_SCHED;
            PG8_LDA(At, 0, 1); PG8_STAGE(PG8_SB(0, 0), b2, voffB); PG8_STAGE(PG8_SB(0, 1), b2 + hstepB, voffB); PG8_STAGE(PG8_SA(0, 0), a2, voffA);
            PG8_WAIT_V(8); PG8_WAIT_L(0); PG8_BAR; PG8_MMA(1, 0, At, B0); PG8_MMA(1, 1, At, B1); PG8_BAR; PG8_SCHED;
            PG8_LDB(B0, 1, 0); PG8_LDB(B1, 1, 1); PG8_SCHED; PG8_LDA(At, 1, 0); PG8_STAGE(PG8_SA(0, 1), a2 + hstepA, voffA);
            PG8_WAIT_V(8); PG8_WAIT_L(0); PG8_BAR; PG8_MMA(0, 0, At, B0); PG8_MMA(0, 1, At, B1); PG8_BAR; PG8_SCHED;
            PG8_LDA(At, 1, 1); PG8_STAGE(PG8_SB(1, 0), b3, voffB); PG8_STAGE(PG8_SB(1, 1), b3 + hstepB, voffB); PG8_STAGE(PG8_SA(1, 0), a3, voffA);
            PG8_WAIT_V(8); PG8_WAIT_L(0); PG8_BAR; PG8_MMA(1, 0, At, B0); PG8_MMA(1, 1, At, B1); PG8_BAR; PG8_SCHED;
            } else {
            PG8_LDB(B0, 0, 0); PG8_SCHED; PG8_LDA(At, 0, 0); PG8_STAGE(PG8_SA(1, 1), a1 + hstepA, voffA);
            PG8_WAIT_L(8); PG8_BAR; PG8_WAIT_L(0); PG8_MMA(0, 0, At, B0); PG8_BAR; PG8_SCHED;
            PG8_LDB(B1, 0, 1); PG8_STAGE(PG8_SB(0, 0), b2, voffB);
            PG8_BAR; PG8_WAIT_L(0); PG8_MMA(0, 1, At, B1); PG8_BAR;
            PG8_LDA(At, 0, 1); PG8_STAGE(PG8_SA(0, 0), a2, voffA);
            PG8_BAR; PG8_WAIT_L(0); PG8_MMA(1, 0, At, B0); PG8_BAR; PG8_SCHED;
            PG8_STAGE(PG8_SB(0, 1), b2 + hstepB, voffB);
            PG8_WAIT_V(6); PG8_BAR; PG8_MMA(1, 1, At, B1); PG8_BAR;
            PG8_LDB(B0, 1, 0); PG8_SCHED; PG8_LDA(At, 1, 0); PG8_STAGE(PG8_SA(0, 1), a2 + hstepA, voffA);
            PG8_WAIT_L(8); PG8_BAR; PG8_WAIT_L(0); PG8_MMA(0, 0, At, B0); PG8_BAR; PG8_SCHED;
            PG8_LDB(B1, 1, 1); PG8_STAGE(PG8_SB(1, 0), b3, voffB);
            PG8_BAR; PG8_WAIT_L(0); PG8_MMA(0, 1, At, B1); PG8_BAR;
            PG8_LDA(At, 1, 1); PG8_STAGE(PG8_SA(1, 0), a3, voffA);
            PG8_BAR; PG8_WAIT_L(0); PG8_MMA(1, 0, At, B0); PG8_BAR; PG8_SCHED;
            PG8_STAGE(PG8_SB(1, 1), b3 + hstepB, voffB);
            PG8_WAIT_V(6); PG8_BAR; PG8_MMA(1, 1, At, B1); PG8_BAR;
            }
        }
        if constexpr (ALIGN_EPI) { if (wr == 0) PG8_BAR; }
        if constexpr (!Epi::AFTER_DRAIN) { E(acc, cur, wr, wc, fr, fq); S.done(cur); }
        if (!has_next) break;
#pragma unroll
        for (int a = 0; a < 2; ++a)
#pragma unroll
            for (int b = 0; b < 2; ++b)
#pragma unroll
                for (int m = 0; m < 4; ++m)
#pragma unroll
                    for (int n = 0; n < 2; ++n) acc[a][b][m][n] = (f32x4){0.f, 0.f, 0.f, 0.f};
        cur = nxt; cA = nA; cB = nB; ++ui;
        if constexpr (ALIGN_EPI) { if (wr == 1) PG8_BAR; }
    }
    PG8_WAIT_V(0);
    if constexpr (!ALIGN_EPI) { if (wr == 0) PG8_BAR; }
    PG8_BAR;
    if constexpr (Epi::AFTER_DRAIN) { E.fused(acc, cur, wr, wc, fr, fq, lds, wid, lane); S.done(cur); }
#undef PG8_SA
#undef PG8_SB
#undef PG8_STAGE
#undef PG8_LDA
#undef PG8_LDB
#undef PG8_MMA
#undef PG8_WAIT_V
#undef PG8_WAIT_L
#undef PG8_BAR
#undef PG8_SCHED
}
}
#define GAS __attribute__((address_space(1)))
#define LAS __attribute__((address_space(3)))
typedef unsigned short bf16_t;
typedef unsigned u32x4 __attribute__((ext_vector_type(4)));
typedef unsigned u32x2 __attribute__((ext_vector_type(2)));
typedef float f32x4 __attribute__((ext_vector_type(4)));
typedef float f32x2 __attribute__((ext_vector_type(2)));

constexpr int D = 2048, NBATCH = 16, SEQ = 2048, DEPTH = 4, CTXL = 256;
constexpr int ML = NBATCH * SEQ, MC = NBATCH * CTXL, MT = ML + MC;
constexpr int NPROJ = 3840, DFF = 5632, NGU = 2 * DFF, MODW = 6 * D;
constexpr int OFF_AX = 0, OFF_AB = 512, OFF_AC = 1024, OFF_F = 1536, OFF_Q = 2048, OFF_K = 2560, OFF_V = 2688, OFF_U = 2816, OFF_MV = 3328;
constexpr float EPS = 1e-6f;
constexpr int NWAVES = 8, NTHREADS = 512;

constexpr size_t al256(size_t x) { return (x + 255) & ~(size_t)255; }
constexpr size_t WS_CTL = 0, CTL_ZERO_BYTES = 1u << 20;
constexpr size_t WS_WIN = CTL_ZERO_BYTES;
constexpr size_t WS_WOUT = WS_WIN + (size_t)DEPTH * NPROJ * D * 2;
constexpr size_t WS_WGU = WS_WOUT + (size_t)DEPTH * D * D * 2;
constexpr size_t WS_WDN = WS_WGU + (size_t)DEPTH * NGU * D * 2;
constexpr size_t WS_MOD = WS_WDN + (size_t)DEPTH * D * DFF * 2;
constexpr size_t WS_MODP = al256(WS_MOD + (size_t)DEPTH * 17 * MODW * 4);
constexpr size_t WS_XS = al256(WS_MODP + (size_t)DEPTH * 8 * 17 * MODW * 4);
constexpr size_t WS_H = WS_XS + (size_t)MT * D * 4;
constexpr size_t WS_P = WS_H + (size_t)MT * D * 2;
constexpr size_t WS_Y = WS_P + (size_t)MT * NPROJ * 2;
constexpr size_t WS_HF = WS_P;
constexpr size_t WS_TT = WS_Y + (size_t)MT * D * 2;
static_assert(WS_HF + (size_t)MT * DFF * 2 <= WS_TT, "hf overlay");
constexpr size_t WS_TTC = WS_TT + (size_t)NBATCH * 512 * 4096 * 2;
constexpr size_t WS_DFTN = WS_TTC + (size_t)NBATCH * 512 * 512 * 2;
constexpr size_t WS_DFTC = WS_DFTN + (size_t)2048 * 4096 * 2;
constexpr size_t WS_ROPE = WS_DFTC + (size_t)256 * 512 * 2;
constexpr size_t WS_CSBD = WS_ROPE + (size_t)2048 * 32 * 8;
constexpr size_t WS_DL = WS_CSBD + (size_t)1024 * 512 * 2;
constexpr size_t WS_END = WS_DL + (size_t)MT * D * 2;
constexpr int CW_BAR = 4096;

constexpr int LDS_BYTES = 147456;
constexpr int LDSCTL_OFF = 146432, MISC_OFF = LDSCTL_OFF;

#define LDS_WAIT() asm volatile("s_waitcnt lgkmcnt(0)" ::: "memory")
__device__ __forceinline__ float bf2f(unsigned b) { return __uint_as_float(b << 16); }
__device__ __forceinline__ unsigned f2bf(float f) { unsigned u = __float_as_uint(f); return (u + 0x7fffu + ((u >> 16) & 1u)) >> 16; }
__device__ __forceinline__ unsigned pk2(float lo, float hi) { return f2bf(lo) | (f2bf(hi) << 16); }
__device__ __forceinline__ void unpack8(const u32x4 w, float* o) {
    o[0] = __uint_as_float(w.x << 16); o[1] = __uint_as_float(w.x & 0xffff0000u); o[2] = __uint_as_float(w.y << 16); o[3] = __uint_as_float(w.y & 0xffff0000u);
    o[4] = __uint_as_float(w.z << 16); o[5] = __uint_as_float(w.z & 0xffff0000u); o[6] = __uint_as_float(w.w << 16); o[7] = __uint_as_float(w.w & 0xffff0000u);
}
__device__ __forceinline__ float wave_sum(float v) {
#pragma unroll
    for (int o = 1; o < 64; o <<= 1) v += __shfl_xor(v, o);
    return v;
}
__device__ __forceinline__ float gelu_tanh(float x) {
    const float u = 0.7978845608028654f * (x + 0.044715f * x * x * x);
    const float e = __expf(2.0f * u);
    const float t = 1.0f - 2.0f * __builtin_amdgcn_rcpf(1.0f + e);
    return 0.5f * x * (1.0f + t);
}
#define XB_TMO      128
#define XB_XCNT(j)  (256  + 64 * (j))
#define XB_XSUB(j)  (1280 + 64 * (j))
#define XB_XGEN(j)  (2304 + 64 * (j))
#define XB_TOP      3328
#define XB_TOPGEN   3392
#define XCD_BAR_WORDS 3456
#define XB_SPIN_CAP (1u << 18)

__device__ __forceinline__ unsigned xb_ld(unsigned* p)              { return __hip_atomic_load(p, __ATOMIC_RELAXED, __HIP_MEMORY_SCOPE_AGENT); }
__device__ __forceinline__ unsigned xb_add(unsigned* p, unsigned v) { return __hip_atomic_fetch_add(p, v, __ATOMIC_RELAXED, __HIP_MEMORY_SCOPE_AGENT); }
__device__ __forceinline__ unsigned xb_xcc_id() { return (unsigned)__builtin_amdgcn_s_getreg((3 << 11) | 20) & 0xFu; }
#define XB_SPIN(cond, bar) do { unsigned _sp = 0; while (cond) { __builtin_amdgcn_s_sleep(1); \
    if ((++_sp & 255u) == 0u) { if (xb_ld(&(bar)[XB_TMO])) break; if (_sp > XB_SPIN_CAP) { atomicAdd(&(bar)[XB_TMO], 1u); break; } } } } while (0)

struct XcdBarrier {
    unsigned* bar; unsigned x;
    volatile LAS unsigned* st;
};

__device__ __forceinline__ XcdBarrier xcd_barrier_post(unsigned* bar, volatile LAS unsigned* st) {
    XcdBarrier b; b.bar = bar; b.x = xb_xcc_id(); b.st = st;
    if (threadIdx.x == 0) (void)xb_add(&bar[XB_XCNT(b.x)], 1u);
    return b;
}
__device__ __forceinline__ void xcd_barrier_complete(unsigned* bar, unsigned x, unsigned& nloc, unsigned& nx) {
    const unsigned G = gridDim.x * gridDim.y * gridDim.z;
    unsigned sum, cnt, mine, sp = 0u;
    for (;;) {
        sum = 0u; cnt = 0u; mine = 0u;
#pragma unroll
        for (unsigned j = 0; j < 16; ++j) { const unsigned c = xb_ld(&bar[XB_XCNT(j)]); sum += c; cnt += (c > 0u) ? 1u : 0u; mine = (j == x) ? c : mine; }
        if (sum == G) break;
        __builtin_amdgcn_s_sleep(1);
        if ((++sp & 255u) == 0u) { if (xb_ld(&bar[XB_TMO])) break; if (sp > XB_SPIN_CAP) { atomicAdd(&bar[XB_TMO], 1u); break; } }
    }
    nloc = mine > 0u ? mine : 1u; nx = cnt > 0u ? cnt : 1u;
}

__device__ __forceinline__ void xcd_barrier(const XcdBarrier& b) {
    asm volatile("s_waitcnt vmcnt(0)" ::: "memory");
    __syncthreads();
    if (threadIdx.x == 0) {
        unsigned* bar = b.bar;
        __builtin_amdgcn_s_waitcnt(0);
        unsigned nloc = b.st[0], nx = b.st[1];
        if (nloc == 0u) { xcd_barrier_complete(bar, b.x, nloc, nx); b.st[0] = nloc; b.st[1] = nx; }
        const unsigned old = xb_add(&bar[XB_XSUB(b.x)], 1u);
        const unsigned gen = old / nloc;
        if (old + 1u == (gen + 1u) * nloc) {
            __builtin_amdgcn_fence(__ATOMIC_RELEASE, "agent");
            asm volatile("s_waitcnt vmcnt(0)" ::: "memory");
            const unsigned og = xb_add(&bar[XB_TOP], 1u);
            const unsigned tg = og / nx;
            if (og + 1u == (tg + 1u) * nx) xb_add(&bar[XB_TOPGEN], 1u);
            else XB_SPIN(xb_ld(&bar[XB_TOPGEN]) == tg, bar);
            __builtin_amdgcn_fence(__ATOMIC_ACQUIRE, "agent");
            xb_add(&bar[XB_XGEN(b.x)], 1u);
            asm volatile("s_waitcnt vmcnt(0)" ::: "memory");
        } else {
            XB_SPIN(xb_ld(&bar[XB_XGEN(b.x)]) == gen, bar);
            __builtin_amdgcn_fence(__ATOMIC_ACQUIRE, "agent");
            asm volatile("s_waitcnt vmcnt(0)" ::: "memory");
        }
    }
    __syncthreads();
}
__device__ __forceinline__ void tr_item(const float* __restrict__ W, int K, int N, bf16_t* __restrict__ WT, int k0, int n0, int drow0, LAS float* scr, int lane) {
#pragma unroll 8
    for (int i = 0; i < 32; ++i) { const int kk = 2 * i + (lane >> 5); scr[kk * 33 + (lane & 31)] = W[(size_t)(k0 + kk) * N + n0 + (lane & 31)]; }
    LDS_WAIT(); asm volatile("" ::: "memory");
    const int c = lane & 7;
#pragma unroll
    for (int j = 0; j < 4; ++j) { const int n = (lane >> 3) + 8 * j; const LAS float* s = scr + (8 * c) * 33 + n;
        u32x4 o; o.x = pk2(s[0 * 33], s[1 * 33]); o.y = pk2(s[2 * 33], s[3 * 33]); o.z = pk2(s[4 * 33], s[5 * 33]); o.w = pk2(s[6 * 33], s[7 * 33]);
        *(u32x4*)(WT + (size_t)(drow0 + n) * K + k0 + 8 * c) = o; }
    LDS_WAIT(); asm volatile("" ::: "memory");
}
constexpr int TR_IN = 32 * 120, TR_OUT = 32 * 64, TR_G = 32 * 176, TR_DN = 88 * 64, TR_LAYER = TR_IN + TR_OUT + 2 * TR_G + TR_DN;
__device__ __forceinline__ void p0_transposes(const float* w_in, const float* w_out, const float* w_gate, const float* w_up, const float* w_down,
                                              bf16_t* WIN, bf16_t* WOUT, bf16_t* WGU, bf16_t* WDN, LAS float* scr, int gw, int NGW, int lane) {
    for (int it = gw; it < DEPTH * TR_LAYER; it += NGW) {
        const int l = it / TR_LAYER; int r = it % TR_LAYER;
        if (r < TR_IN) { const int kb = r / 120, nb = r % 120; tr_item(w_in + (size_t)l * D * NPROJ, D, NPROJ, WIN + (size_t)l * NPROJ * D, kb * 64, nb * 32, nb * 32, scr, lane); continue; } r -= TR_IN;
        if (r < TR_OUT) { const int kb = r / 64, nb = r % 64; tr_item(w_out + (size_t)l * D * D, D, D, WOUT + (size_t)l * D * D, kb * 64, nb * 32, nb * 32, scr, lane); continue; } r -= TR_OUT;
        if (r < TR_G) { const int kb = r / 176, nb = r % 176, n0 = nb * 32; tr_item(w_gate + (size_t)l * D * DFF, D, DFF, WGU + (size_t)l * NGU * D, kb * 64, n0, (n0 >> 7) * 256 + (n0 & 127), scr, lane); continue; } r -= TR_G;
        if (r < TR_G) { const int kb = r / 176, nb = r % 176, n0 = nb * 32; tr_item(w_up + (size_t)l * D * DFF, D, DFF, WGU + (size_t)l * NGU * D, kb * 64, n0, (n0 >> 7) * 256 + 128 + (n0 & 127), scr, lane); continue; } r -= TR_G;
        { const int kb = r / 64, nb = r % 64; tr_item(w_down + (size_t)l * DFF * D, DFF, D, WDN + (size_t)l * D * DFF, kb * 64, nb * 32, nb * 32, scr, lane); }
    }
}
__device__ __forceinline__ void p0_modp(const float* __restrict__ c, const float* __restrict__ c_ctx, const float* __restrict__ w_ada, float* __restrict__ modp, LAS float* scr  , int gw, int NGW, int lane) {
    for (int it = gw; it < DEPTH * 48 * 8; it += NGW) {
        const int l = it / 384, rem = it % 384, cc = rem >> 3, ks = rem & 7, k0 = ks * 256;
#pragma unroll
        for (int r = 0; r < 17; ++r)
#pragma unroll
            for (int j = 0; j < 4; ++j) { const int idx = j * 64 + lane; const float v = (r < 16) ? c[r * D + k0 + idx] : c_ctx[k0 + idx]; scr[r * 256 + idx] = v * (1.0f / (1.0f + __expf(-v))); }
        LDS_WAIT(); asm volatile("" ::: "memory");
        f32x4 acc[17];
#pragma unroll
        for (int r = 0; r < 17; ++r) acc[r] = (f32x4){0.f, 0.f, 0.f, 0.f};
        const float* wp = w_ada + ((size_t)l * D + k0) * MODW + cc * 256 + lane * 4;
#pragma unroll 2
        for (int k4 = 0; k4 < 64; ++k4) {
            const f32x4 w0 = *(const f32x4*)(wp + (size_t)(4 * k4 + 0) * MODW), w1 = *(const f32x4*)(wp + (size_t)(4 * k4 + 1) * MODW);
            const f32x4 w2 = *(const f32x4*)(wp + (size_t)(4 * k4 + 2) * MODW), w3 = *(const f32x4*)(wp + (size_t)(4 * k4 + 3) * MODW);
#pragma unroll
            for (int r = 0; r < 17; ++r) { const f32x4 s = *(const LAS f32x4*)(scr + r * 256 + 4 * k4); acc[r] = acc[r] + w0 * s.x + w1 * s.y + w2 * s.z + w3 * s.w; }
        }
#pragma unroll
        for (int r = 0; r < 17; ++r) *(f32x4*)(modp + ((size_t)((l * 8 + ks) * 17 + r)) * MODW + cc * 256 + lane * 4) = acc[r];
        LDS_WAIT(); asm volatile("" ::: "memory");
    }
}
__device__ __forceinline__ void p0_tables(bf16_t* DFTN, bf16_t* DFTC, bf16_t* CSBD, f32x2* ROPE, size_t gtid, size_t NT) {
    for (size_t i = gtid; i < (size_t)1024 * 512 / 8; i += NT) {
        const int r = (int)(i >> 6), c0 = (int)(i & 63) * 8, g = r >> 8, t = (r >> 7) & 1, m = r & 127; float v[8];
#pragma unroll
        for (int e = 0; e < 8; ++e) { const int cp = c0 + e, c = cp & 127, j = (m * c) & 127; const float x = (float)j * (1.0f / 64.0f); v[e] = (cp >> 7) == g ? (t == 0 ? cospif(x) : sinpif(x)) : 0.f; }
        u32x4 o; o.x = pk2(v[0], v[1]); o.y = pk2(v[2], v[3]); o.z = pk2(v[4], v[5]); o.w = pk2(v[6], v[7]);
        *(u32x4*)(CSBD + i * 8) = o;
    }
    for (size_t i = gtid; i < (size_t)2048 * 4096 / 8; i += NT) {
        const int k = (int)(i >> 9), n0 = (int)(i & 511) * 8; float v[8];
#pragma unroll
        for (int e = 0; e < 8; ++e) { const int np = n0 + e, n = np & 2047, j = (k * n) & 2047; const float x = (float)j * (1.0f / 1024.0f); v[e] = np < 2048 ? cospif(x) : -sinpif(x); }
        u32x4 o; o.x = pk2(v[0], v[1]); o.y = pk2(v[2], v[3]); o.z = pk2(v[4], v[5]); o.w = pk2(v[6], v[7]);
        *(u32x4*)(DFTN + i * 8) = o;
    }
    for (size_t i = gtid; i < (size_t)256 * 512 / 8; i += NT) {
        const int k = (int)(i >> 6), n0 = (int)(i & 63) * 8; float v[8];
#pragma unroll
        for (int e = 0; e < 8; ++e) { const int np = n0 + e, n = np & 255, j = (k * n) & 255; const float x = (float)j * (1.0f / 128.0f); v[e] = np < 256 ? cospif(x) : -sinpif(x); }
        u32x4 o; o.x = pk2(v[0], v[1]); o.y = pk2(v[2], v[3]); o.z = pk2(v[4], v[5]); o.w = pk2(v[6], v[7]);
        *(u32x4*)(DFTC + i * 8) = o;
    }
    for (size_t i = gtid; i < (size_t)2048 * 32; i += NT) {
        const int pos = (int)(i >> 5), ii = (int)(i & 31), half = ii >> 4, fi = ii & 15;
        const float inv = exp2f(-(float)fi * (13.287712379549449f / 16.0f));
        const float ang = (float)(half ? (pos & 63) : (pos >> 6)) * inv;
        const float xr = ang * 0.3183098861837907f;
        ROPE[i] = (f32x2){cospif(xr), sinpif(xr)};
    }
}
__device__ __forceinline__ void p1_mod(const float* __restrict__ modp, const float* __restrict__ b_ada, float* __restrict__ mod, size_t gtid, size_t NT) {
    for (size_t i = gtid; i < (size_t)DEPTH * 17 * MODW; i += NT) {
        const int l = (int)(i / (17 * MODW)), rn = (int)(i % (17 * MODW)), n = rn % MODW;
        float s = b_ada[l * MODW + n];
#pragma unroll
        for (int ks = 0; ks < 8; ++ks) s += modp[(size_t)(l * 8 + ks) * 17 * MODW + rn];
        mod[i] = s;
    }
}
template <bool HAS_DELTA, bool WRITE_X>
__device__ __forceinline__ void resnorm_rows(const float* __restrict__ xlat, const float* __restrict__ xctx, const bf16_t* __restrict__ DL, float* __restrict__ xout, const float* __restrict__ gvec,
                                             const float* __restrict__ modl, int shoff, int scoff, bf16_t* __restrict__ H, int nrows, int gw, int NGW, int lane) {
    const int rpw = (nrows + NGW - 1) / NGW, r0 = gw * rpw, r1 = (r0 + rpw < nrows) ? r0 + rpw : nrows;
    int bcur = -1; f32x4 gm[8], sh[8];
    for (int row = r0; row < r1; ) {
        const int b = row < ML ? (row >> 11) : 16, bn = (row + 1) < ML ? ((row + 1) >> 11) : 16;
        const bool two = (row + 1 < r1) && (bn == b) && ((row + 1 == ML) == false);
        if (b != bcur) { bcur = b; const float* mrow = modl + (size_t)b * MODW;
#pragma unroll
            for (int j = 0; j < 8; ++j) { const int col = 4 * lane + 256 * j; gm[j] = *(const f32x4*)(gvec + col) * (*(const f32x4*)(mrow + scoff + col) + 1.0f); sh[j] = *(const f32x4*)(mrow + shoff + col); } }
        const float* xa = (row < ML ? xlat + (size_t)row * D : xctx + (size_t)(row - ML) * D) + 4 * lane;
        const float* xb = two ? xa + D : xa;
        f32x4 va[8], vb[8];
#pragma unroll
        for (int j = 0; j < 8; ++j) { va[j] = *(const f32x4*)(xa + 256 * j); vb[j] = *(const f32x4*)(xb + 256 * j); }
        if (HAS_DELTA) { const bf16_t* da = DL + (size_t)row * D + 4 * lane; const bf16_t* db = two ? da + D : da; u32x2 wa[8], wb[8];
#pragma unroll
            for (int j = 0; j < 8; ++j) { wa[j] = *(const u32x2*)(da + 256 * j); wb[j] = *(const u32x2*)(db + 256 * j); }
#pragma unroll
            for (int j = 0; j < 8; ++j) { va[j] = va[j] + (f32x4){__uint_as_float(wa[j].x << 16), __uint_as_float(wa[j].x & 0xffff0000u), __uint_as_float(wa[j].y << 16), __uint_as_float(wa[j].y & 0xffff0000u)};
                                          vb[j] = vb[j] + (f32x4){__uint_as_float(wb[j].x << 16), __uint_as_float(wb[j].x & 0xffff0000u), __uint_as_float(wb[j].y << 16), __uint_as_float(wb[j].y & 0xffff0000u)}; } }
        float sa = 0.f, sb = 0.f;
#pragma unroll
        for (int j = 0; j < 8; ++j) { sa += (va[j].x * va[j].x + va[j].y * va[j].y) + (va[j].z * va[j].z + va[j].w * va[j].w); sb += (vb[j].x * vb[j].x + vb[j].y * vb[j].y) + (vb[j].z * vb[j].z + vb[j].w * vb[j].w); }
#pragma unroll
        for (int o = 1; o < 64; o <<= 1) { sa += __shfl_xor(sa, o); sb += __shfl_xor(sb, o); }
        const float ra = 1.0f / sqrtf(sa * (1.0f / D) + EPS), rb = 1.0f / sqrtf(sb * (1.0f / D) + EPS);
        if (WRITE_X) { float* oa = xout + (size_t)row * D + 4 * lane;
#pragma unroll
            for (int j = 0; j < 8; ++j) { *(f32x4*)(oa + 256 * j) = va[j]; if (two) *(f32x4*)(oa + D + 256 * j) = vb[j]; } }
        bf16_t* ha = H + (size_t)row * D + 4 * lane;
#pragma unroll
        for (int j = 0; j < 8; ++j) { const f32x4 oa = (va[j] * ra) * gm[j] + sh[j], ob = (vb[j] * rb) * gm[j] + sh[j];
            u32x2 w; w.x = pk2(oa.x, oa.y); w.y = pk2(oa.z, oa.w); *(u32x2*)(ha + 256 * j) = w;
            if (two) { u32x2 w2; w2.x = pk2(ob.x, ob.y); w2.y = pk2(ob.z, ob.w); *(u32x2*)(ha + D + 256 * j) = w2; } }
        row += two ? 2 : 1;
    }
}
__device__ __forceinline__ void final_rows(const float* __restrict__ xs, const bf16_t* __restrict__ DL, const float* __restrict__ gvec, float* __restrict__ out, int gw, int NGW, int lane) {
    const int rpw = (ML + NGW - 1) / NGW, r0 = gw * rpw, r1 = (r0 + rpw < ML) ? r0 + rpw : ML;
    f32x4 g4[8];
#pragma unroll
    for (int j = 0; j < 8; ++j) g4[j] = *(const f32x4*)(gvec + 4 * lane + 256 * j);
    for (int row = r0; row < r1; ++row) {
        const float* xa = xs + (size_t)row * D + 4 * lane; const bf16_t* da = DL + (size_t)row * D + 4 * lane;
        f32x4 v[8]; u32x2 w[8]; float ss = 0.f;
#pragma unroll
        for (int j = 0; j < 8; ++j) { v[j] = *(const f32x4*)(xa + 256 * j); w[j] = *(const u32x2*)(da + 256 * j); }
#pragma unroll
        for (int j = 0; j < 8; ++j) { v[j] = v[j] + (f32x4){__uint_as_float(w[j].x << 16), __uint_as_float(w[j].x & 0xffff0000u), __uint_as_float(w[j].y << 16), __uint_as_float(w[j].y & 0xffff0000u)};
            ss += (v[j].x * v[j].x + v[j].y * v[j].y) + (v[j].z * v[j].z + v[j].w * v[j].w); }
        const float rstd = 1.0f / sqrtf(wave_sum(ss) * (1.0f / D) + EPS);
#pragma unroll
        for (int j = 0; j < 8; ++j) *(f32x4*)(out + (size_t)row * D + 4 * lane + 256 * j) = (v[j] * rstd) * g4[j];
    }
}
__device__ __forceinline__ void mix_conv(const bf16_t* __restrict__ P, const float* __restrict__ wc  , bf16_t* __restrict__ Y, int nrows, size_t gtid, size_t NT) {
    for (size_t it = gtid; it < (size_t)nrows * 64; it += NT) {
        const int row = (int)(it >> 6), c0 = (int)(it & 63) * 8;
        int n, L; if (row < ML) { n = row & 2047; L = 2048; } else { n = (row - ML) & 255; L = 256; }
        const bf16_t* pr = P + (size_t)row * NPROJ;
        float xc[8], gc[8], gb[8], zp[8], zn[8], t0[8], t1[8];
        unpack8(*(const u32x4*)(pr + OFF_AX + c0), xc); unpack8(*(const u32x4*)(pr + OFF_AC + c0), gc); unpack8(*(const u32x4*)(pr + OFF_AB + c0), gb);
        if (n > 0) { unpack8(*(const u32x4*)(pr - NPROJ + OFF_AX + c0), t0); unpack8(*(const u32x4*)(pr - NPROJ + OFF_AC + c0), t1);
#pragma unroll
            for (int e = 0; e < 8; ++e) zp[e] = t0[e] * t1[e]; }
        else {
#pragma unroll
            for (int e = 0; e < 8; ++e) zp[e] = 0.f; }
        if (n < L - 1) { unpack8(*(const u32x4*)(pr + NPROJ + OFF_AX + c0), t0); unpack8(*(const u32x4*)(pr + NPROJ + OFF_AC + c0), t1);
#pragma unroll
            for (int e = 0; e < 8; ++e) zn[e] = t0[e] * t1[e]; }
        else {
#pragma unroll
            for (int e = 0; e < 8; ++e) zn[e] = 0.f; }
        float o[8];
#pragma unroll
        for (int e = 0; e < 8; ++e) o[e] = gb[e] * (zp[e] * wc[c0 + e] + (gc[e] * xc[e]) * wc[512 + c0 + e] + zn[e] * wc[1024 + c0 + e]);
        u32x4 w; w.x = pk2(o[0], o[1]); w.y = pk2(o[2], o[3]); w.z = pk2(o[4], o[5]); w.w = pk2(o[6], o[7]);
        *(u32x4*)(Y + (size_t)row * D + c0) = w;
    }
}
typedef short bf16x8_t __attribute__((ext_vector_type(8)));
typedef short bf16x4_t __attribute__((ext_vector_type(4)));
constexpr int ATT_KS = 0, ATT_VT = 9216, ATT_LD = 72;
__device__ __forceinline__ void attn_item(const bf16_t* __restrict__ P, bf16_t* __restrict__ Y, const f32x2* __restrict__ rope, const float* __restrict__ sinkl, int b, int kvh, int qb, bool isctx, LAS unsigned char* lds, int tid) {
    LAS bf16_t* Ks = (LAS bf16_t*)(lds + ATT_KS); LAS bf16_t* Vt = (LAS bf16_t*)(lds + ATT_VT);
    const int lane = tid & 63, wave = __builtin_amdgcn_readfirstlane(tid >> 6), fr = lane & 15, fq = lane >> 4;
    const int g = wave >> 1, h = kvh * 4 + g, p0 = qb * 128 + (wave & 1) * 64;
    const float L2E = 1.4426950408889634f, QS = 0.125f * L2E;
    bf16x8_t Qf[4][2];
#pragma unroll
    for (int qblk = 0; qblk < 4; ++qblk) {
        const int qpos = p0 + qblk * 16 + fr;
        const size_t rowq = isctx ? (size_t)ML + b * 256 + qpos : (size_t)b * 2048 + qpos;
        const bf16_t* qp = P + rowq * NPROJ + OFF_Q + h * 64;
#pragma unroll
        for (int s = 0; s < 2; ++s) {
            if (isctx) Qf[qblk][s] = *(const bf16x8_t*)(qp + 32 * s + 8 * fq);
            else { const int which = fq >> 1, sub = fq & 1; float t1[8], t2[8];
                unpack8(*(const u32x4*)(qp + 32 * s + 8 * sub), t1); unpack8(*(const u32x4*)(qp + 32 * s + 16 + 8 * sub), t2);
                float o[8];
#pragma unroll
                for (int i = 0; i < 8; ++i) { const f32x2 cs = rope[qpos * 32 + s * 16 + sub * 8 + i]; o[i] = which == 0 ? (t1[i] * cs.x - t2[i] * cs.y) : (t2[i] * cs.x + t1[i] * cs.y); }
                u32x4 w; w.x = pk2(o[0], o[1]); w.y = pk2(o[2], o[3]); w.z = pk2(o[4], o[5]); w.w = pk2(o[6], o[7]);
                Qf[qblk][s] = __builtin_bit_cast(bf16x8_t, w); }
        }
    }
    f32x4 O[4][4]; float mrun[4], lsum[4];
    const float sk = sinkl[h] * L2E;
#pragma unroll
    for (int qblk = 0; qblk < 4; ++qblk) { mrun[qblk] = sk; lsum[qblk] = fq == 0 ? 1.0f : 0.0f;
#pragma unroll
        for (int db = 0; db < 4; ++db) O[qblk][db] = (f32x4){0.f, 0.f, 0.f, 0.f}; }
    const int ntiles = isctx ? 4 : 10;
#pragma unroll 1
    for (int t = 0; t < ntiles; ++t) {
        bool local; int k0;
        if (isctx) { local = false; k0 = t * 64; } else if (t < 6) { local = true; k0 = (qb - 1) * 128 + t * 64; } else { local = false; k0 = (t - 6) * 64; }
        if (local && (k0 < 0 || k0 >= 2048)) continue;
        __syncthreads();
        { const int j = tid >> 3, part = tid & 7, half = part >> 2, which = (part >> 1) & 1, sub = part & 1;
          const size_t rowk = local ? (size_t)b * 2048 + k0 + j : (size_t)ML + b * 256 + k0 + j;
          const bf16_t* kp = P + rowk * NPROJ + OFF_K + kvh * 64; const bf16_t* vp = P + rowk * NPROJ + OFF_V + kvh * 64 + part * 8;
          const u32x4 vraw = *(const u32x4*)vp;
          u32x4 kw;
          if (local) { float t1[8], t2[8], ko[8]; const int kpos = k0 + j;
              unpack8(*(const u32x4*)(kp + half * 32 + sub * 8), t1); unpack8(*(const u32x4*)(kp + half * 32 + 16 + sub * 8), t2);
#pragma unroll
              for (int i = 0; i < 8; ++i) { const f32x2 cs = rope[kpos * 32 + half * 16 + sub * 8 + i]; ko[i] = which == 0 ? (t1[i] * cs.x - t2[i] * cs.y) : (t2[i] * cs.x + t1[i] * cs.y); }
              kw.x = pk2(ko[0], ko[1]); kw.y = pk2(ko[2], ko[3]); kw.z = pk2(ko[4], ko[5]); kw.w = pk2(ko[6], ko[7]); }
          else kw = *(const u32x4*)(kp + part * 8);
          *(LAS u32x4*)(Ks + j * ATT_LD + part * 8) = kw;
          const unsigned vw[4] = {vraw.x, vraw.y, vraw.z, vraw.w};
#pragma unroll
          for (int i = 0; i < 4; ++i) { Vt[(part * 8 + 2 * i) * ATT_LD + j] = (bf16_t)(vw[i] & 0xffffu); Vt[(part * 8 + 2 * i + 1) * ATT_LD + j] = (bf16_t)(vw[i] >> 16); }
        }
        __syncthreads();
#pragma unroll 1
        for (int kb = 0; kb < 64; kb += 32) {
            const int kmin = k0 + kb;
            if (local && (kmin + 31 < p0 - 128 || kmin > p0 + 63 + 128)) continue;
            bf16x8_t Kf[2][2];
#pragma unroll
            for (int blk = 0; blk < 2; ++blk)
#pragma unroll
                for (int s = 0; s < 2; ++s) Kf[blk][s] = *(const LAS bf16x8_t*)(Ks + (kb + 16 * blk + fr) * ATT_LD + 32 * s + 8 * fq);
            bf16x8_t Vf[4];
#pragma unroll
            for (int db = 0; db < 4; ++db) { const LAS bf16_t* vp = Vt + (16 * db + fr) * ATT_LD + kb + 4 * fq;
                const bf16x4_t lo = *(const LAS bf16x4_t*)vp, hi = *(const LAS bf16x4_t*)(vp + 16);
                Vf[db] = __builtin_shufflevector(lo, hi, 0, 1, 2, 3, 4, 5, 6, 7); }
#pragma unroll
            for (int qblk = 0; qblk < 4; ++qblk) {
                f32x4 S0 = (f32x4){0.f, 0.f, 0.f, 0.f}, S1 = S0;
                S0 = __builtin_amdgcn_mfma_f32_16x16x32_bf16(Kf[0][0], Qf[qblk][0], S0, 0, 0, 0); S0 = __builtin_amdgcn_mfma_f32_16x16x32_bf16(Kf[0][1], Qf[qblk][1], S0, 0, 0, 0);
                S1 = __builtin_amdgcn_mfma_f32_16x16x32_bf16(Kf[1][0], Qf[qblk][0], S1, 0, 0, 0); S1 = __builtin_amdgcn_mfma_f32_16x16x32_bf16(Kf[1][1], Qf[qblk][1], S1, 0, 0, 0);
                float sv[8]; bool valid[8];
                const int qpos = p0 + qblk * 16 + fr;
#pragma unroll
                for (int r = 0; r < 4; ++r) { sv[r] = S0[r] * QS; sv[4 + r] = S1[r] * QS;
                    int d0 = qpos - (kmin + 4 * fq + r); d0 = d0 < 0 ? -d0 : d0; int d1 = qpos - (kmin + 16 + 4 * fq + r); d1 = d1 < 0 ? -d1 : d1;
                    valid[r] = !local || d0 <= 128; valid[4 + r] = !local || d1 <= 128; }
                float cm = -3.0e38f;
#pragma unroll
                for (int r = 0; r < 8; ++r) cm = fmaxf(cm, valid[r] ? sv[r] : -3.0e38f);
                cm = fmaxf(cm, __shfl_xor(cm, 16)); cm = fmaxf(cm, __shfl_xor(cm, 32));
                const float mnew = fmaxf(mrun[qblk], cm), sc = exp2f(mrun[qblk] - mnew);
                float pp[8], ps = 0.f;
#pragma unroll
                for (int r = 0; r < 8; ++r) { pp[r] = valid[r] ? exp2f(sv[r] - mnew) : 0.f; ps += pp[r]; }
                lsum[qblk] = lsum[qblk] * sc + ps; mrun[qblk] = mnew;
                u32x4 pw; pw.x = pk2(pp[0], pp[1]); pw.y = pk2(pp[2], pp[3]); pw.z = pk2(pp[4], pp[5]); pw.w = pk2(pp[6], pp[7]);
                const bf16x8_t Pf = __builtin_bit_cast(bf16x8_t, pw);
#pragma unroll
                for (int db = 0; db < 4; ++db) { O[qblk][db] = O[qblk][db] * sc; O[qblk][db] = __builtin_amdgcn_mfma_f32_16x16x32_bf16(Vf[db], Pf, O[qblk][db], 0, 0, 0); }
            }
        }
    }
#pragma unroll
    for (int qblk = 0; qblk < 4; ++qblk) {
        float l = lsum[qblk]; l += __shfl_xor(l, 16); l += __shfl_xor(l, 32);
        const float rl = 1.0f / l;
        const int qpos = p0 + qblk * 16 + fr;
        const size_t rowq = isctx ? (size_t)ML + b * 256 + qpos : (size_t)b * 2048 + qpos;
        bf16_t* yp = Y + rowq * D + 1024 + h * 64 + 4 * fq;
#pragma unroll
        for (int db = 0; db < 4; ++db) { const f32x4 o = O[qblk][db] * rl; u32x2 w; w.x = pk2(o[0], o[1]); w.y = pk2(o[2], o[3]); *(u32x2*)(yp + 16 * db) = w; }
    }
}
__device__ __forceinline__ void mix_attn(const bf16_t* P, bf16_t* Y, const f32x2* rope, const float* sinkl, int nitems, LAS unsigned char* lds, int vcu, int G, int tid) {
    for (int it = vcu; it < nitems; it += G) {
        if (it < 512) { const int b = it >> 5, kvh = (it >> 4) & 1, qb = it & 15; attn_item(P, Y, rope, sinkl, b, kvh, qb, false, lds, tid); }
        else { const int r = it - 512, b = r >> 2, kvh = (r >> 1) & 1, qb = r & 1; attn_item(P, Y, rope, sinkl, b, kvh, qb, true, lds, tid); }
    }
    __syncthreads();
}
__device__ __forceinline__ void mix_mlp(const bf16_t* __restrict__ P, const float* __restrict__ w_s  , const float* __restrict__ b_s  , bf16_t* __restrict__ Y, int nrows, LAS unsigned char* lds, int vcu, int G, int tid) {
    LAS float* vn = (LAS float*)lds; LAS float* wsm = vn + 128 * 128;
    for (int it = vcu; it < (nrows / 128) * 4; it += G) {
        const int ch = it >> 2, g = it & 3; const size_t row0 = (size_t)ch * 128;
        __syncthreads();
        for (int i = tid; i < 128 * 128; i += NTHREADS) wsm[(i >> 7) * 129 + (i & 127)] = w_s[g * 16384 + i];
        const int p = tid >> 2, cp = tid & 3;
        const bf16_t* pr = P + (row0 + p) * NPROJ;
        { float vv[32];
#pragma unroll
          for (int j = 0; j < 4; ++j) unpack8(*(const u32x4*)(pr + OFF_MV + g * 128 + cp * 32 + 8 * j), vv + 8 * j);
          float s = 0.f;
#pragma unroll
          for (int i = 0; i < 32; ++i) { vv[i] = gelu_tanh(vv[i]); s += vv[i]; }
          s += __shfl_xor(s, 1); s += __shfl_xor(s, 2);
          const float mean = s * (1.0f / 128.0f); float qq = 0.f;
#pragma unroll
          for (int i = 0; i < 32; ++i) { vv[i] -= mean; qq += vv[i] * vv[i]; }
          qq += __shfl_xor(qq, 1); qq += __shfl_xor(qq, 2);
          const float rstd = 1.0f / sqrtf(qq * (1.0f / 128.0f) + EPS);
#pragma unroll
          for (int i = 0; i < 32; i += 4) *(LAS f32x4*)(vn + p * 128 + cp * 32 + i) = (f32x4){vv[i] * rstd, vv[i + 1] * rstd, vv[i + 2] * rstd, vv[i + 3] * rstd}; }
        __syncthreads();
        float acc[32];
#pragma unroll
        for (int i = 0; i < 32; ++i) acc[i] = 0.f;
        for (int qi = 0; qi < 128; ++qi) { const float w = wsm[p * 129 + qi];
#pragma unroll
            for (int i = 0; i < 32; i += 4) { const f32x4 x = *(const LAS f32x4*)(vn + qi * 128 + cp * 32 + i); acc[i] += w * x.x; acc[i + 1] += w * x.y; acc[i + 2] += w * x.z; acc[i + 3] += w * x.w; } }
        const float bias = b_s[g * 128 + p];
        float uu[32];
#pragma unroll
        for (int j = 0; j < 4; ++j) unpack8(*(const u32x4*)(pr + OFF_U + g * 128 + cp * 32 + 8 * j), uu + 8 * j);
        bf16_t* yp = Y + (row0 + p) * D + 1536 + g * 128 + cp * 32;
#pragma unroll
        for (int i = 0; i < 32; i += 8) { float o[8];
#pragma unroll
            for (int e = 0; e < 8; ++e) o[e] = gelu_tanh(uu[i + e]) * (acc[i + e] + bias);
            u32x4 w; w.x = pk2(o[0], o[1]); w.y = pk2(o[2], o[3]); w.z = pk2(o[4], o[5]); w.w = pk2(o[6], o[7]);
            *(u32x4*)(yp + i) = w; }
    }
    __syncthreads();
}
constexpr int PH_LAYER0 = 2, PH_PER_LAYER = 8, PH_FINAL = PH_LAYER0 + DEPTH * PH_PER_LAYER, NPH = PH_FINAL + 1;
#ifndef PROBE_DUP
#define PROBE_DUP 0
#endif
#ifndef MK_ONE_LAUNCH
#define MK_ONE_LAUNCH 1
#endif
struct Args { const float* in[18]; float* out; unsigned char* ws; int ph_lo, ph_hi, use_bar, pad; };
__global__ void __launch_bounds__(NTHREADS, 2) fwd(Args a) {
    extern __shared__ __attribute__((aligned(16))) unsigned char lds_raw[];
    LAS unsigned char* lds = (LAS unsigned char*)lds_raw;
    volatile LAS unsigned* MISC = (volatile LAS unsigned*)(lds + MISC_OFF);
    const int G = gridDim.x, bx = blockIdx.x, vcu = (G % 8 == 0) ? (bx % 8) * (G / 8) + bx / 8 : bx;
    const int NGW = G * NWAVES; const size_t NT = (size_t)G * NTHREADS;
#define TID_VARS int tid = threadIdx.x; asm volatile("" : "+v"(tid)); const int lane = tid & 63, wave = __builtin_amdgcn_readfirstlane(tid >> 6), gw = vcu * NWAVES + wave; const size_t gtid = (size_t)vcu * NTHREADS + tid; (void)lane; (void)gw; (void)gtid
    unsigned char* ws = a.ws;
    unsigned* ctl = (unsigned*)(ws + WS_CTL);
    for (int u = threadIdx.x; u < (LDS_BYTES - LDSCTL_OFF) / 4; u += NTHREADS) ((LAS unsigned*)(lds + LDSCTL_OFF))[u] = 0u;
    __syncthreads();
    XcdBarrier bar; bar.bar = ctl + CW_BAR; bar.x = 0; bar.st = nullptr;
    if (a.use_bar) bar = xcd_barrier_post(ctl + CW_BAR, MISC + 8);
    const int lo = a.ph_lo, hi = a.ph_hi;
#define IN(k) (lo <= (k) && (k) < hi)
#define SEAM(k) do { if (IN(k) && IN((k) + 1)) xcd_barrier(bar); } while (0)
#define REP(bit) for (int rep_ = 0; rep_ < (((PROBE_DUP) >> (bit)) & 1) + 1; ++rep_)
#define REPBAR() do { if (rep_ == 0 && a.use_bar && PROBE_DUP) xcd_barrier(bar); } while (0)
    const float* x = a.in[0]; const float* cvec = a.in[1]; const float* ctx = a.in[2]; const float* c_ctx = a.in[3]; const float* w_ada = a.in[4]; const float* b_ada = a.in[5];
    const float* g_norm1 = a.in[6]; const float* w_in = a.in[7]; const float* w_conv = a.in[8]; const float* sink = a.in[9]; const float* w_s = a.in[10]; const float* b_s = a.in[11];
    const float* w_out = a.in[12]; const float* g_norm2 = a.in[13]; const float* w_gate = a.in[14]; const float* w_up = a.in[15]; const float* w_down = a.in[16]; const float* g_final = a.in[17];
    bf16_t* WIN = (bf16_t*)(ws + WS_WIN); bf16_t* WOUT = (bf16_t*)(ws + WS_WOUT); bf16_t* WGU = (bf16_t*)(ws + WS_WGU); bf16_t* WDN = (bf16_t*)(ws + WS_WDN);
    float* MOD = (float*)(ws + WS_MOD); float* MODP = (float*)(ws + WS_MODP); float* XS = (float*)(ws + WS_XS);
    bf16_t* H = (bf16_t*)(ws + WS_H); bf16_t* P = (bf16_t*)(ws + WS_P); bf16_t* Y = (bf16_t*)(ws + WS_Y); bf16_t* HF = (bf16_t*)(ws + WS_HF);
    bf16_t* TT = (bf16_t*)(ws + WS_TT); bf16_t* TTC = (bf16_t*)(ws + WS_TTC); bf16_t* DFTN = (bf16_t*)(ws + WS_DFTN); bf16_t* DFTC = (bf16_t*)(ws + WS_DFTC);
    f32x2* ROPE = (f32x2*)(ws + WS_ROPE); bf16_t* CSBD = (bf16_t*)(ws + WS_CSBD); bf16_t* DL = (bf16_t*)(ws + WS_DL);

    REP(8) { if (rep_) xcd_barrier(bar);
    if (IN(0)) { TID_VARS;
        LAS float* scr = (LAS float*)(lds + wave * 17408);
        p0_modp(cvec, c_ctx, w_ada, MODP, scr, gw, NGW, lane);
        p0_transposes(w_in, w_out, w_gate, w_up, w_down, WIN, WOUT, WGU, WDN, scr, gw, NGW, lane);
        p0_tables(DFTN, DFTC, CSBD, ROPE, gtid, NT);
        SEAM(0);
    }
    if (IN(1)) { TID_VARS; p1_mod(MODP, b_ada, MOD, gtid, NT); SEAM(1); } }

    for (int l = 0; l < DEPTH; ++l) {
        const int pb = PH_LAYER0 + l * PH_PER_LAYER;
        const float* modl = MOD + (size_t)l * 17 * MODW;
        const bool lastl = (l == DEPTH - 1);
        const int Mrows = lastl ? ML : MT;
        if (IN(pb + 0)) { TID_VARS;
            if (l == 0) resnorm_rows<false, false>(x, ctx, nullptr, nullptr, g_norm1, modl, 0, D, H, MT, gw, NGW, lane);
            else resnorm_rows<true, true>(XS, XS + (size_t)ML * D, DL, XS, g_norm1 + l * D, modl, 0, D, H, MT, gw, NGW, lane);
            SEAM(pb + 0); }
        REP(1) { if (rep_) xcd_barrier(bar);
        if (IN(pb + 1)) {
            pg8::Gemm g{H, WIN + (size_t)l * NPROJ * D, Mrows, NPROJ, D, D, D}; pg8::OrderIn S; S.init(Mrows, NPROJ, G, bx); S.extra = lastl ? 16 : 0;
            pg8::EpiP E{P, NPROJ};
            pg8::gemm_phase<pg8::EpiP, pg8::OrderIn, true, true>(lds, g, S, E);
            SEAM(pb + 1);
        } }
        REP(2) { if (rep_) xcd_barrier(bar);
        if (IN(pb + 2)) {
            { pg8::Gemm g{CSBD, P + OFF_F, 1024, Mrows, 512, 512, NPROJ}; pg8::StaticOrder S; S.init(1024, Mrows, G, bx);
              pg8::EpiFour1 E{TT, TTC};
              pg8::gemm_phase<pg8::EpiFour1, pg8::StaticOrder, true, true>(lds, g, S, E); }
            TID_VARS;
            mix_conv(P, w_conv + (size_t)l * 3 * 512, Y, Mrows, gtid, NT);
            mix_attn(P, Y, ROPE, sink + l * 8, lastl ? 512 : 576, lds, vcu, G, tid);
            mix_mlp(P, w_s + (size_t)l * 4 * 128 * 128, b_s + (size_t)l * 4 * 128, Y, Mrows, lds, vcu, G, tid);
            SEAM(pb + 2);
        } }
        REP(3) { if (rep_) xcd_barrier(bar);
        if (IN(pb + 3)) {
            { pg8::Gemm g{DFTN, TT, 2048, 8192, 4096, 4096, 4096}; pg8::StaticOrder S; S.init(2048, 8192, G, bx);
              pg8::EpiFour E{Y, 1.0f / 512.0f, 0, 2048};
              pg8::gemm_phase<pg8::EpiFour, pg8::StaticOrder, true, true>(lds, g, S, E); }
            if (!lastl) { pg8::Gemm g{DFTC, TTC, 256, 8192, 512, 512, 512}; pg8::StaticOrder S; S.init(256, 8192, G, bx);
              pg8::EpiFour E{Y, 0.005524271728019903f  , ML, 256};
              pg8::gemm_phase<pg8::EpiFour, pg8::StaticOrder, true, true>(lds, g, S, E); }
            SEAM(pb + 3);
        } }
        REP(4) { if (rep_) xcd_barrier(bar);
        if (IN(pb + 4)) {
            pg8::Gemm g{Y, WOUT + (size_t)l * D * D, Mrows, D, D, D, D}; pg8::StaticOrder S; S.init(Mrows, D, G, bx);
            pg8::EpiDelta E{DL, modl, 2 * D};
            pg8::gemm_phase<pg8::EpiDelta, pg8::StaticOrder, true, true>(lds, g, S, E);
            SEAM(pb + 4);
        } }
        if (IN(pb + 5)) { TID_VARS;
            resnorm_rows<true, true>(l == 0 ? x : XS, l == 0 ? ctx : XS + (size_t)ML * D, DL, XS, g_norm2 + l * D, modl, 3 * D, 4 * D, H, Mrows, gw, NGW, lane);
            SEAM(pb + 5); }
        REP(6) { if (rep_) xcd_barrier(bar);
        if (IN(pb + 6)) {
            pg8::Gemm g{H, WGU + (size_t)l * NGU * D, Mrows, NGU, D, D, D}; pg8::StaticOrder S; S.init(Mrows, NGU, G, bx);
            pg8::EpiGU E{HF};
            pg8::gemm_phase<pg8::EpiGU, pg8::StaticOrder, true, true>(lds, g, S, E);
            SEAM(pb + 6);
        } }
        REP(7) { if (rep_) xcd_barrier(bar);
        if (IN(pb + 7)) {
            pg8::Gemm g{HF, WDN + (size_t)l * D * DFF, Mrows, D, DFF, DFF, DFF}; pg8::StaticOrder S; S.init(Mrows, D, G, bx);
            pg8::EpiDelta E{DL, modl, 5 * D};
            pg8::gemm_phase<pg8::EpiDelta, pg8::StaticOrder, true, true>(lds, g, S, E);
            SEAM(pb + 7);
        } }
    }
    if (IN(PH_FINAL)) { TID_VARS; final_rows(XS, DL, g_final, a.out, gw, NGW, lane); }
#undef IN
#undef SEAM
}

extern "C" void kernel_launch(void* const* d_in, const int* in_sizes, int n_in, void* d_out, int out_size, void* d_ws, size_t ws_size, hipStream_t stream) {
    static int grid = 0;
    if (grid == 0) {
        if (n_in != 18 || in_sizes[0] != ML * D || out_size != ML * D || ws_size < WS_END) { fprintf(stderr, "kernel_launch: unexpected shapes: n_in %d in0 %d out %d ws %zu (need %zu)\n", n_in, n_in > 0 ? in_sizes[0] : -1, out_size, ws_size, (size_t)WS_END); grid = -1; return; }
        int dev = 0, cus = 0, per_cu = 0;
        if (hipGetDevice(&dev) != hipSuccess || hipDeviceGetAttribute(&cus, hipDeviceAttributeMultiprocessorCount, dev) != hipSuccess) { fprintf(stderr, "kernel_launch: device query failed\n"); grid = -1; return; }
        if (hipFuncSetAttribute((const void*)fwd, hipFuncAttributeMaxDynamicSharedMemorySize, LDS_BYTES) != hipSuccess) { fprintf(stderr, "kernel_launch: hipFuncSetAttribute failed\n"); grid = -1; return; }
        if (hipOccupancyMaxActiveBlocksPerMultiprocessor(&per_cu, (const void*)fwd, NTHREADS, LDS_BYTES) != hipSuccess || per_cu < 1) fprintf(stderr, "kernel_launch: note: occupancy query reports %d workgroups per CU\n", per_cu);
        (void)hipGetLastError();
        grid = cus;
    }
    if (grid < 0) return;
    if (hipMemsetAsync((char*)d_ws + WS_CTL, 0, CTL_ZERO_BYTES, stream) != hipSuccess) { fprintf(stderr, "kernel_launch: memset failed\n"); return; }
    Args a{};
    for (int i = 0; i < 18; ++i) a.in[i] = (const float*)d_in[i];
    a.out = (float*)d_out; a.ws = (unsigned char*)d_ws; a.pad = 0;
#if MK_ONE_LAUNCH
    a.ph_lo = 0; a.ph_hi = NPH; a.use_bar = 1;
    hipLaunchKernelGGL(fwd, dim3(grid), dim3(NTHREADS), LDS_BYTES, stream, a);
#else
    for (int ph = 0; ph < NPH; ++ph) { a.ph_lo = ph; a.ph_hi = ph + 1; a.use_bar = 0; hipLaunchKernelGGL(fwd, dim3(grid), dim3(NTHREADS), LDS_BYTES, stream, a); }
#endif
    const hipError_t le = hipPeekAtLastError();
    if (le != hipSuccess) fprintf(stderr, "kernel_launch: launch failed: %s\n", hipGetErrorName(le));
}
```

```cpp
#include <hip/hip_runtime.h>
#include <cstdio>
#include <cstdint>
namespace pg8 {
#define PG8_LAS __attribute__((address_space(3)))
typedef unsigned short bf16_t;
typedef short bf16x8 __attribute__((ext_vector_type(8)));
typedef float f32x4 __attribute__((ext_vector_type(4)));
typedef unsigned u32x4 __attribute__((ext_vector_type(4)));
constexpr int BM = 256, BK = 64, HALF = 128, HTB = HALF * BK * 2  , STAGE_BYTES = 8 * HTB, NXCD = 8, WGM = 8;

__host__ __device__ __forceinline__ int lds_byte(int r, int c) { const int st = (r >> 4) * 2 + (c >> 5), rr = r & 15, cc = c & 31, ob = rr * 64 + cc * 2; return st * 1024 + (ob ^ (((ob >> 9) & 1) << 5)); }
__host__ __device__ __forceinline__ void stage_rc(int b, int& R, int& C) { const int st = b / 1024, sb = b % 1024, swz = sb ^ (((sb >> 9) & 1) << 5); R = (st >> 1) * 16 + swz / 64; C = (st & 1) * 32 + (swz % 64) / 2; }
__host__ __device__ __forceinline__ int perm32(int rho) { const int n = rho >> 4, i = rho & 15; return 8 * (i >> 2) + 4 * n + (i & 3); }

struct Unit { int pm, pn; };
struct Gemm { const bf16_t* A; const bf16_t* Bt; int M, N, K, lda, ldb; };

struct StaticOrder {
    int nM, nN, nwg, G, c;
    __host__ __device__ void init(int M, int N, int G_, int c_) { nM = M / BM; nN = N / BM; nwg = nM * nN; G = G_; c = c_; }
    __host__ __device__ bool next(int i, Unit& u) const {
        const long L = (long)i * G + c; if (L >= nwg) return false;
        int wgid = (int)L; { const int q = nwg / NXCD, r = nwg % NXCD, xcd = wgid % NXCD, off = wgid / NXCD; wgid = (xcd < r ? xcd * (q + 1) : r * (q + 1) + (xcd - r) * q) + off; }
        const int nig = WGM * nN, gid = wgid / nig, fm = gid * WGM, gsz = (nM - fm) < WGM ? (nM - fm) : WGM;
        u.pm = fm + ((wgid % nig) % gsz); u.pn = (wgid % nig) / gsz; return true;
    }
    __device__ __forceinline__ void a_ready(const Unit&) const {}
    __device__ __forceinline__ void done(const Unit&) const {}
};

struct OrderIn : StaticOrder {
    int extra;
    __host__ __device__ bool next(int i, Unit& u) const {
        const long L = (long)i * G + c; if (L < nwg) return StaticOrder::next(i, u);
        const long j = L - nwg; if (j >= extra) return false;
        u.pm = 128 + (int)j; u.pn = 10; return true;
    }
};
typedef float f32x2 __attribute__((ext_vector_type(2)));
typedef __bf16 bf16x2_hw __attribute__((ext_vector_type(2)));
__device__ __forceinline__ unsigned cvt_pk_bf16(float lo, float hi) { const f32x2 v = {lo, hi}; const bf16x2_hw b = __builtin_convertvector(v, bf16x2_hw); return __builtin_bit_cast(unsigned, b); }
__device__ __forceinline__ float silu_f(float x) { return x * __builtin_amdgcn_rcpf(1.0f + __expf(-x)); }
struct EpiP {
    static constexpr bool PERM = true, AFTER_DRAIN = false;
    bf16_t* O; int ldc;
    __device__ __forceinline__ void operator()(const f32x4 (&acc)[2][2][4][2], const Unit& u, int wr, int wc, int fr, int fq) const {
        const int row0 = u.pm * BM + wr * 64 + fr, col0 = u.pn * BM + wc * 32 + 8 * fq;
#pragma unroll
        for (int ai = 0; ai < 2; ++ai)
#pragma unroll
            for (int m = 0; m < 4; ++m) { bf16_t* rowp = O + (size_t)(row0 + ai * HALF + m * 16) * ldc + col0;
#pragma unroll
                for (int bj = 0; bj < 2; ++bj) { const f32x4 v0 = acc[ai][bj][m][0], v1 = acc[ai][bj][m][1];
                    u32x4 w; w.x = cvt_pk_bf16(v0[0], v0[1]); w.y = cvt_pk_bf16(v0[2], v0[3]); w.z = cvt_pk_bf16(v1[0], v1[1]); w.w = cvt_pk_bf16(v1[2], v1[3]);
                    *(u32x4*)(rowp + bj * HALF) = w; } }
    }
};
struct EpiDelta {
    static constexpr bool PERM = true, AFTER_DRAIN = false;
    bf16_t* O; const float* modl; int goff;
    __device__ __forceinline__ void operator()(const f32x4 (&acc)[2][2][4][2], const Unit& u, int wr, int wc, int fr, int fq) const {
        const int b = u.pm < 128 ? (u.pm >> 3) : 16;
        const float* gate = modl + (size_t)b * 12288 + goff;
        const int row0 = u.pm * BM + wr * 64 + fr, col0 = u.pn * BM + wc * 32 + 8 * fq;
        f32x4 gv[2][2];
#pragma unroll
        for (int bj = 0; bj < 2; ++bj)
#pragma unroll
            for (int n = 0; n < 2; ++n) gv[bj][n] = *(const f32x4*)(gate + col0 + bj * HALF + 4 * n);
#pragma unroll
        for (int ai = 0; ai < 2; ++ai)
#pragma unroll
            for (int m = 0; m < 4; ++m) { bf16_t* rowp = O + (size_t)(row0 + ai * HALF + m * 16) * 2048 + col0;
#pragma unroll
                for (int bj = 0; bj < 2; ++bj) { const f32x4 v0 = acc[ai][bj][m][0] * gv[bj][0], v1 = acc[ai][bj][m][1] * gv[bj][1];
                    u32x4 w; w.x = cvt_pk_bf16(v0[0], v0[1]); w.y = cvt_pk_bf16(v0[2], v0[3]); w.z = cvt_pk_bf16(v1[0], v1[1]); w.w = cvt_pk_bf16(v1[2], v1[3]);
                    *(u32x4*)(rowp + bj * HALF) = w; } }
    }
};
struct EpiGU {
    static constexpr bool PERM = true, AFTER_DRAIN = false;
    bf16_t* O;
    __device__ __forceinline__ void operator()(const f32x4 (&acc)[2][2][4][2], const Unit& u, int wr, int wc, int fr, int fq) const {
        const int row0 = u.pm * BM + wr * 64 + fr, col0 = u.pn * HALF + wc * 32 + 8 * fq;
#pragma unroll
        for (int ai = 0; ai < 2; ++ai)
#pragma unroll
            for (int m = 0; m < 4; ++m) { bf16_t* rowp = O + (size_t)(row0 + ai * HALF + m * 16) * 5632 + col0;
                const f32x4 g0 = acc[ai][0][m][0], g1 = acc[ai][0][m][1], u0 = acc[ai][1][m][0], u1 = acc[ai][1][m][1];
                u32x4 w;
                w.x = cvt_pk_bf16(silu_f(g0[0]) * u0[0], silu_f(g0[1]) * u0[1]); w.y = cvt_pk_bf16(silu_f(g0[2]) * u0[2], silu_f(g0[3]) * u0[3]);
                w.z = cvt_pk_bf16(silu_f(g1[0]) * u1[0], silu_f(g1[1]) * u1[1]); w.w = cvt_pk_bf16(silu_f(g1[2]) * u1[2], silu_f(g1[3]) * u1[3]);
                *(u32x4*)rowp = w; }
    }
};
struct EpiFour {
    static constexpr bool PERM = true, AFTER_DRAIN = false;
    bf16_t* Y; float scale; int row_base, rows_per_batch;
    __device__ __forceinline__ void operator()(const f32x4 (&acc)[2][2][4][2], const Unit& u, int wr, int wc, int fr, int fq) const {
        const int row0 = row_base + (u.pn >> 1) * rows_per_batch + u.pm * BM + wr * 64 + fr, col0 = 512 + (u.pn & 1) * BM + wc * 32 + 8 * fq;
#pragma unroll
        for (int ai = 0; ai < 2; ++ai)
#pragma unroll
            for (int m = 0; m < 4; ++m) { bf16_t* rowp = Y + (size_t)(row0 + ai * HALF + m * 16) * 2048 + col0;
#pragma unroll
                for (int bj = 0; bj < 2; ++bj) { const f32x4 v0 = acc[ai][bj][m][0] * scale, v1 = acc[ai][bj][m][1] * scale;
                    u32x4 w; w.x = cvt_pk_bf16(v0[0], v0[1]); w.y = cvt_pk_bf16(v0[2], v0[3]); w.z = cvt_pk_bf16(v1[0], v1[1]); w.w = cvt_pk_bf16(v1[2], v1[3]);
                    *(u32x4*)(rowp + bj * HALF) = w; } }
    }
};
struct EpiFour1 {
    static constexpr bool PERM = true, AFTER_DRAIN = false;
    bf16_t* TT; bf16_t* TTC;
    __device__ __forceinline__ void operator()(const f32x4 (&acc)[2][2][4][2], const Unit& u, int wr, int wc, int fr, int fq) const {
        const int g = u.pm; bf16_t* base; size_t chs, half;
        if (u.pn < 128) { const int b = u.pn >> 3, n0 = (u.pn & 7) * BM + wc * 32 + 8 * fq; base = TT + (size_t)(b * 512 + g * 128) * 4096 + n0; chs = 4096; half = 2048; }
        else { const int b = u.pn - 128, n0 = wc * 32 + 8 * fq; base = TTC + (size_t)(b * 512 + g * 128) * 512 + n0; chs = 512; half = 256; }
#pragma unroll
        for (int ai = 0; ai < 2; ++ai)
#pragma unroll
            for (int m = 0; m < 4; ++m) { bf16_t* rowp = base + (size_t)(wr * 64 + m * 16 + fr) * chs + ai * half;
#pragma unroll
                for (int bj = 0; bj < 2; ++bj) { const f32x4 v0 = acc[ai][bj][m][0], v1 = acc[ai][bj][m][1];
                    u32x4 w; w.x = cvt_pk_bf16(v0[0], v0[1]); w.y = cvt_pk_bf16(v0[2], v0[3]); w.z = cvt_pk_bf16(v1[0], v1[1]); w.w = cvt_pk_bf16(v1[2], v1[3]);
                    *(u32x4*)(rowp + bj * HALF) = w; } }
    }
};
template <class Epi, class Sched, bool ALIGN_EPI = false, bool SP2 = false>
__device__ __forceinline__ void gemm_phase(PG8_LAS unsigned char* lds, const Gemm g, const Sched& S, const Epi& E) {
    int tid_ = threadIdx.x; asm volatile("" : "+v"(tid_));
    const int tid = tid_, wid = __builtin_amdgcn_readfirstlane(tid >> 6), lane = tid & 63, wr = wid >> 2, wc = wid & 3, fr = lane & 15, fq = lane >> 4;
    const int K = g.K, nt = K / BK;
    unsigned voffA[2], voffB[2];
#pragma unroll
    for (int i = 0; i < 2; ++i) { int R, C; stage_rc(tid * 16 + i * 8192, R, C); const int Rb = Epi::PERM ? ((R & ~31) + perm32(R & 31)) : R;
        voffA[i] = (unsigned)(R * g.lda + C) * 2u; voffB[i] = (unsigned)(Rb * g.ldb + C) * 2u; }
    const size_t kstep = (size_t)(BK * 2);
    const size_t hstepA = (size_t)HALF * g.lda * 2, hstepB = (size_t)HALF * g.ldb * 2;
    const size_t tstepA = 2 * hstepA, tstepB = 2 * hstepB;
    const unsigned ldsw = (unsigned)wid * 1024u;
    const int aoff = lds_byte(wr * 64 + fr, fq * 8), boff = lds_byte(wc * 32 + fr, fq * 8);
#define PG8_SA(b, h) (((b) * 2 + (h)) * HTB)
#define PG8_SB(b, h) ((4 + (b) * 2 + (h)) * HTB)
#define PG8_STAGE(bufoff, gbase, voff) do { _Pragma("unroll") for (int _i = 0; _i < 2; ++_i) \
        __builtin_amdgcn_global_load_lds((const unsigned*)((const char*)(gbase) + (voff)[_i]), (PG8_LAS unsigned*)(lds + (bufoff) + ldsw + _i * 8192), 16, 0, 0); } while (0)
#define PG8_LDA(dst, b, h) do { _Pragma("unroll") for (int m = 0; m < 4; ++m) _Pragma("unroll") for (int k = 0; k < 2; ++k) dst[m][k] = *(const PG8_LAS bf16x8*)(lds + PG8_SA(b, h) + aoff + m * 2048 + k * 1024); } while (0)
#define PG8_LDB(dst, b, h) do { _Pragma("unroll") for (int n = 0; n < 2; ++n) _Pragma("unroll") for (int k = 0; k < 2; ++k) dst[n][k] = *(const PG8_LAS bf16x8*)(lds + PG8_SB(b, h) + boff + n * 2048 + k * 1024); } while (0)
#define PG8_MMA(ai, bj, At, Bt) do { __builtin_amdgcn_s_setprio(1); _Pragma("unroll") for (int m = 0; m < 4; ++m) _Pragma("unroll") for (int n = 0; n < 2; ++n) _Pragma("unroll") for (int k = 0; k < 2; ++k) \
        acc[ai][bj][m][n] = __builtin_amdgcn_mfma_f32_16x16x32_bf16(Bt[n][k], At[m][k], acc[ai][bj][m][n], 0, 0, 0); __builtin_amdgcn_s_setprio(0); } while (0)
#define PG8_WAIT_V(n) asm volatile("s_waitcnt vmcnt(" #n ")" ::: "memory")
#define PG8_WAIT_L(n) asm volatile("s_waitcnt lgkmcnt(" #n ")" ::: "memory")
#define PG8_BAR __builtin_amdgcn_s_barrier()
#define PG8_SCHED __builtin_amdgcn_sched_barrier(0)
    Unit cur, nxt; int ui = 0;
    if (!S.next(0, cur)) return;
    f32x4 acc[2][2][4][2];
#pragma unroll
    for (int a = 0; a < 2; ++a)
#pragma unroll
        for (int b = 0; b < 2; ++b)
#pragma unroll
            for (int m = 0; m < 4; ++m)
#pragma unroll
                for (int n = 0; n < 2; ++n) acc[a][b][m][n] = (f32x4){0.f, 0.f, 0.f, 0.f};
    bf16x8 At[4][2], B0[2][2], B1[2][2];
    const char* cA = (const char*)g.A + (size_t)cur.pm * tstepA; const char* cB = (const char*)g.Bt + (size_t)cur.pn * tstepB;
    S.a_ready(cur);
    if constexpr (SP2) {
        PG8_STAGE(PG8_SB(0, 0), cB, voffB); PG8_STAGE(PG8_SB(0, 1), cB + hstepB, voffB); PG8_STAGE(PG8_SA(0, 0), cA, voffA); PG8_STAGE(PG8_SA(0, 1), cA + hstepA, voffA);
        if (wr == 1) PG8_BAR;
        PG8_WAIT_V(2); PG8_BAR;
        PG8_STAGE(PG8_SB(1, 0), cB + kstep, voffB); PG8_STAGE(PG8_SA(1, 0), cA + kstep, voffA); PG8_STAGE(PG8_SB(1, 1), cB + hstepB + kstep, voffB);
        PG8_WAIT_V(6); PG8_BAR;
    } else {
        PG8_STAGE(PG8_SB(0, 0), cB, voffB); PG8_STAGE(PG8_SA(0, 0), cA, voffA); PG8_STAGE(PG8_SB(0, 1), cB + hstepB, voffB); PG8_STAGE(PG8_SA(0, 1), cA + hstepA, voffA);
        if (wr == 1) PG8_BAR;
        PG8_WAIT_V(4); PG8_BAR;
        PG8_STAGE(PG8_SB(1, 0), cB + kstep, voffB); PG8_STAGE(PG8_SA(1, 0), cA + kstep, voffA); PG8_STAGE(PG8_SB(1, 1), cB + hstepB + kstep, voffB);
        PG8_WAIT_V(6); PG8_BAR;
    }
    for (;;) {
        const bool has_next = S.next(ui + 1, nxt);
        const char* nA = has_next ? (const char*)g.A + (size_t)nxt.pm * tstepA : cA; const char* nB = has_next ? (const char*)g.Bt + (size_t)nxt.pn * tstepB : cB;
        for (int t = 0; t < nt; t += 2) {
            const bool last = (t == nt - 2);
            const char* a1 = cA + (size_t)(t + 1) * kstep;
            const char* a2 = last ? nA : cA + (size_t)(t + 2) * kstep; const char* b2 = last ? nB : cB + (size_t)(t + 2) * kstep;
            const char* a3 = a2 + kstep; const char* b3 = b2 + kstep;
            if (last && has_next) S.a_ready(nxt);
            if constexpr (SP2) {
            PG8_LDB(B0, 0, 0); PG8_LDB(B1, 0, 1); PG8_SCHED; PG8_LDA(At, 0, 0); PG8_STAGE(PG8_SA(1, 1), a1 + hstepA, voffA);
            PG8_WAIT_V(8); PG8_WAIT_L(0); PG8_BAR; PG8_MMA(0, 0, At, B0); PG8_MMA(0, 1, At, B1); PG8_BAR; PG8_SCHED;
            PG8_LDA(At, 0, 1); PG8_STAGE(PG8_SB(0, 0), b2, voffB); PG8_STAGE(PG8_SB(0, 1), b2 + hstepB, voffB); PG8_STAGE(PG8_SA(0, 0), a2, voffA);
            PG8_WAIT_V(8); PG8_WAIT_L(0); PG8_BAR; PG8_MMA(1, 0, At, B0); PG8_MMA(1, 1, At, B1); PG8_BAR; PG8_SCHED;
            PG8_LDB(B0, 1, 0); PG8_LDB(B1, 1, 1); PG8_SCHED; PG8_LDA(At, 1, 0); PG8_STAGE(PG8_SA(0, 1), a2 + hstepA, voffA);
            PG8_WAIT_V(8); PG8_WAIT_L(0); PG8_BAR; PG8_MMA(0, 0, At, B0); PG8_MMA(0, 1, At, B1); PG8_BAR; PG8_SCHED;
            PG8_LDA(At, 1, 1); PG8_STAGE(PG8_SB(1, 0), b3, voffB); PG8_STAGE(PG8_SB(1, 1), b3 + hstepB, voffB); PG8_STAGE(PG8_SA(1, 0), a3, voffA);
            PG8_WAIT_V(8); PG8_WAIT_L(0); PG8_BAR; PG8_MMA(1, 0, At, B0); PG8_MMA(1, 1, At, B1); PG8_BAR; PG8_SCHED;
            } else {
            PG8_LDB(B0, 0, 0); PG8_SCHED; PG8_LDA(At, 0, 0); PG8_STAGE(PG8_SA(1, 1), a1 + hstepA, voffA);
            PG8_WAIT_L(8); PG8_BAR; PG8_WAIT_L(0); PG8_MMA(0, 0, At, B0); PG8_BAR; PG8_SCHED;
            PG8_LDB(B1, 0, 1); PG8_STAGE(PG8_SB(0, 0), b2, voffB);
            PG8_BAR; PG8_WAIT_L(0); PG8_MMA(0, 1, At, B1); PG8_BAR;
            PG8_LDA(At, 0, 1); PG8_STAGE(PG8_SA(0, 0), a2, voffA);
            PG8_BAR; PG8_WAIT_L(0); PG8_MMA(1, 0, At, B0); PG8_BAR; PG8_SCHED;
            PG8_STAGE(PG8_SB(0, 1), b2 + hstepB, voffB);
            PG8_WAIT_V(6); PG8_BAR; PG8_MMA(1, 1, At, B1); PG8_BAR;
            PG8_LDB(B0, 1, 0); PG8_SCHED; PG8_LDA(At, 1, 0); PG8_STAGE(PG8_SA(0, 1), a2 + hstepA, voffA);
            PG8_WAIT_L(8); PG8_BAR; PG8_WAIT_L(0); PG8_MMA(0, 0, At, B0); PG8_BAR; PG8_SCHED;
            PG8_LDB(B1, 1, 1); PG8_STAGE(PG8_SB(1, 0), b3, voffB);
            PG8_BAR; PG8_WAIT_L(0); PG8_MMA(0, 1, At, B1); PG8_BAR;
            PG8_LDA(At, 1, 1); PG8_STAGE(PG8_SA(1, 0), a3, voffA);
            PG8_BAR; PG8_WAIT_L(0); PG8_MMA(1, 0, At, B0); PG8_BAR; PG8_SCHED;
            PG8_STAGE(PG8_SB(1, 1), b3 + hstepB, voffB);
            PG8_WAIT_V(6); PG8_BAR; PG8_MMA(1, 1, At, B1); PG8_BAR;
            }
        }
        if constexpr (ALIGN_EPI) { if (wr == 0) PG8_BAR; }
        if constexpr (!Epi::AFTER_DRAIN) { E(acc, cur, wr, wc, fr, fq); S.done(cur); }
        if (!has_next) break;
#pragma unroll
        for (int a = 0; a < 2; ++a)
#pragma unroll
            for (int b = 0; b < 2; ++b)
#pragma unroll
                for (int m = 0; m < 4; ++m)
#pragma unroll
                    for (int n = 0; n < 2; ++n) acc[a][b][m][n] = (f32x4){0.f, 0.f, 0.f, 0.f};
        cur = nxt; cA = nA; cB = nB; ++ui;
        if constexpr (ALIGN_EPI) { if (wr == 1) PG8_BAR; }
    }
    PG8_WAIT_V(0);
    if constexpr (!ALIGN_EPI) { if (wr == 0) PG8_BAR; }
    PG8_BAR;
    if constexpr (Epi::AFTER_DRAIN) { E.fused(acc, cur, wr, wc, fr, fq, lds, wid, lane); S.done(cur); }
#undef PG8_SA
#undef PG8_SB
#undef PG8_STAGE
#undef PG8_LDA
#undef PG8_LDB
#undef PG8_MMA
#undef PG8_WAIT_V
#undef PG8_WAIT_L
#undef PG8_BAR
#undef PG8_SCHED
}
}
#define GAS __attribute__((address_space(1)))
#define LAS __attribute__((address_space(3)))
typedef unsigned short bf16_t;
typedef unsigned u32x4 __attribute__((ext_vector_type(4)));
typedef unsigned u32x2 __attribute__((ext_vector_type(2)));
typedef float f32x4 __attribute__((ext_vector_type(4)));
typedef float f32x2 __attribute__((ext_vector_type(2)));

constexpr int D = 2048, NBATCH = 16, SEQ = 2048, DEPTH = 4, CTXL = 256;
constexpr int ML = NBATCH * SEQ, MC = NBATCH * CTXL, MT = ML + MC;
constexpr int NPROJ = 3840, DFF = 5632, NGU = 2 * DFF, MODW = 6 * D;
constexpr int OFF_AX = 0, OFF_AB = 512, OFF_AC = 1024, OFF_F = 1536, OFF_Q = 2048, OFF_K = 2560, OFF_V = 2688, OFF_U = 2816, OFF_MV = 3328;
constexpr float EPS = 1e-6f;
constexpr int NWAVES = 8, NTHREADS = 512;

constexpr size_t al256(size_t x) { return (x + 255) & ~(size_t)255; }
constexpr size_t WS_CTL = 0, CTL_ZERO_BYTES = 1u << 20;
constexpr size_t WS_WIN = CTL_ZERO_BYTES;
constexpr size_t WS_WOUT = WS_WIN + (size_t)DEPTH * NPROJ * D * 2;
constexpr size_t WS_WGU = WS_WOUT + (size_t)DEPTH * D * D * 2;
constexpr size_t WS_WDN = WS_WGU + (size_t)DEPTH * NGU * D * 2;
constexpr size_t WS_MOD = WS_WDN + (size_t)DEPTH * D * DFF * 2;
constexpr size_t WS_MODP = al256(WS_MOD + (size_t)DEPTH * 17 * MODW * 4);
constexpr size_t WS_XS = al256(WS_MODP + (size_t)DEPTH * 8 * 17 * MODW * 4);
constexpr size_t WS_H = WS_XS + (size_t)MT * D * 4;
constexpr size_t WS_P = WS_H + (size_t)MT * D * 2;
constexpr size_t WS_Y = WS_P + (size_t)MT * NPROJ * 2;
constexpr size_t WS_HF = WS_P;
constexpr size_t WS_TT = WS_Y + (size_t)MT * D * 2;
static_assert(WS_HF + (size_t)MT * DFF * 2 <= WS_TT, "hf overlay");
constexpr size_t WS_TTC = WS_TT + (size_t)NBATCH * 512 * 4096 * 2;
constexpr size_t WS_DFTN = WS_TTC + (size_t)NBATCH * 512 * 512 * 2;
constexpr size_t WS_DFTC = WS_DFTN + (size_t)2048 * 4096 * 2;
constexpr size_t WS_ROPE = WS_DFTC + (size_t)256 * 512 * 2;
constexpr size_t WS_CSBD = WS_ROPE + (size_t)2048 * 32 * 8;
constexpr size_t WS_DL = WS_CSBD + (size_t)1024 * 512 * 2;
constexpr size_t WS_END = WS_DL + (size_t)MT * D * 2;
constexpr int CW_BAR = 4096;

constexpr int LDS_BYTES = 147456;
constexpr int LDSCTL_OFF = 146432, MISC_OFF = LDSCTL_OFF;

#define LDS_WAIT() asm volatile("s_waitcnt lgkmcnt(0)" ::: "memory")
__device__ __forceinline__ float bf2f(unsigned b) { return __uint_as_float(b << 16); }
__device__ __forceinline__ unsigned f2bf(float f) { unsigned u = __float_as_uint(f); return (u + 0x7fffu + ((u >> 16) & 1u)) >> 16; }
typedef __bf16 bf16x2_hw __attribute__((ext_vector_type(2)));
__device__ __forceinline__ unsigned pk2(float lo, float hi) { const f32x2 v = {lo, hi}; const bf16x2_hw b = __builtin_convertvector(v, bf16x2_hw); return __builtin_bit_cast(unsigned, b); }
__device__ __forceinline__ void unpack8(const u32x4 w, float* o) {
    o[0] = __uint_as_float(w.x << 16); o[1] = __uint_as_float(w.x & 0xffff0000u); o[2] = __uint_as_float(w.y << 16); o[3] = __uint_as_float(w.y & 0xffff0000u);
    o[4] = __uint_as_float(w.z << 16); o[5] = __uint_as_float(w.z & 0xffff0000u); o[6] = __uint_as_float(w.w << 16); o[7] = __uint_as_float(w.w & 0xffff0000u);
}
__device__ __forceinline__ float wave_sum(float v) {
#pragma unroll
    for (int o = 1; o < 64; o <<= 1) v += __shfl_xor(v, o);
    return v;
}
__device__ __forceinline__ float gelu_tanh(float x) {
    const float u = 0.7978845608028654f * (x + 0.044715f * x * x * x);
    const float e = __expf(2.0f * u);
    const float t = 1.0f - 2.0f * __builtin_amdgcn_rcpf(1.0f + e);
    return 0.5f * x * (1.0f + t);
}
#define XB_TMO      128
#define XB_XCNT(j)  (256  + 64 * (j))
#define XB_XSUB(j)  (1280 + 64 * (j))
#define XB_XGEN(j)  (2304 + 64 * (j))
#define XB_TOP      3328
#define XB_TOPGEN   3392
#define XCD_BAR_WORDS 3456
#define XB_SPIN_CAP (1u << 18)

__device__ __forceinline__ unsigned xb_ld(unsigned* p)              { return __hip_atomic_load(p, __ATOMIC_RELAXED, __HIP_MEMORY_SCOPE_AGENT); }
__device__ __forceinline__ unsigned xb_add(unsigned* p, unsigned v) { return __hip_atomic_fetch_add(p, v, __ATOMIC_RELAXED, __HIP_MEMORY_SCOPE_AGENT); }
__device__ __forceinline__ unsigned xb_xcc_id() { return (unsigned)__builtin_amdgcn_s_getreg((3 << 11) | 20) & 0xFu; }
#define XB_SPIN(cond, bar) do { unsigned _sp = 0; while (cond) { __builtin_amdgcn_s_sleep(1); \
    if ((++_sp & 255u) == 0u) { if (xb_ld(&(bar)[XB_TMO])) break; if (_sp > XB_SPIN_CAP) { atomicAdd(&(bar)[XB_TMO], 1u); break; } } } } while (0)

struct XcdBarrier {
    unsigned* bar; unsigned x;
    volatile LAS unsigned* st;
};

__device__ __forceinline__ XcdBarrier xcd_barrier_post(unsigned* bar, volatile LAS unsigned* st) {
    XcdBarrier b; b.bar = bar; b.x = xb_xcc_id(); b.st = st;
    if (threadIdx.x == 0) (void)xb_add(&bar[XB_XCNT(b.x)], 1u);
    return b;
}
__device__ __forceinline__ void xcd_barrier_complete(unsigned* bar, unsigned x, unsigned& nloc, unsigned& nx) {
    const unsigned G = gridDim.x * gridDim.y * gridDim.z;
    unsigned sum, cnt, mine, sp = 0u;
    for (;;) {
        sum = 0u; cnt = 0u; mine = 0u;
#pragma unroll
        for (unsigned j = 0; j < 16; ++j) { const unsigned c = xb_ld(&bar[XB_XCNT(j)]); sum += c; cnt += (c > 0u) ? 1u : 0u; mine = (j == x) ? c : mine; }
        if (sum == G) break;
        __builtin_amdgcn_s_sleep(1);
        if ((++sp & 255u) == 0u) { if (xb_ld(&bar[XB_TMO])) break; if (sp > XB_SPIN_CAP) { atomicAdd(&bar[XB_TMO], 1u); break; } }
    }
    nloc = mine > 0u ? mine : 1u; nx = cnt > 0u ? cnt : 1u;
}

__device__ __forceinline__ void xcd_barrier(const XcdBarrier& b) {
    asm volatile("s_waitcnt vmcnt(0)" ::: "memory");
    __syncthreads();
    if (threadIdx.x == 0) {
        unsigned* bar = b.bar;
        __builtin_amdgcn_s_waitcnt(0);
        unsigned nloc = b.st[0], nx = b.st[1];
        if (nloc == 0u) { xcd_barrier_complete(bar, b.x, nloc, nx); b.st[0] = nloc; b.st[1] = nx; }
        const unsigned old = xb_add(&bar[XB_XSUB(b.x)], 1u);
        const unsigned gen = old / nloc;
        if (old + 1u == (gen + 1u) * nloc) {
            __builtin_amdgcn_fence(__ATOMIC_RELEASE, "agent");
            asm volatile("s_waitcnt vmcnt(0)" ::: "memory");
            const unsigned og = xb_add(&bar[XB_TOP], 1u);
            const unsigned tg = og / nx;
            if (og + 1u == (tg + 1u) * nx) xb_add(&bar[XB_TOPGEN], 1u);
            else XB_SPIN(xb_ld(&bar[XB_TOPGEN]) == tg, bar);
            __builtin_amdgcn_fence(__ATOMIC_ACQUIRE, "agent");
            xb_add(&bar[XB_XGEN(b.x)], 1u);
            asm volatile("s_waitcnt vmcnt(0)" ::: "memory");
        } else {
            XB_SPIN(xb_ld(&bar[XB_XGEN(b.x)]) == gen, bar);
            __builtin_amdgcn_fence(__ATOMIC_ACQUIRE, "agent");
            asm volatile("s_waitcnt vmcnt(0)" ::: "memory");
        }
    }
    __syncthreads();
}
__device__ __forceinline__ void tr_item(const float* __restrict__ W, int K, int N, bf16_t* __restrict__ WT, int k0, int n0, int drow0, LAS float* scr, int lane) {
#pragma unroll 8
    for (int i = 0; i < 32; ++i) { const int kk = 2 * i + (lane >> 5); scr[kk * 33 + (lane & 31)] = W[(size_t)(k0 + kk) * N + n0 + (lane & 31)]; }
    LDS_WAIT(); asm volatile("" ::: "memory");
    const int c = lane & 7;
#pragma unroll
    for (int j = 0; j < 4; ++j) { const int n = (lane >> 3) + 8 * j; const LAS float* s = scr + (8 * c) * 33 + n;
        u32x4 o; o.x = pk2(s[0 * 33], s[1 * 33]); o.y = pk2(s[2 * 33], s[3 * 33]); o.z = pk2(s[4 * 33], s[5 * 33]); o.w = pk2(s[6 * 33], s[7 * 33]);
        *(u32x4*)(WT + (size_t)(drow0 + n) * K + k0 + 8 * c) = o; }
    LDS_WAIT(); asm volatile("" ::: "memory");
}
constexpr int TR_IN = 32 * 120, TR_OUT = 32 * 64, TR_G = 32 * 176, TR_DN = 88 * 64, TR_LAYER = TR_IN + TR_OUT + 2 * TR_G + TR_DN;
__device__ __forceinline__ void p0_transposes(const float* w_in, const float* w_out, const float* w_gate, const float* w_up, const float* w_down,
                                              bf16_t* WIN, bf16_t* WOUT, bf16_t* WGU, bf16_t* WDN, LAS float* scr, int gw, int NGW, int lane) {
    for (int it = gw; it < DEPTH * TR_LAYER; it += NGW) {
        const int l = it / TR_LAYER; int r = it % TR_LAYER;
        if (r < TR_IN) { const int kb = r / 120, nb = r % 120; tr_item(w_in + (size_t)l * D * NPROJ, D, NPROJ, WIN + (size_t)l * NPROJ * D, kb * 64, nb * 32, nb * 32, scr, lane); continue; } r -= TR_IN;
        if (r < TR_OUT) { const int kb = r / 64, nb = r % 64; tr_item(w_out + (size_t)l * D * D, D, D, WOUT + (size_t)l * D * D, kb * 64, nb * 32, nb * 32, scr, lane); continue; } r -= TR_OUT;
        if (r < TR_G) { const int kb = r / 176, nb = r % 176, n0 = nb * 32; tr_item(w_gate + (size_t)l * D * DFF, D, DFF, WGU + (size_t)l * NGU * D, kb * 64, n0, (n0 >> 7) * 256 + (n0 & 127), scr, lane); continue; } r -= TR_G;
        if (r < TR_G) { const int kb = r / 176, nb = r % 176, n0 = nb * 32; tr_item(w_up + (size_t)l * D * DFF, D, DFF, WGU + (size_t)l * NGU * D, kb * 64, n0, (n0 >> 7) * 256 + 128 + (n0 & 127), scr, lane); continue; } r -= TR_G;
        { const int kb = r / 64, nb = r % 64; tr_item(w_down + (size_t)l * DFF * D, DFF, D, WDN + (size_t)l * D * DFF, kb * 64, nb * 32, nb * 32, scr, lane); }
    }
}
__device__ __forceinline__ void p0_modp(const float* __restrict__ c, const float* __restrict__ c_ctx, const float* __restrict__ w_ada, float* __restrict__ modp, LAS float* scr  , int gw, int NGW, int lane) {
    for (int it = gw; it < DEPTH * 48 * 8; it += NGW) {
        const int l = it / 384, rem = it % 384, cc = rem >> 3, ks = rem & 7, k0 = ks * 256;
#pragma unroll
        for (int r = 0; r < 17; ++r)
#pragma unroll
            for (int j = 0; j < 4; ++j) { const int idx = j * 64 + lane; const float v = (r < 16) ? c[r * D + k0 + idx] : c_ctx[k0 + idx]; scr[r * 256 + idx] = v * (1.0f / (1.0f + __expf(-v))); }
        LDS_WAIT(); asm volatile("" ::: "memory");
        f32x4 acc[17];
#pragma unroll
        for (int r = 0; r < 17; ++r) acc[r] = (f32x4){0.f, 0.f, 0.f, 0.f};
        const float* wp = w_ada + ((size_t)l * D + k0) * MODW + cc * 256 + lane * 4;
#pragma unroll 2
        for (int k4 = 0; k4 < 64; ++k4) {
            const f32x4 w0 = *(const f32x4*)(wp + (size_t)(4 * k4 + 0) * MODW), w1 = *(const f32x4*)(wp + (size_t)(4 * k4 + 1) * MODW);
            const f32x4 w2 = *(const f32x4*)(wp + (size_t)(4 * k4 + 2) * MODW), w3 = *(const f32x4*)(wp + (size_t)(4 * k4 + 3) * MODW);
#pragma unroll
            for (int r = 0; r < 17; ++r) { const f32x4 s = *(const LAS f32x4*)(scr + r * 256 + 4 * k4); acc[r] = acc[r] + w0 * s.x + w1 * s.y + w2 * s.z + w3 * s.w; }
        }
#pragma unroll
        for (int r = 0; r < 17; ++r) *(f32x4*)(modp + ((size_t)((l * 8 + ks) * 17 + r)) * MODW + cc * 256 + lane * 4) = acc[r];
        LDS_WAIT(); asm volatile("" ::: "memory");
    }
}
__device__ __forceinline__ void p0_tables(bf16_t* DFTN, bf16_t* DFTC, bf16_t* CSBD, f32x2* ROPE, size_t gtid, size_t NT) {
    for (size_t i = gtid; i < (size_t)1024 * 512 / 8; i += NT) {
        const int r = (int)(i >> 6), c0 = (int)(i & 63) * 8, g = r >> 8, t = (r >> 7) & 1, m = r & 127; float v[8];
#pragma unroll
        for (int e = 0; e < 8; ++e) { const int cp = c0 + e, c = cp & 127, j = (m * c) & 127; const float x = (float)j * (1.0f / 64.0f); v[e] = (cp >> 7) == g ? (t == 0 ? cospif(x) : sinpif(x)) : 0.f; }
        u32x4 o; o.x = pk2(v[0], v[1]); o.y = pk2(v[2], v[3]); o.z = pk2(v[4], v[5]); o.w = pk2(v[6], v[7]);
        *(u32x4*)(CSBD + i * 8) = o;
    }
    for (size_t i = gtid; i < (size_t)2048 * 4096 / 8; i += NT) {
        const int k = (int)(i >> 9), n0 = (int)(i & 511) * 8; float v[8];
#pragma unroll
        for (int e = 0; e < 8; ++e) { const int np = n0 + e, n = np & 2047, j = (k * n) & 2047; const float x = (float)j * (1.0f / 1024.0f); v[e] = np < 2048 ? cospif(x) : -sinpif(x); }
        u32x4 o; o.x = pk2(v[0], v[1]); o.y = pk2(v[2], v[3]); o.z = pk2(v[4], v[5]); o.w = pk2(v[6], v[7]);
        *(u32x4*)(DFTN + i * 8) = o;
    }
    for (size_t i = gtid; i < (size_t)256 * 512 / 8; i += NT) {
        const int k = (int)(i >> 6), n0 = (int)(i & 63) * 8; float v[8];
#pragma unroll
        for (int e = 0; e < 8; ++e) { const int np = n0 + e, n = np & 255, j = (k * n) & 255; const float x = (float)j * (1.0f / 128.0f); v[e] = np < 256 ? cospif(x) : -sinpif(x); }
        u32x4 o; o.x = pk2(v[0], v[1]); o.y = pk2(v[2], v[3]); o.z = pk2(v[4], v[5]); o.w = pk2(v[6], v[7]);
        *(u32x4*)(DFTC + i * 8) = o;
    }
    for (size_t i = gtid; i < (size_t)2048 * 32; i += NT) {
        const int pos = (int)(i >> 5), ii = (int)(i & 31), half = ii >> 4, fi = ii & 15;
        const float inv = exp2f(-(float)fi * (13.287712379549449f / 16.0f));
        const float ang = (float)(half ? (pos & 63) : (pos >> 6)) * inv;
        const float xr = ang * 0.3183098861837907f;
        ROPE[i] = (f32x2){cospif(xr), sinpif(xr)};
    }
}
__device__ __forceinline__ void p1_mod(const float* __restrict__ modp, const float* __restrict__ b_ada, float* __restrict__ mod, size_t gtid, size_t NT) {
    for (size_t i = gtid; i < (size_t)DEPTH * 17 * MODW; i += NT) {
        const int l = (int)(i / (17 * MODW)), rn = (int)(i % (17 * MODW)), n = rn % MODW;
        float s = b_ada[l * MODW + n];
#pragma unroll
        for (int ks = 0; ks < 8; ++ks) s += modp[(size_t)(l * 8 + ks) * 17 * MODW + rn];
        mod[i] = s;
    }
}
template <bool HAS_DELTA, bool WRITE_X>
__device__ __forceinline__ void resnorm_rows(const float* __restrict__ xlat, const float* __restrict__ xctx, const bf16_t* __restrict__ DL, float* __restrict__ xout, const float* __restrict__ gvec,
                                             const float* __restrict__ modl, int shoff, int scoff, bf16_t* __restrict__ H, int nrows, int gw, int NGW, int lane) {
    const int rpw = (nrows + NGW - 1) / NGW, r0 = gw * rpw, r1 = (r0 + rpw < nrows) ? r0 + rpw : nrows;
    int bcur = -1; f32x4 gm[8], sh[8];
    for (int row = r0; row < r1; ) {
        const int b = row < ML ? (row >> 11) : 16, bn = (row + 1) < ML ? ((row + 1) >> 11) : 16;
        const bool two = (row + 1 < r1) && (bn == b) && ((row + 1 == ML) == false);
        if (b != bcur) { bcur = b; const float* mrow = modl + (size_t)b * MODW;
#pragma unroll
            for (int j = 0; j < 8; ++j) { const int col = 4 * lane + 256 * j; gm[j] = *(const f32x4*)(gvec + col) * (*(const f32x4*)(mrow + scoff + col) + 1.0f); sh[j] = *(const f32x4*)(mrow + shoff + col); } }
        const float* xa = (row < ML ? xlat + (size_t)row * D : xctx + (size_t)(row - ML) * D) + 4 * lane;
        const float* xb = two ? xa + D : xa;
        f32x4 va[8], vb[8];
#pragma unroll
        for (int j = 0; j < 8; ++j) { va[j] = *(const f32x4*)(xa + 256 * j); vb[j] = *(const f32x4*)(xb + 256 * j); }
        if (HAS_DELTA) { const bf16_t* da = DL + (size_t)row * D + 4 * lane; const bf16_t* db = two ? da + D : da; u32x2 wa[8], wb[8];
#pragma unroll
            for (int j = 0; j < 8; ++j) { wa[j] = *(const u32x2*)(da + 256 * j); wb[j] = *(const u32x2*)(db + 256 * j); }
#pragma unroll
            for (int j = 0; j < 8; ++j) { va[j] = va[j] + (f32x4){__uint_as_float(wa[j].x << 16), __uint_as_float(wa[j].x & 0xffff0000u), __uint_as_float(wa[j].y << 16), __uint_as_float(wa[j].y & 0xffff0000u)};
                                          vb[j] = vb[j] + (f32x4){__uint_as_float(wb[j].x << 16), __uint_as_float(wb[j].x & 0xffff0000u), __uint_as_float(wb[j].y << 16), __uint_as_float(wb[j].y & 0xffff0000u)}; } }
        float sa = 0.f, sb = 0.f;
#pragma unroll
        for (int j = 0; j < 8; ++j) { sa += (va[j].x * va[j].x + va[j].y * va[j].y) + (va[j].z * va[j].z + va[j].w * va[j].w); sb += (vb[j].x * vb[j].x + vb[j].y * vb[j].y) + (vb[j].z * vb[j].z + vb[j].w * vb[j].w); }
#pragma unroll
        for (int o = 1; o < 64; o <<= 1) { sa += __shfl_xor(sa, o); sb += __shfl_xor(sb, o); }
        const float ra = 1.0f / sqrtf(sa * (1.0f / D) + EPS), rb = 1.0f / sqrtf(sb * (1.0f / D) + EPS);
        if (WRITE_X) { float* oa = xout + (size_t)row * D + 4 * lane;
#pragma unroll
            for (int j = 0; j < 8; ++j) { *(f32x4*)(oa + 256 * j) = va[j]; if (two) *(f32x4*)(oa + D + 256 * j) = vb[j]; } }
        bf16_t* ha = H + (size_t)row * D + 4 * lane;
#pragma unroll
        for (int j = 0; j < 8; ++j) { const f32x4 oa = (va[j] * ra) * gm[j] + sh[j], ob = (vb[j] * rb) * gm[j] + sh[j];
            u32x2 w; w.x = pk2(oa.x, oa.y); w.y = pk2(oa.z, oa.w); *(u32x2*)(ha + 256 * j) = w;
            if (two) { u32x2 w2; w2.x = pk2(ob.x, ob.y); w2.y = pk2(ob.z, ob.w); *(u32x2*)(ha + D + 256 * j) = w2; } }
        row += two ? 2 : 1;
    }
}
__device__ __forceinline__ void final_rows(const float* __restrict__ xs, const bf16_t* __restrict__ DL, const float* __restrict__ gvec, float* __restrict__ out, int gw, int NGW, int lane) {
    const int rpw = (ML + NGW - 1) / NGW, r0 = gw * rpw, r1 = (r0 + rpw < ML) ? r0 + rpw : ML;
    f32x4 g4[8];
#pragma unroll
    for (int j = 0; j < 8; ++j) g4[j] = *(const f32x4*)(gvec + 4 * lane + 256 * j);
    for (int row = r0; row < r1; ++row) {
        const float* xa = xs + (size_t)row * D + 4 * lane; const bf16_t* da = DL + (size_t)row * D + 4 * lane;
        f32x4 v[8]; u32x2 w[8]; float ss = 0.f;
#pragma unroll
        for (int j = 0; j < 8; ++j) { v[j] = *(const f32x4*)(xa + 256 * j); w[j] = *(const u32x2*)(da + 256 * j); }
#pragma unroll
        for (int j = 0; j < 8; ++j) { v[j] = v[j] + (f32x4){__uint_as_float(w[j].x << 16), __uint_as_float(w[j].x & 0xffff0000u), __uint_as_float(w[j].y << 16), __uint_as_float(w[j].y & 0xffff0000u)};
            ss += (v[j].x * v[j].x + v[j].y * v[j].y) + (v[j].z * v[j].z + v[j].w * v[j].w); }
        const float rstd = 1.0f / sqrtf(wave_sum(ss) * (1.0f / D) + EPS);
#pragma unroll
        for (int j = 0; j < 8; ++j) *(f32x4*)(out + (size_t)row * D + 4 * lane + 256 * j) = (v[j] * rstd) * g4[j];
    }
}
__device__ __forceinline__ void mix_conv(const bf16_t* __restrict__ P, const float* __restrict__ wc  , bf16_t* __restrict__ Y, int nrows, size_t gtid, size_t NT) {
    for (size_t it = gtid; it < (size_t)nrows * 64; it += NT) {
        const int row = (int)(it >> 6), c0 = (int)(it & 63) * 8;
        int n, L; if (row < ML) { n = row & 2047; L = 2048; } else { n = (row - ML) & 255; L = 256; }
        const bf16_t* pr = P + (size_t)row * NPROJ;
        float xc[8], gc[8], gb[8], zp[8], zn[8], t0[8], t1[8];
        unpack8(*(const u32x4*)(pr + OFF_AX + c0), xc); unpack8(*(const u32x4*)(pr + OFF_AC + c0), gc); unpack8(*(const u32x4*)(pr + OFF_AB + c0), gb);
        if (n > 0) { unpack8(*(const u32x4*)(pr - NPROJ + OFF_AX + c0), t0); unpack8(*(const u32x4*)(pr - NPROJ + OFF_AC + c0), t1);
#pragma unroll
            for (int e = 0; e < 8; ++e) zp[e] = t0[e] * t1[e]; }
        else {
#pragma unroll
            for (int e = 0; e < 8; ++e) zp[e] = 0.f; }
        if (n < L - 1) { unpack8(*(const u32x4*)(pr + NPROJ + OFF_AX + c0), t0); unpack8(*(const u32x4*)(pr + NPROJ + OFF_AC + c0), t1);
#pragma unroll
            for (int e = 0; e < 8; ++e) zn[e] = t0[e] * t1[e]; }
        else {
#pragma unroll
            for (int e = 0; e < 8; ++e) zn[e] = 0.f; }
        float o[8];
#pragma unroll
        for (int e = 0; e < 8; ++e) o[e] = gb[e] * (zp[e] * wc[c0 + e] + (gc[e] * xc[e]) * wc[512 + c0 + e] + zn[e] * wc[1024 + c0 + e]);
        u32x4 w; w.x = pk2(o[0], o[1]); w.y = pk2(o[2], o[3]); w.z = pk2(o[4], o[5]); w.w = pk2(o[6], o[7]);
        *(u32x4*)(Y + (size_t)row * D + c0) = w;
    }
}
typedef short bf16x8_t __attribute__((ext_vector_type(8)));
typedef short bf16x4_t __attribute__((ext_vector_type(4)));
constexpr int ATT_KS = 0, ATT_VT = 9216, ATT_LD = 72;
__device__ __forceinline__ void attn_item(const bf16_t* __restrict__ P, bf16_t* __restrict__ Y, const f32x2* __restrict__ rope, const float* __restrict__ sinkl, int b, int kvh, int qb, bool isctx, LAS unsigned char* lds, int tid) {
    LAS bf16_t* Ks = (LAS bf16_t*)(lds + ATT_KS); LAS bf16_t* Vt = (LAS bf16_t*)(lds + ATT_VT);
    const int lane = tid & 63, wave = __builtin_amdgcn_readfirstlane(tid >> 6), fr = lane & 15, fq = lane >> 4;
    const int g = wave >> 1, h = kvh * 4 + g, p0 = qb * 128 + (wave & 1) * 64;
    const float L2E = 1.4426950408889634f, QS = 0.125f * L2E;
    bf16x8_t Qf[4][2];
#pragma unroll
    for (int qblk = 0; qblk < 4; ++qblk) {
        const int qpos = p0 + qblk * 16 + fr;
        const size_t rowq = isctx ? (size_t)ML + b * 256 + qpos : (size_t)b * 2048 + qpos;
        const bf16_t* qp = P + rowq * NPROJ + OFF_Q + h * 64;
#pragma unroll
        for (int s = 0; s < 2; ++s) {
            if (isctx) Qf[qblk][s] = *(const bf16x8_t*)(qp + 32 * s + 8 * fq);
            else { const int which = fq >> 1, sub = fq & 1; float t1[8], t2[8];
                unpack8(*(const u32x4*)(qp + 32 * s + 8 * sub), t1); unpack8(*(const u32x4*)(qp + 32 * s + 16 + 8 * sub), t2);
                float o[8];
#pragma unroll
                for (int i = 0; i < 8; ++i) { const f32x2 cs = rope[qpos * 32 + s * 16 + sub * 8 + i]; o[i] = which == 0 ? (t1[i] * cs.x - t2[i] * cs.y) : (t2[i] * cs.x + t1[i] * cs.y); }
                u32x4 w; w.x = pk2(o[0], o[1]); w.y = pk2(o[2], o[3]); w.z = pk2(o[4], o[5]); w.w = pk2(o[6], o[7]);
                Qf[qblk][s] = __builtin_bit_cast(bf16x8_t, w); }
        }
    }
    f32x4 O[4][4]; float mrun[4], lsum[4];
    const float sk = sinkl[h] * L2E;
#pragma unroll
    for (int qblk = 0; qblk < 4; ++qblk) { mrun[qblk] = sk; lsum[qblk] = fq == 0 ? 1.0f : 0.0f;
#pragma unroll
        for (int db = 0; db < 4; ++db) O[qblk][db] = (f32x4){0.f, 0.f, 0.f, 0.f}; }
    const int ntiles = isctx ? 4 : 10;
#pragma unroll 1
    for (int t = 0; t < ntiles; ++t) {
        bool local; int k0;
        if (isctx) { local = false; k0 = t * 64; } else if (t < 6) { local = true; k0 = (qb - 1) * 128 + t * 64; } else { local = false; k0 = (t - 6) * 64; }
        if (local && (k0 < 0 || k0 >= 2048)) continue;
        __syncthreads();
        { const int j = tid >> 3, part = tid & 7, half = part >> 2, which = (part >> 1) & 1, sub = part & 1;
          const size_t rowk = local ? (size_t)b * 2048 + k0 + j : (size_t)ML + b * 256 + k0 + j;
          const bf16_t* kp = P + rowk * NPROJ + OFF_K + kvh * 64; const bf16_t* vp = P + rowk * NPROJ + OFF_V + kvh * 64 + part * 8;
          const u32x4 vraw = *(const u32x4*)vp;
          u32x4 kw;
          if (local) { float t1[8], t2[8], ko[8]; const int kpos = k0 + j;
              unpack8(*(const u32x4*)(kp + half * 32 + sub * 8), t1); unpack8(*(const u32x4*)(kp + half * 32 + 16 + sub * 8), t2);
#pragma unroll
              for (int i = 0; i < 8; ++i) { const f32x2 cs = rope[kpos * 32 + half * 16 + sub * 8 + i]; ko[i] = which == 0 ? (t1[i] * cs.x - t2[i] * cs.y) : (t2[i] * cs.x + t1[i] * cs.y); }
              kw.x = pk2(ko[0], ko[1]); kw.y = pk2(ko[2], ko[3]); kw.z = pk2(ko[4], ko[5]); kw.w = pk2(ko[6], ko[7]); }
          else kw = *(const u32x4*)(kp + part * 8);
          *(LAS u32x4*)(Ks + j * ATT_LD + part * 8) = kw;
          const unsigned vw[4] = {vraw.x, vraw.y, vraw.z, vraw.w};
#pragma unroll
          for (int i = 0; i < 4; ++i) { Vt[(part * 8 + 2 * i) * ATT_LD + j] = (bf16_t)(vw[i] & 0xffffu); Vt[(part * 8 + 2 * i + 1) * ATT_LD + j] = (bf16_t)(vw[i] >> 16); }
        }
        __syncthreads();
#pragma unroll 1
        for (int kb = 0; kb < 64; kb += 32) {
            const int kmin = k0 + kb;
            if (local && (kmin + 31 < p0 - 128 || kmin > p0 + 63 + 128)) continue;
            bf16x8_t Kf[2][2];
#pragma unroll
            for (int blk = 0; blk < 2; ++blk)
#pragma unroll
                for (int s = 0; s < 2; ++s) Kf[blk][s] = *(const LAS bf16x8_t*)(Ks + (kb + 16 * blk + fr) * ATT_LD + 32 * s + 8 * fq);
            bf16x8_t Vf[4];
#pragma unroll
            for (int db = 0; db < 4; ++db) { const LAS bf16_t* vp = Vt + (16 * db + fr) * ATT_LD + kb + 4 * fq;
                const bf16x4_t lo = *(const LAS bf16x4_t*)vp, hi = *(const LAS bf16x4_t*)(vp + 16);
                Vf[db] = __builtin_shufflevector(lo, hi, 0, 1, 2, 3, 4, 5, 6, 7); }
            const bool needmask = local && ((kmin + 31) - p0 > 128 || (p0 + 63) - kmin > 128);
#pragma unroll
            for (int qblk = 0; qblk < 4; ++qblk) {
                f32x4 S0 = (f32x4){0.f, 0.f, 0.f, 0.f}, S1 = S0;
                S0 = __builtin_amdgcn_mfma_f32_16x16x32_bf16(Kf[0][0], Qf[qblk][0], S0, 0, 0, 0); S0 = __builtin_amdgcn_mfma_f32_16x16x32_bf16(Kf[0][1], Qf[qblk][1], S0, 0, 0, 0);
                S1 = __builtin_amdgcn_mfma_f32_16x16x32_bf16(Kf[1][0], Qf[qblk][0], S1, 0, 0, 0); S1 = __builtin_amdgcn_mfma_f32_16x16x32_bf16(Kf[1][1], Qf[qblk][1], S1, 0, 0, 0);
                float sv[8];
#pragma unroll
                for (int r = 0; r < 4; ++r) { sv[r] = S0[r]; sv[4 + r] = S1[r]; }
                if (needmask) { const int qpos = p0 + qblk * 16 + fr;
#pragma unroll
                    for (int r = 0; r < 4; ++r) { int d0 = qpos - (kmin + 4 * fq + r); d0 = d0 < 0 ? -d0 : d0; int d1 = qpos - (kmin + 16 + 4 * fq + r); d1 = d1 < 0 ? -d1 : d1;
                        sv[r] = d0 <= 128 ? sv[r] : -__builtin_inff(); sv[4 + r] = d1 <= 128 ? sv[4 + r] : -__builtin_inff(); } }
                float cm = fmaxf(fmaxf(fmaxf(sv[0], sv[1]), fmaxf(sv[2], sv[3])), fmaxf(fmaxf(sv[4], sv[5]), fmaxf(sv[6], sv[7])));
                cm = fmaxf(cm, __shfl_xor(cm, 16)); cm = fmaxf(cm, __shfl_xor(cm, 32));
                const float mnew = fmaxf(mrun[qblk], cm * QS), sc = __builtin_amdgcn_exp2f(mrun[qblk] - mnew);
                float pp[8], ps = 0.f;
#pragma unroll
                for (int r = 0; r < 8; ++r) { pp[r] = __builtin_amdgcn_exp2f(__builtin_fmaf(sv[r], QS, -mnew)); ps += pp[r]; }
                lsum[qblk] = lsum[qblk] * sc + ps; mrun[qblk] = mnew;
                u32x4 pw; pw.x = pk2(pp[0], pp[1]); pw.y = pk2(pp[2], pp[3]); pw.z = pk2(pp[4], pp[5]); pw.w = pk2(pp[6], pp[7]);
                const bf16x8_t Pf = __builtin_bit_cast(bf16x8_t, pw);
#pragma unroll
                for (int db = 0; db < 4; ++db) { O[qblk][db] = O[qblk][db] * sc; O[qblk][db] = __builtin_amdgcn_mfma_f32_16x16x32_bf16(Vf[db], Pf, O[qblk][db], 0, 0, 0); }
            }
        }
    }
#pragma unroll
    for (int qblk = 0; qblk < 4; ++qblk) {
        float l = lsum[qblk]; l += __shfl_xor(l, 16); l += __shfl_xor(l, 32);
        const float rl = 1.0f / l;
        const int qpos = p0 + qblk * 16 + fr;
        const size_t rowq = isctx ? (size_t)ML + b * 256 + qpos : (size_t)b * 2048 + qpos;
        bf16_t* yp = Y + rowq * D + 1024 + h * 64 + 4 * fq;
#pragma unroll
        for (int db = 0; db < 4; ++db) { const f32x4 o = O[qblk][db] * rl; u32x2 w; w.x = pk2(o[0], o[1]); w.y = pk2(o[2], o[3]); *(u32x2*)(yp + 16 * db) = w; }
    }
}
__device__ __forceinline__ void mix_attn(const bf16_t* P, bf16_t* Y, const f32x2* rope, const float* sinkl, int nitems, LAS unsigned char* lds, int vcu, int G, int tid) {
    for (int it = vcu; it < nitems; it += G) {
        if (it < 512) { const int b = it >> 5, kvh = (it >> 4) & 1, qb = it & 15; attn_item(P, Y, rope, sinkl, b, kvh, qb, false, lds, tid); }
        else { const int r = it - 512, b = r >> 2, kvh = (r >> 1) & 1, qb = r & 1; attn_item(P, Y, rope, sinkl, b, kvh, qb, true, lds, tid); }
    }
    __syncthreads();
}
constexpr int MLP_LD = 136, MLP_WS = 0, MLP_VT = 128 * MLP_LD * 2;
__device__ __forceinline__ void mix_mlp(const bf16_t* __restrict__ P, const float* __restrict__ w_s  , const float* __restrict__ b_s  , bf16_t* __restrict__ Y, int nrows, LAS unsigned char* lds, int vcu, int G, int tid) {
    LAS bf16_t* Ws = (LAS bf16_t*)(lds + MLP_WS); LAS bf16_t* VnT = (LAS bf16_t*)(lds + MLP_VT);
    const int lane = tid & 63, wave = __builtin_amdgcn_readfirstlane(tid >> 6), fr = lane & 15, fq = lane >> 4;
    for (int it = vcu; it < (nrows / 128) * 4; it += G) {
        const int ch = it >> 2, g = it & 3; const size_t row0 = (size_t)ch * 128;
        __syncthreads();
        { const int p = tid >> 2, c0 = (tid & 3) * 32; const float* wp = w_s + (size_t)g * 16384 + p * 128 + c0;
#pragma unroll
          for (int j = 0; j < 4; ++j) { const f32x4 a = *(const f32x4*)(wp + 8 * j), b = *(const f32x4*)(wp + 8 * j + 4);
              u32x4 w; w.x = pk2(a.x, a.y); w.y = pk2(a.z, a.w); w.z = pk2(b.x, b.y); w.w = pk2(b.z, b.w);
              *(LAS u32x4*)(Ws + p * MLP_LD + c0 + 8 * j) = w; } }
        { const int q = tid >> 2, cp = tid & 3;
          const bf16_t* pr = P + (row0 + q) * NPROJ + OFF_MV + g * 128 + cp * 32;
          float vv[32];
#pragma unroll
          for (int j = 0; j < 4; ++j) unpack8(*(const u32x4*)(pr + 8 * j), vv + 8 * j);
          float s = 0.f;
#pragma unroll
          for (int i = 0; i < 32; ++i) { vv[i] = gelu_tanh(vv[i]); s += vv[i]; }
          s += __shfl_xor(s, 1); s += __shfl_xor(s, 2);
          const float mean = s * (1.0f / 128.0f); float qq = 0.f;
#pragma unroll
          for (int i = 0; i < 32; ++i) { vv[i] -= mean; qq += vv[i] * vv[i]; }
          qq += __shfl_xor(qq, 1); qq += __shfl_xor(qq, 2);
          const float rstd = 1.0f / sqrtf(qq * (1.0f / 128.0f) + EPS);
#pragma unroll
          for (int i = 0; i < 32; ++i) VnT[(cp * 32 + i) * MLP_LD + q] = (bf16_t)f2bf(vv[i] * rstd); }
        __syncthreads();
        bf16x8_t Wf[4];
#pragma unroll
        for (int ks = 0; ks < 4; ++ks) Wf[ks] = *(const LAS bf16x8_t*)(Ws + (16 * wave + fr) * MLP_LD + 32 * ks + 8 * fq);
        const int p = 16 * wave + fr; const float bias = b_s[g * 128 + p];
        const bf16_t* ur = P + (row0 + p) * NPROJ + OFF_U + g * 128 + 4 * fq;
        bf16_t* yr = Y + (row0 + p) * D + 1536 + g * 128 + 4 * fq;
#pragma unroll
        for (int cb = 0; cb < 8; ++cb) {
            f32x4 acc = (f32x4){0.f, 0.f, 0.f, 0.f};
#pragma unroll
            for (int ks = 0; ks < 4; ++ks) { const bf16x8_t Vf = *(const LAS bf16x8_t*)(VnT + (16 * cb + fr) * MLP_LD + 32 * ks + 8 * fq);
                acc = __builtin_amdgcn_mfma_f32_16x16x32_bf16(Vf, Wf[ks], acc, 0, 0, 0); }
            const u32x2 uw = *(const u32x2*)(ur + 16 * cb);
            const float u0 = gelu_tanh(__uint_as_float(uw.x << 16)), u1 = gelu_tanh(__uint_as_float(uw.x & 0xffff0000u)), u2 = gelu_tanh(__uint_as_float(uw.y << 16)), u3 = gelu_tanh(__uint_as_float(uw.y & 0xffff0000u));
            u32x2 w; w.x = pk2(u0 * (acc[0] + bias), u1 * (acc[1] + bias)); w.y = pk2(u2 * (acc[2] + bias), u3 * (acc[3] + bias));
            *(u32x2*)(yr + 16 * cb) = w;
        }
    }
    __syncthreads();
}
constexpr int PH_LAYER0 = 2, PH_PER_LAYER = 8, PH_FINAL = PH_LAYER0 + DEPTH * PH_PER_LAYER, NPH = PH_FINAL + 1;
#ifndef PROBE_DUP
#define PROBE_DUP 0
#endif
#ifndef MK_ONE_LAUNCH
#define MK_ONE_LAUNCH 1
#endif
struct Args { const float* in[18]; float* out; unsigned char* ws; int ph_lo, ph_hi, use_bar, pad; };
__global__ void __launch_bounds__(NTHREADS, 2) fwd(Args a) {
    extern __shared__ __attribute__((aligned(16))) unsigned char lds_raw[];
    LAS unsigned char* lds = (LAS unsigned char*)lds_raw;
    volatile LAS unsigned* MISC = (volatile LAS unsigned*)(lds + MISC_OFF);
    const int G = gridDim.x, bx = blockIdx.x, vcu = (G % 8 == 0) ? (bx % 8) * (G / 8) + bx / 8 : bx;
    const int NGW = G * NWAVES; const size_t NT = (size_t)G * NTHREADS;
#define TID_VARS int tid = threadIdx.x; asm volatile("" : "+v"(tid)); const int lane = tid & 63, wave = __builtin_amdgcn_readfirstlane(tid >> 6), gw = vcu * NWAVES + wave; const size_t gtid = (size_t)vcu * NTHREADS + tid; (void)lane; (void)gw; (void)gtid
    unsigned char* ws = a.ws;
    unsigned* ctl = (unsigned*)(ws + WS_CTL);
    for (int u = threadIdx.x; u < (LDS_BYTES - LDSCTL_OFF) / 4; u += NTHREADS) ((LAS unsigned*)(lds + LDSCTL_OFF))[u] = 0u;
    __syncthreads();
    XcdBarrier bar; bar.bar = ctl + CW_BAR; bar.x = 0; bar.st = nullptr;
    if (a.use_bar) bar = xcd_barrier_post(ctl + CW_BAR, MISC + 8);
    const int lo = a.ph_lo, hi = a.ph_hi;
#define IN(k) (lo <= (k) && (k) < hi)
#define SEAM(k) do { if (IN(k) && IN((k) + 1)) xcd_barrier(bar); } while (0)
#define REP(bit) for (int rep_ = 0; rep_ < (((PROBE_DUP) >> (bit)) & 1) + 1; ++rep_)
#define REPBAR() do { if (rep_ == 0 && a.use_bar && PROBE_DUP) xcd_barrier(bar); } while (0)
    const float* x = a.in[0]; const float* cvec = a.in[1]; const float* ctx = a.in[2]; const float* c_ctx = a.in[3]; const float* w_ada = a.in[4]; const float* b_ada = a.in[5];
    const float* g_norm1 = a.in[6]; const float* w_in = a.in[7]; const float* w_conv = a.in[8]; const float* sink = a.in[9]; const float* w_s = a.in[10]; const float* b_s = a.in[11];
    const float* w_out = a.in[12]; const float* g_norm2 = a.in[13]; const float* w_gate = a.in[14]; const float* w_up = a.in[15]; const float* w_down = a.in[16]; const float* g_final = a.in[17];
    bf16_t* WIN = (bf16_t*)(ws + WS_WIN); bf16_t* WOUT = (bf16_t*)(ws + WS_WOUT); bf16_t* WGU = (bf16_t*)(ws + WS_WGU); bf16_t* WDN = (bf16_t*)(ws + WS_WDN);
    float* MOD = (float*)(ws + WS_MOD); float* MODP = (float*)(ws + WS_MODP); float* XS = (float*)(ws + WS_XS);
    bf16_t* H = (bf16_t*)(ws + WS_H); bf16_t* P = (bf16_t*)(ws + WS_P); bf16_t* Y = (bf16_t*)(ws + WS_Y); bf16_t* HF = (bf16_t*)(ws + WS_HF);
    bf16_t* TT = (bf16_t*)(ws + WS_TT); bf16_t* TTC = (bf16_t*)(ws + WS_TTC); bf16_t* DFTN = (bf16_t*)(ws + WS_DFTN); bf16_t* DFTC = (bf16_t*)(ws + WS_DFTC);
    f32x2* ROPE = (f32x2*)(ws + WS_ROPE); bf16_t* CSBD = (bf16_t*)(ws + WS_CSBD); bf16_t* DL = (bf16_t*)(ws + WS_DL);

    REP(8) { if (rep_) xcd_barrier(bar);
    if (IN(0)) { TID_VARS;
        LAS float* scr = (LAS float*)(lds + wave * 17408);
        p0_modp(cvec, c_ctx, w_ada, MODP, scr, gw, NGW, lane);
        p0_transposes(w_in, w_out, w_gate, w_up, w_down, WIN, WOUT, WGU, WDN, scr, gw, NGW, lane);
        p0_tables(DFTN, DFTC, CSBD, ROPE, gtid, NT);
        SEAM(0);
    }
    if (IN(1)) { TID_VARS; p1_mod(MODP, b_ada, MOD, gtid, NT); SEAM(1); } }

    for (int l = 0; l < DEPTH; ++l) {
        const int pb = PH_LAYER0 + l * PH_PER_LAYER;
        const float* modl = MOD + (size_t)l * 17 * MODW;
        const bool lastl = (l == DEPTH - 1);
        const int Mrows = lastl ? ML : MT;
        if (IN(pb + 0)) { TID_VARS;
            if (l == 0) resnorm_rows<false, false>(x, ctx, nullptr, nullptr, g_norm1, modl, 0, D, H, MT, gw, NGW, lane);
            else resnorm_rows<true, true>(XS, XS + (size_t)ML * D, DL, XS, g_norm1 + l * D, modl, 0, D, H, MT, gw, NGW, lane);
            SEAM(pb + 0); }
        REP(1) { if (rep_) xcd_barrier(bar);
        if (IN(pb + 1)) {
            pg8::Gemm g{H, WIN + (size_t)l * NPROJ * D, Mrows, NPROJ, D, D, D}; pg8::OrderIn S; S.init(Mrows, NPROJ, G, bx); S.extra = lastl ? 16 : 0;
            pg8::EpiP E{P, NPROJ};
            pg8::gemm_phase<pg8::EpiP, pg8::OrderIn, true, true>(lds, g, S, E);
            SEAM(pb + 1);
        } }
        REP(2) { if (rep_) xcd_barrier(bar);
        if (IN(pb + 2)) {
            REP(9) { pg8::Gemm g{CSBD, P + OFF_F, 1024, Mrows, 512, 512, NPROJ}; pg8::StaticOrder S; S.init(1024, Mrows, G, bx);
              pg8::EpiFour1 E{TT, TTC};
              pg8::gemm_phase<pg8::EpiFour1, pg8::StaticOrder, true, true>(lds, g, S, E); }
            TID_VARS;
            REP(10) mix_conv(P, w_conv + (size_t)l * 3 * 512, Y, Mrows, gtid, NT);
            REP(11) mix_attn(P, Y, ROPE, sink + l * 8, lastl ? 512 : 576, lds, vcu, G, tid);
            REP(12) mix_mlp(P, w_s + (size_t)l * 4 * 128 * 128, b_s + (size_t)l * 4 * 128, Y, Mrows, lds, vcu, G, tid);
            SEAM(pb + 2);
        } }
        REP(3) { if (rep_) xcd_barrier(bar);
        if (IN(pb + 3)) {
            { pg8::Gemm g{DFTN, TT, 2048, 8192, 4096, 4096, 4096}; pg8::StaticOrder S; S.init(2048, 8192, G, bx);
              pg8::EpiFour E{Y, 1.0f / 512.0f, 0, 2048};
              pg8::gemm_phase<pg8::EpiFour, pg8::StaticOrder, true, true>(lds, g, S, E); }
            if (!lastl) { pg8::Gemm g{DFTC, TTC, 256, 8192, 512, 512, 512}; pg8::StaticOrder S; S.init(256, 8192, G, bx);
              pg8::EpiFour E{Y, 0.005524271728019903f  , ML, 256};
              pg8::gemm_phase<pg8::EpiFour, pg8::StaticOrder, true, true>(lds, g, S, E); }
            SEAM(pb + 3);
        } }
        REP(4) { if (rep_) xcd_barrier(bar);
        if (IN(pb + 4)) {
            pg8::Gemm g{Y, WOUT + (size_t)l * D * D, Mrows, D, D, D, D}; pg8::StaticOrder S; S.init(Mrows, D, G, bx);
            pg8::EpiDelta E{DL, modl, 2 * D};
            pg8::gemm_phase<pg8::EpiDelta, pg8::StaticOrder, true, true>(lds, g, S, E);
            SEAM(pb + 4);
        } }
        if (IN(pb + 5)) { TID_VARS;
            resnorm_rows<true, true>(l == 0 ? x : XS, l == 0 ? ctx : XS + (size_t)ML * D, DL, XS, g_norm2 + l * D, modl, 3 * D, 4 * D, H, Mrows, gw, NGW, lane);
            SEAM(pb + 5); }
        REP(6) { if (rep_) xcd_barrier(bar);
        if (IN(pb + 6)) {
            pg8::Gemm g{H, WGU + (size_t)l * NGU * D, Mrows, NGU, D, D, D}; pg8::StaticOrder S; S.init(Mrows, NGU, G, bx);
            pg8::EpiGU E{HF};
            pg8::gemm_phase<pg8::EpiGU, pg8::StaticOrder, true, true>(lds, g, S, E);
            SEAM(pb + 6);
        } }
        REP(7) { if (rep_) xcd_barrier(bar);
        if (IN(pb + 7)) {
            pg8::Gemm g{HF, WDN + (size_t)l * D * DFF, Mrows, D, DFF, DFF, DFF}; pg8::StaticOrder S; S.init(Mrows, D, G, bx);
            pg8::EpiDelta E{DL, modl, 5 * D};
            pg8::gemm_phase<pg8::EpiDelta, pg8::StaticOrder, true, true>(lds, g, S, E);
            SEAM(pb + 7);
        } }
    }
    if (IN(PH_FINAL)) { TID_VARS; final_rows(XS, DL, g_final, a.out, gw, NGW, lane); }
#undef IN
#undef SEAM
}

extern "C" void kernel_launch(void* const* d_in, const int* in_sizes, int n_in, void* d_out, int out_size, void* d_ws, size_t ws_size, hipStream_t stream) {
    static int grid = 0;
    if (grid == 0) {
        if (n_in != 18 || in_sizes[0] != ML * D || out_size != ML * D || ws_size < WS_END) { fprintf(stderr, "kernel_launch: unexpected shapes: n_in %d in0 %d out %d ws %zu (need %zu)\n", n_in, n_in > 0 ? in_sizes[0] : -1, out_size, ws_size, (size_t)WS_END); grid = -1; return; }
        int dev = 0, cus = 0, per_cu = 0;
        if (hipGetDevice(&dev) != hipSuccess || hipDeviceGetAttribute(&cus, hipDeviceAttributeMultiprocessorCount, dev) != hipSuccess) { fprintf(stderr, "kernel_launch: device query failed\n"); grid = -1; return; }
        if (hipFuncSetAttribute((const void*)fwd, hipFuncAttributeMaxDynamicSharedMemorySize, LDS_BYTES) != hipSuccess) { fprintf(stderr, "kernel_launch: hipFuncSetAttribute failed\n"); grid = -1; return; }
        if (hipOccupancyMaxActiveBlocksPerMultiprocessor(&per_cu, (const void*)fwd, NTHREADS, LDS_BYTES) != hipSuccess || per_cu < 1) fprintf(stderr, "kernel_launch: note: occupancy query reports %d workgroups per CU\n", per_cu);
        (void)hipGetLastError();
        grid = cus;
    }
    if (grid < 0) return;
    if (hipMemsetAsync((char*)d_ws + WS_CTL, 0, CTL_ZERO_BYTES, stream) != hipSuccess) { fprintf(stderr, "kernel_launch: memset failed\n"); return; }
    Args a{};
    for (int i = 0; i < 18; ++i) a.in[i] = (const float*)d_in[i];
    a.out = (float*)d_out; a.ws = (unsigned char*)d_ws; a.pad = 0;
#if MK_ONE_LAUNCH
    a.ph_lo = 0; a.ph_hi = NPH; a.use_bar = 1;
    hipLaunchKernelGGL(fwd, dim3(grid), dim3(NTHREADS), LDS_BYTES, stream, a);
#else
    for (int ph = 0; ph < NPH; ++ph) { a.ph_lo = ph; a.ph_hi = ph + 1; a.use_bar = 0; hipLaunchKernelGGL(fwd, dim3(grid), dim3(NTHREADS), LDS_BYTES, stream, a); }
#endif
    const hipError_t le = hipPeekAtLastError();
    if (le != hipSuccess) fprintf(stderr, "kernel_launch: launch failed: %s\n", hipGetErrorName(le));
}
```

```cpp
#include <hip/hip_runtime.h>
#include <cstdio>
#include <cstdint>
namespace pg8 {
#define PG8_LAS __attribute__((address_space(3)))
typedef unsigned short bf16_t;
typedef short bf16x8 __attribute__((ext_vector_type(8)));
typedef float f32x4 __attribute__((ext_vector_type(4)));
typedef unsigned u32x4 __attribute__((ext_vector_type(4)));
constexpr int BM = 256, BK = 64, HALF = 128, HTB = HALF * BK * 2  , STAGE_BYTES = 8 * HTB, NXCD = 8, WGM = 8;

__host__ __device__ __forceinline__ int lds_byte(int r, int c) { const int st = (r >> 4) * 2 + (c >> 5), rr = r & 15, cc = c & 31, ob = rr * 64 + cc * 2; return st * 1024 + (ob ^ (((ob >> 9) & 1) << 5)); }
__host__ __device__ __forceinline__ void stage_rc(int b, int& R, int& C) { const int st = b / 1024, sb = b % 1024, swz = sb ^ (((sb >> 9) & 1) << 5); R = (st >> 1) * 16 + swz / 64; C = (st & 1) * 32 + (swz % 64) / 2; }
__host__ __device__ __forceinline__ int perm32(int rho) { const int n = rho >> 4, i = rho & 15; return 8 * (i >> 2) + 4 * n + (i & 3); }

struct Unit { int pm, pn, bo; };
struct Gemm { const bf16_t* A; const bf16_t* Bt; int M, N, K, lda, ldb; };

struct StaticOrder {
    int nM, nN, nwg, G, c;
    __host__ __device__ void init(int M, int N, int G_, int c_) { nM = M / BM; nN = N / BM; nwg = nM * nN; G = G_; c = c_; }
    __host__ __device__ bool next(int i, Unit& u) const {
        const long L = (long)i * G + c; if (L >= nwg) return false;
        int wgid = (int)L; { const int q = nwg / NXCD, r = nwg % NXCD, xcd = wgid % NXCD, off = wgid / NXCD; wgid = (xcd < r ? xcd * (q + 1) : r * (q + 1) + (xcd - r) * q) + off; }
        const int nig = WGM * nN, gid = wgid / nig, fm = gid * WGM, gsz = (nM - fm) < WGM ? (nM - fm) : WGM;
        u.pm = fm + ((wgid % nig) % gsz); u.pn = (wgid % nig) / gsz; u.bo = 0; return true;
    }
    __device__ __forceinline__ void a_ready(const Unit&) const {}
    __device__ __forceinline__ void done(const Unit&) const {}
};

struct OrderIn : StaticOrder {
    int extra;
    __host__ __device__ bool next(int i, Unit& u) const {
        const long L = (long)i * G + c; if (L < nwg) return StaticOrder::next(i, u);
        const long j = L - nwg; if (j >= extra) return false;
        u.pm = 128 + (int)j; u.pn = 10; u.bo = 0; return true;
    }
};
struct OrderFour1 {
    int nwg, G, c;
    __host__ __device__ void init(int npanels, int G_, int c_) { nwg = 4 * npanels; G = G_; c = c_; }
    __host__ __device__ bool next(int i, Unit& u) const { const long L = (long)i * G + c; if (L >= nwg) return false; u.pm = (int)(L & 3); u.pn = (int)(L >> 2); u.bo = u.pm * 128; return true; }
    __device__ __forceinline__ void a_ready(const Unit&) const {}
    __device__ __forceinline__ void done(const Unit&) const {}
};
typedef float f32x2 __attribute__((ext_vector_type(2)));
typedef unsigned u32x2 __attribute__((ext_vector_type(2)));
typedef __bf16 bf16x2_hw __attribute__((ext_vector_type(2)));
__device__ __forceinline__ unsigned cvt_pk_bf16(float lo, float hi) { const f32x2 v = {lo, hi}; const bf16x2_hw b = __builtin_convertvector(v, bf16x2_hw); return __builtin_bit_cast(unsigned, b); }
__device__ __forceinline__ float silu_f(float x) { return x * __builtin_amdgcn_rcpf(1.0f + __expf(-x)); }
struct EpiP {
    static constexpr bool PERM = true, AFTER_DRAIN = false; static constexpr int NSTORES = 16;
    bf16_t* O; int ldc; const PG8_LAS float* rope;
    __device__ __forceinline__ void operator()(const f32x4 (&acc)[2][2][4][2], const Unit& u, int wr, int wc, int fr, int fq) const {
        const int row0 = u.pm * BM + wr * 64 + fr;
        if (u.pn < 4) {
            bf16_t* zp = O + (size_t)row0 * ldc + u.pn * HALF + wc * 32 + 8 * fq;
#pragma unroll
            for (int ai = 0; ai < 2; ++ai)
#pragma unroll
                for (int m = 0; m < 4; ++m) { const f32x4 v0 = acc[ai][0][m][0] * acc[ai][1][m][0], v1 = acc[ai][0][m][1] * acc[ai][1][m][1];
                    u32x4 w; w.x = cvt_pk_bf16(v0[0], v0[1]); w.y = cvt_pk_bf16(v0[2], v0[3]); w.z = cvt_pk_bf16(v1[0], v1[1]); w.w = cvt_pk_bf16(v1[2], v1[3]);
                    *(u32x4*)(zp + (size_t)(ai * HALF + m * 16) * ldc) = w; }
            return;
        }
        const int col0 = (u.pn < 6 ? u.pn - 2 : u.pn) * BM + wc * 32 + 8 * fq;
        const bool qk = (u.pm < 128) && (u.pn >= 8) && (u.pn <= 10);
        const float sgn = (fq >> 1) ? 1.0f : -1.0f; const bool lo = fq < 2;
#pragma unroll
        for (int ai = 0; ai < 2; ++ai)
#pragma unroll
            for (int m = 0; m < 4; ++m) { const int row = row0 + ai * HALF + m * 16; bf16_t* rowp = O + (size_t)row * ldc + col0;
                f32x4 cs[4];
                if (qk) { const int pos = row & 2047, coord = (wc & 1) ? 32 + (pos & 63) : (pos >> 6); const PG8_LAS float* rp = rope + (coord * 16 + (fq & 1) * 8) * 2;
#pragma unroll
                    for (int k = 0; k < 4; ++k) cs[k] = *(const PG8_LAS f32x4*)(rp + 4 * k); }
#pragma unroll
                for (int bj = 0; bj < 2; ++bj) { f32x4 v0 = acc[ai][bj][m][0], v1 = acc[ai][bj][m][1];
                    if (qk && (u.pn != 10 || bj == 0)) {
                        f32x4 p0, p1;
#pragma unroll
                        for (int e = 0; e < 4; ++e) {
                            const u32x2 s0 = __builtin_amdgcn_permlane32_swap(__float_as_uint(v0[e]), __float_as_uint(v0[e]), false, false); p0[e] = __uint_as_float(lo ? s0.y : s0.x);
                            const u32x2 s1 = __builtin_amdgcn_permlane32_swap(__float_as_uint(v1[e]), __float_as_uint(v1[e]), false, false); p1[e] = __uint_as_float(lo ? s1.y : s1.x); }
                        v0[0] = v0[0] * cs[0].x + sgn * (p0[0] * cs[0].y); v0[1] = v0[1] * cs[0].z + sgn * (p0[1] * cs[0].w);
                        v0[2] = v0[2] * cs[1].x + sgn * (p0[2] * cs[1].y); v0[3] = v0[3] * cs[1].z + sgn * (p0[3] * cs[1].w);
                        v1[0] = v1[0] * cs[2].x + sgn * (p1[0] * cs[2].y); v1[1] = v1[1] * cs[2].z + sgn * (p1[1] * cs[2].w);
                        v1[2] = v1[2] * cs[3].x + sgn * (p1[2] * cs[3].y); v1[3] = v1[3] * cs[3].z + sgn * (p1[3] * cs[3].w);
                    }
                    u32x4 w; w.x = cvt_pk_bf16(v0[0], v0[1]); w.y = cvt_pk_bf16(v0[2], v0[3]); w.z = cvt_pk_bf16(v1[0], v1[1]); w.w = cvt_pk_bf16(v1[2], v1[3]);
                    *(u32x4*)(rowp + bj * HALF) = w; } }
    }
};
struct EpiRes {
    static constexpr bool PERM = true, AFTER_DRAIN = false; static constexpr int NSTORES = 16;
    bf16_t* XS; const float* modl; int goff, pm_off;
    __device__ __forceinline__ void operator()(const f32x4 (&acc)[2][2][4][2], const Unit& u, int wr, int wc, int fr, int fq) const {
        const int pm = u.pm + pm_off, b = pm < 128 ? (pm >> 3) : 16;
        const int row0 = pm * BM + wr * 64 + fr, col0 = u.pn * BM + wc * 32 + 8 * fq;
        const float* gate = modl + (size_t)b * 12288 + goff;
        f32x4 gv[2][2];
#pragma unroll
        for (int bj = 0; bj < 2; ++bj)
#pragma unroll
            for (int n = 0; n < 2; ++n) gv[bj][n] = *(const f32x4*)(gate + col0 + bj * HALF + 4 * n);
#pragma unroll
        for (int ai = 0; ai < 2; ++ai) {
            u32x4 xw[4][2];
#pragma unroll
            for (int m = 0; m < 4; ++m)
#pragma unroll
                for (int bj = 0; bj < 2; ++bj) xw[m][bj] = *(const u32x4*)(XS + (size_t)(row0 + ai * HALF + m * 16) * 2048 + col0 + bj * HALF);
#pragma unroll
            for (int m = 0; m < 4; ++m) { bf16_t* rowp = XS + (size_t)(row0 + ai * HALF + m * 16) * 2048 + col0;
#pragma unroll
                for (int bj = 0; bj < 2; ++bj) { const u32x4 xv = xw[m][bj];
                    const f32x4 x0 = {__uint_as_float(xv.x << 16), __uint_as_float(xv.x & 0xffff0000u), __uint_as_float(xv.y << 16), __uint_as_float(xv.y & 0xffff0000u)};
                    const f32x4 x1 = {__uint_as_float(xv.z << 16), __uint_as_float(xv.z & 0xffff0000u), __uint_as_float(xv.w << 16), __uint_as_float(xv.w & 0xffff0000u)};
                    const f32x4 v0 = x0 + acc[ai][bj][m][0] * gv[bj][0], v1 = x1 + acc[ai][bj][m][1] * gv[bj][1];
                    u32x4 w; w.x = cvt_pk_bf16(v0[0], v0[1]); w.y = cvt_pk_bf16(v0[2], v0[3]); w.z = cvt_pk_bf16(v1[0], v1[1]); w.w = cvt_pk_bf16(v1[2], v1[3]);
                    *(u32x4*)(rowp + bj * HALF) = w; } }
        }
    }
};
struct EpiGU {
    static constexpr bool PERM = true, AFTER_DRAIN = false; static constexpr int NSTORES = 8;
    bf16_t* O;
    __device__ __forceinline__ void operator()(const f32x4 (&acc)[2][2][4][2], const Unit& u, int wr, int wc, int fr, int fq) const {
        const int row0 = u.pm * BM + wr * 64 + fr, col0 = u.pn * HALF + wc * 32 + 8 * fq;
#pragma unroll
        for (int ai = 0; ai < 2; ++ai)
#pragma unroll
            for (int mp = 0; mp < 4; mp += 2) {
                f32x2 gg[8], uu[8], e[8];
#pragma unroll
                for (int q = 0; q < 2; ++q)
#pragma unroll
                    for (int n = 0; n < 2; ++n) { const f32x4 ga = acc[ai][0][mp + q][n], ua = acc[ai][1][mp + q][n];
                        gg[q * 4 + n * 2] = (f32x2){ga[0], ga[1]}; gg[q * 4 + n * 2 + 1] = (f32x2){ga[2], ga[3]}; uu[q * 4 + n * 2] = (f32x2){ua[0], ua[1]}; uu[q * 4 + n * 2 + 1] = (f32x2){ua[2], ua[3]}; }
#pragma unroll
                for (int i = 0; i < 8; ++i) { const f32x2 t = gg[i] * -1.4426950408889634f; e[i] = (f32x2){__builtin_amdgcn_exp2f(t[0]), __builtin_amdgcn_exp2f(t[1])}; }
#pragma unroll
                for (int i = 0; i < 8; ++i) { const f32x2 d = e[i] + 1.0f; e[i] = (f32x2){__builtin_amdgcn_rcpf(d[0]), __builtin_amdgcn_rcpf(d[1])}; }
#pragma unroll
                for (int i = 0; i < 8; ++i) e[i] = (gg[i] * uu[i]) * e[i];
#pragma unroll
                for (int q = 0; q < 2; ++q) { bf16_t* rowp = O + (size_t)(row0 + ai * HALF + (mp + q) * 16) * 5632 + col0;
                    u32x4 w; w.x = cvt_pk_bf16(e[q * 4 + 0][0], e[q * 4 + 0][1]); w.y = cvt_pk_bf16(e[q * 4 + 1][0], e[q * 4 + 1][1]); w.z = cvt_pk_bf16(e[q * 4 + 2][0], e[q * 4 + 2][1]); w.w = cvt_pk_bf16(e[q * 4 + 3][0], e[q * 4 + 3][1]);
                    *(u32x4*)rowp = w; }
            }
    }
};
struct EpiFour {
    static constexpr bool PERM = true, AFTER_DRAIN = false; static constexpr int NSTORES = 16;
    bf16_t* Y; float scale; int row_base, rows_per_batch;
    __device__ __forceinline__ void operator()(const f32x4 (&acc)[2][2][4][2], const Unit& u, int wr, int wc, int fr, int fq) const {
        const int row0 = row_base + (u.pn >> 1) * rows_per_batch + u.pm * BM + wr * 64 + fr, col0 = 512 + (u.pn & 1) * BM + wc * 32 + 8 * fq;
#pragma unroll
        for (int ai = 0; ai < 2; ++ai)
#pragma unroll
            for (int m = 0; m < 4; ++m) { bf16_t* rowp = Y + (size_t)(row0 + ai * HALF + m * 16) * 2048 + col0;
#pragma unroll
                for (int bj = 0; bj < 2; ++bj) { const f32x4 v0 = acc[ai][bj][m][0] * scale, v1 = acc[ai][bj][m][1] * scale;
                    u32x4 w; w.x = cvt_pk_bf16(v0[0], v0[1]); w.y = cvt_pk_bf16(v0[2], v0[3]); w.z = cvt_pk_bf16(v1[0], v1[1]); w.w = cvt_pk_bf16(v1[2], v1[3]);
                    *(u32x4*)(rowp + bj * HALF) = w; } }
    }
};
struct EpiFourEO {
    static constexpr bool PERM = true, AFTER_DRAIN = false; static constexpr int NSTORES = 16;
    bf16_t* Y; float scale;
    __device__ __forceinline__ void operator()(const f32x4 (&acc)[2][2][4][2], const Unit& u, int wr, int wc, int fr, int fq) const {
        const int rowb = (u.pn >> 1) * 2048, col0 = 512 + (u.pn & 1) * BM + wc * 32 + 8 * fq;
#pragma unroll
        for (int m = 0; m < 4; ++m) { const int k = u.pm * HALF + wr * 64 + m * 16 + fr;
            bf16_t* ra = Y + (size_t)(rowb + k) * 2048 + col0; bf16_t* rb = Y + (size_t)(rowb + 2048 - k) * 2048 + col0;
#pragma unroll
            for (int bj = 0; bj < 2; ++bj) { const f32x4 e0 = acc[0][bj][m][0] * scale, e1 = acc[0][bj][m][1] * scale, o0 = acc[1][bj][m][0] * scale, o1 = acc[1][bj][m][1] * scale;
                const f32x4 a0 = e0 - o0, a1 = e1 - o1, b0 = e0 + o0, b1 = e1 + o1;
                u32x4 w; w.x = cvt_pk_bf16(a0[0], a0[1]); w.y = cvt_pk_bf16(a0[2], a0[3]); w.z = cvt_pk_bf16(a1[0], a1[1]); w.w = cvt_pk_bf16(a1[2], a1[3]);
                *(u32x4*)(ra + bj * HALF) = w;
                u32x4 v; v.x = cvt_pk_bf16(b0[0], b0[1]); v.y = cvt_pk_bf16(b0[2], b0[3]); v.z = cvt_pk_bf16(b1[0], b1[1]); v.w = cvt_pk_bf16(b1[2], b1[3]);
                if (k > 0) *(u32x4*)(rb + bj * HALF) = v; } }
    }
};
struct EpiFour1 {
    static constexpr bool PERM = true, AFTER_DRAIN = false; static constexpr int NSTORES = 16;
    bf16_t* TT; bf16_t* TTC;
    __device__ __forceinline__ void operator()(const f32x4 (&acc)[2][2][4][2], const Unit& u, int wr, int wc, int fr, int fq) const {
        const int g = u.pm; bf16_t* base; size_t chs, half;
        if (u.pn < 128) { const int b = u.pn >> 3, n0 = (u.pn & 7) * BM + wc * 32 + 8 * fq; base = TT + (size_t)(b * 512 + g * 128) * 4096 + n0; chs = 4096; half = 2048; }
        else { const int b = u.pn - 128, n0 = wc * 32 + 8 * fq; base = TTC + (size_t)(b * 512 + g * 128) * 512 + n0; chs = 512; half = 256; }
#pragma unroll
        for (int ai = 0; ai < 2; ++ai)
#pragma unroll
            for (int m = 0; m < 4; ++m) { bf16_t* rowp = base + (size_t)(wr * 64 + m * 16 + fr) * chs + ai * half;
#pragma unroll
                for (int bj = 0; bj < 2; ++bj) { const f32x4 v0 = acc[ai][bj][m][0], v1 = acc[ai][bj][m][1];
                    u32x4 w; w.x = cvt_pk_bf16(v0[0], v0[1]); w.y = cvt_pk_bf16(v0[2], v0[3]); w.z = cvt_pk_bf16(v1[0], v1[1]); w.w = cvt_pk_bf16(v1[2], v1[3]);
                    *(u32x4*)(rowp + bj * HALF) = w; } }
    }
};
template <class Epi, class Sched, bool ALIGN_EPI = false, bool SP2 = false, bool EO = false>
__device__ __forceinline__ void gemm_phase(PG8_LAS unsigned char* lds, const Gemm g, const Sched& S, const Epi& E) {
    int tid_ = threadIdx.x; asm volatile("" : "+v"(tid_));
    const int tid = tid_, wid = __builtin_amdgcn_readfirstlane(tid >> 6), lane = tid & 63, wr = wid >> 2, wc = wid & 3, fr = lane & 15, fq = lane >> 4;
    const int K = g.K, nt = K / BK;
    unsigned voffA[2], voffB[2];
#pragma unroll
    for (int i = 0; i < 2; ++i) { int R, C; stage_rc(tid * 16 + i * 8192, R, C); const int Rb = Epi::PERM ? ((R & ~31) + perm32(R & 31)) : R;
        voffA[i] = (unsigned)(R * g.lda + C) * 2u; voffB[i] = (unsigned)(Rb * g.ldb + C) * 2u; }
    const size_t kstep = (size_t)(BK * 2);
    const size_t hstepA = (size_t)HALF * g.lda * 2, hstepB = (size_t)HALF * g.ldb * 2;
    const size_t tstepA = 2 * hstepA, tstepB = 2 * hstepB;
    const unsigned ldsw = (unsigned)wid * 1024u;
    const int aoff = lds_byte(wr * 64 + fr, fq * 8), boff = lds_byte(wc * 32 + fr, fq * 8);
#define PG8_SA(b, h) (((b) * 2 + (h)) * HTB)
#define PG8_SB(b, h) ((4 + (b) * 2 + (h)) * HTB)
#define PG8_STAGE(bufoff, gbase, voff) do { _Pragma("unroll") for (int _i = 0; _i < 2; ++_i) \
        __builtin_amdgcn_global_load_lds((const unsigned*)((const char*)(gbase) + (voff)[_i]), (PG8_LAS unsigned*)(lds + (bufoff) + ldsw + _i * 8192), 16, 0, 0); } while (0)
#define PG8_LDA(dst, b, h) do { _Pragma("unroll") for (int m = 0; m < 4; ++m) _Pragma("unroll") for (int k = 0; k < 2; ++k) dst[m][k] = *(const PG8_LAS bf16x8*)(lds + PG8_SA(b, h) + aoff + m * 2048 + k * 1024); } while (0)
#define PG8_LDB(dst, b, h) do { _Pragma("unroll") for (int n = 0; n < 2; ++n) _Pragma("unroll") for (int k = 0; k < 2; ++k) dst[n][k] = *(const PG8_LAS bf16x8*)(lds + PG8_SB(b, h) + boff + n * 2048 + k * 1024); } while (0)
#define PG8_MMA(ai, bj, At, Bt) do { __builtin_amdgcn_s_setprio(1); _Pragma("unroll") for (int m = 0; m < 4; ++m) _Pragma("unroll") for (int n = 0; n < 2; ++n) _Pragma("unroll") for (int k = 0; k < 2; ++k) \
        acc[ai][bj][m][n] = __builtin_amdgcn_mfma_f32_16x16x32_bf16(Bt[n][k], At[m][k], acc[ai][bj][m][n], 0, 0, 0); __builtin_amdgcn_s_setprio(0); } while (0)
#define PG8_WAIT_V(n) asm volatile("s_waitcnt vmcnt(" #n ")" ::: "memory")
#define PG8_WAIT_L(n) asm volatile("s_waitcnt lgkmcnt(" #n ")" ::: "memory")
#define PG8_BAR __builtin_amdgcn_s_barrier()
#define PG8_SCHED __builtin_amdgcn_sched_barrier(0)
    Unit cur, nxt; int ui = 0;
    if (!S.next(0, cur)) return;
    f32x4 acc[2][2][4][2];
#pragma unroll
    for (int a = 0; a < 2; ++a)
#pragma unroll
        for (int b = 0; b < 2; ++b)
#pragma unroll
            for (int m = 0; m < 4; ++m)
#pragma unroll
                for (int n = 0; n < 2; ++n) acc[a][b][m][n] = (f32x4){0.f, 0.f, 0.f, 0.f};
    bf16x8 At[4][2], B0[2][2], B1[2][2];
    const char* cA = (const char*)g.A + (size_t)cur.pm * tstepA; const char* cB = (const char*)g.Bt + (size_t)cur.pn * tstepB + (size_t)cur.bo * 2;
    S.a_ready(cur);
    if constexpr (SP2) {
        PG8_STAGE(PG8_SB(0, 0), cB, voffB); PG8_STAGE(PG8_SB(0, 1), cB + hstepB, voffB); PG8_STAGE(PG8_SA(0, 0), cA, voffA); PG8_STAGE(PG8_SA(0, 1), cA + hstepA, voffA);
        if (wr == 1) PG8_BAR;
        PG8_WAIT_V(2); PG8_BAR;
        PG8_STAGE(PG8_SB(1, 0), cB + kstep, voffB); PG8_STAGE(PG8_SA(1, 0), cA + kstep, voffA); PG8_STAGE(PG8_SB(1, 1), cB + hstepB + kstep, voffB);
        PG8_WAIT_V(6); PG8_BAR;
    } else {
        PG8_STAGE(PG8_SB(0, 0), cB, voffB); PG8_STAGE(PG8_SA(0, 0), cA, voffA); PG8_STAGE(PG8_SB(0, 1), cB + hstepB, voffB); PG8_STAGE(PG8_SA(0, 1), cA + hstepA, voffA);
        if (wr == 1) PG8_BAR;
        PG8_WAIT_V(4); PG8_BAR;
        PG8_STAGE(PG8_SB(1, 0), cB + kstep, voffB); PG8_STAGE(PG8_SA(1, 0), cA + kstep, voffA); PG8_STAGE(PG8_SB(1, 1), cB + hstepB + kstep, voffB);
        PG8_WAIT_V(6); PG8_BAR;
    }
    for (;;) {
        const bool has_next = S.next(ui + 1, nxt);
        const char* nA = has_next ? (const char*)g.A + (size_t)nxt.pm * tstepA : cA; const char* nB = has_next ? (const char*)g.Bt + (size_t)nxt.pn * tstepB + (size_t)nxt.bo * 2 : cB;
        for (int t = 0; t < nt; t += 2) {
            const bool last = (t == nt - 2);
            const char* a1 = cA + (size_t)(t + 1) * kstep;
            const char* a2 = last ? nA : cA + (size_t)(t + 2) * kstep; const char* b2 = last ? nB : cB + (size_t)(t + 2) * kstep;
            const char* a3 = a2 + kstep; const char* b3 = b2 + kstep;
            if (last && has_next) S.a_ready(nxt);
            const bool eo1 = 2 * t < nt;
            if constexpr (SP2) {
            PG8_LDB(B0, 0, 0); PG8_LDB(B1, 0, 1); PG8_SCHED; if (!EO || eo1) PG8_LDA(At, 0, 0); PG8_STAGE(PG8_SA(1, 1), a1 + hstepA, voffA);
            PG8_WAIT_V(8); PG8_WAIT_L(0); PG8_BAR; if (!EO || eo1) { PG8_MMA(0, 0, At, B0); PG8_MMA(0, 1, At, B1); } PG8_BAR; PG8_SCHED;
            if (!EO || !eo1) PG8_LDA(At, 0, 1); PG8_STAGE(PG8_SB(0, 0), b2, voffB); PG8_STAGE(PG8_SB(0, 1), b2 + hstepB, voffB); PG8_STAGE(PG8_SA(0, 0), a2, voffA);
            PG8_WAIT_V(8); PG8_WAIT_L(0); PG8_BAR; if (!EO || !eo1) { PG8_MMA(1, 0, At, B0); PG8_MMA(1, 1, At, B1); } PG8_BAR; PG8_SCHED;
            PG8_LDB(B0, 1, 0); PG8_LDB(B1, 1, 1); PG8_SCHED; if (!EO || eo1) PG8_LDA(At, 1, 0); PG8_STAGE(PG8_SA(0, 1), a2 + hstepA, voffA);
            PG8_WAIT_V(8); PG8_WAIT_L(0); PG8_BAR; if (!EO || eo1) { PG8_MMA(0, 0, At, B0); PG8_MMA(0, 1, At, B1); } PG8_BAR; PG8_SCHED;
            if (!EO || !eo1) PG8_LDA(At, 1, 1); PG8_STAGE(PG8_SB(1, 0), b3, voffB); PG8_STAGE(PG8_SB(1, 1), b3 + hstepB, voffB); PG8_STAGE(PG8_SA(1, 0), a3, voffA);
            PG8_WAIT_V(8); PG8_WAIT_L(0); PG8_BAR; if (!EO || !eo1) { PG8_MMA(1, 0, At, B0); PG8_MMA(1, 1, At, B1); } PG8_BAR; PG8_SCHED;
            } else {
            PG8_LDB(B0, 0, 0); PG8_SCHED; PG8_LDA(At, 0, 0); PG8_STAGE(PG8_SA(1, 1), a1 + hstepA, voffA);
            PG8_WAIT_L(8); PG8_BAR; PG8_WAIT_L(0); PG8_MMA(0, 0, At, B0); PG8_BAR; PG8_SCHED;
            PG8_LDB(B1, 0, 1); PG8_STAGE(PG8_SB(0, 0), b2, voffB);
            PG8_BAR; PG8_WAIT_L(0); PG8_MMA(0, 1, At, B1); PG8_BAR;
            PG8_LDA(At, 0, 1); PG8_STAGE(PG8_SA(0, 0), a2, voffA);
            PG8_BAR; PG8_WAIT_L(0); PG8_MMA(1, 0, At, B0); PG8_BAR; PG8_SCHED;
            PG8_STAGE(PG8_SB(0, 1), b2 + hstepB, voffB);
            PG8_WAIT_V(6); PG8_BAR; PG8_MMA(1, 1, At, B1); PG8_BAR;
            PG8_LDB(B0, 1, 0); PG8_SCHED; PG8_LDA(At, 1, 0); PG8_STAGE(PG8_SA(0, 1), a2 + hstepA, voffA);
            PG8_WAIT_L(8); PG8_BAR; PG8_WAIT_L(0); PG8_MMA(0, 0, At, B0); PG8_BAR; PG8_SCHED;
            PG8_LDB(B1, 1, 1); PG8_STAGE(PG8_SB(1, 0), b3, voffB);
            PG8_BAR; PG8_WAIT_L(0); PG8_MMA(0, 1, At, B1); PG8_BAR;
            PG8_LDA(At, 1, 1); PG8_STAGE(PG8_SA(1, 0), a3, voffA);
            PG8_BAR; PG8_WAIT_L(0); PG8_MMA(1, 0, At, B0); PG8_BAR; PG8_SCHED;
            PG8_STAGE(PG8_SB(1, 1), b3 + hstepB, voffB);
            PG8_WAIT_V(6); PG8_BAR; PG8_MMA(1, 1, At, B1); PG8_BAR;
            }
        }
        if constexpr (ALIGN_EPI) { if (wr == 0) PG8_BAR; }
        if constexpr (!Epi::AFTER_DRAIN) { E(acc, cur, wr, wc, fr, fq); S.done(cur); }
        if (!has_next) break;
#pragma unroll
        for (int a = 0; a < 2; ++a)
#pragma unroll
            for (int b = 0; b < 2; ++b)
#pragma unroll
                for (int m = 0; m < 4; ++m)
#pragma unroll
                    for (int n = 0; n < 2; ++n) acc[a][b][m][n] = (f32x4){0.f, 0.f, 0.f, 0.f};
        cur = nxt; cA = nA; cB = nB; ++ui;
        if constexpr (ALIGN_EPI) { if (wr == 1) PG8_BAR; }
    }
    PG8_WAIT_V(0);
    if constexpr (!ALIGN_EPI) { if (wr == 0) PG8_BAR; }
    PG8_BAR;
    if constexpr (Epi::AFTER_DRAIN) { E.fused(acc, cur, wr, wc, fr, fq, lds, wid, lane); S.done(cur); }
#undef PG8_SA
#undef PG8_SB
#undef PG8_STAGE
#undef PG8_LDA
#undef PG8_LDB
#undef PG8_MMA
#undef PG8_WAIT_V
#undef PG8_WAIT_L
#undef PG8_BAR
#undef PG8_SCHED
}
}
#define GAS __attribute__((address_space(1)))
#define LAS __attribute__((address_space(3)))
typedef unsigned short bf16_t;
typedef unsigned u32x4 __attribute__((ext_vector_type(4)));
typedef unsigned u32x2 __attribute__((ext_vector_type(2)));
typedef float f32x4 __attribute__((ext_vector_type(4)));
typedef float f32x2 __attribute__((ext_vector_type(2)));

constexpr int D = 2048, NBATCH = 16, SEQ = 2048, DEPTH = 4, CTXL = 256;
constexpr int ML = NBATCH * SEQ, MC = NBATCH * CTXL, MT = ML + MC;
constexpr int NPROJ = 3840, DFF = 5632, NGU = 2 * DFF, MODW = 6 * D;
constexpr int OFF_Z = 0  , OFF_AX = 0, OFF_AB = 512, OFF_AC = 1024, OFF_F = 1536, OFF_Q = 2048, OFF_K = 2560, OFF_V = 2688, OFF_U = 2816, OFF_MV = 3328;
constexpr float EPS = 1e-6f;
constexpr int NWAVES = 8, NTHREADS = 512;

constexpr size_t al256(size_t x) { return (x + 255) & ~(size_t)255; }
constexpr size_t WS_CTL = 0, CTL_ZERO_BYTES = 1u << 20;
constexpr size_t WS_WIN = CTL_ZERO_BYTES;
constexpr size_t WS_WOUT = WS_WIN + (size_t)DEPTH * NPROJ * D * 2;
constexpr size_t WS_WGU = WS_WOUT + (size_t)DEPTH * D * D * 2;
constexpr size_t WS_WDN = WS_WGU + (size_t)DEPTH * NGU * D * 2;
constexpr size_t WS_MOD = WS_WDN + (size_t)DEPTH * D * DFF * 2;
constexpr size_t WS_MODP = al256(WS_MOD + (size_t)DEPTH * 17 * MODW * 4);
constexpr size_t WS_XS = al256(WS_MODP + (size_t)DEPTH * 8 * 17 * MODW * 4);
constexpr size_t WS_H = WS_XS + (size_t)MT * D * 2;
constexpr size_t WS_P = WS_H + (size_t)MT * D * 2;
constexpr size_t WS_Y = WS_P + (size_t)MT * NPROJ * 2;
constexpr size_t WS_HF = WS_P;
constexpr size_t WS_TT = WS_Y + (size_t)MT * D * 2;
static_assert(WS_HF + (size_t)MT * DFF * 2 <= WS_TT, "hf overlay");
constexpr size_t WS_TTC = WS_TT + (size_t)NBATCH * 512 * 4096 * 2;
constexpr size_t WS_DFTN = WS_TTC + (size_t)NBATCH * 512 * 512 * 2;
constexpr size_t WS_DFTC = WS_DFTN + (size_t)2048 * 4096 * 2;
constexpr size_t WS_ROPE = WS_DFTC + (size_t)256 * 512 * 2;
constexpr size_t WS_CSBD = WS_ROPE + (size_t)2048 * 32 * 8;
constexpr size_t WS_DL = WS_CSBD + (size_t)1024 * 512 * 2;
constexpr size_t WS_WSB = WS_DL + (size_t)MT * D * 2;
constexpr size_t WS_END = WS_WSB + (size_t)DEPTH * 4 * 128 * 128 * 2;
constexpr int CW_BAR = 4096;

constexpr int LDS_BYTES = 147456;
constexpr int ROPE_LDS_OFF = 131072;
constexpr int LDSCTL_OFF = 146432, MISC_OFF = LDSCTL_OFF;

#define LDS_WAIT() asm volatile("s_waitcnt lgkmcnt(0)" ::: "memory")
__device__ __forceinline__ float bf2f(unsigned b) { return __uint_as_float(b << 16); }
__device__ __forceinline__ unsigned f2bf(float f) { unsigned u = __float_as_uint(f); return (u + 0x7fffu + ((u >> 16) & 1u)) >> 16; }
typedef __bf16 bf16x2_hw __attribute__((ext_vector_type(2)));
__device__ __forceinline__ unsigned pk2(float lo, float hi) { const f32x2 v = {lo, hi}; const bf16x2_hw b = __builtin_convertvector(v, bf16x2_hw); return __builtin_bit_cast(unsigned, b); }
__device__ __forceinline__ void unpack8(const u32x4 w, float* o) {
    o[0] = __uint_as_float(w.x << 16); o[1] = __uint_as_float(w.x & 0xffff0000u); o[2] = __uint_as_float(w.y << 16); o[3] = __uint_as_float(w.y & 0xffff0000u);
    o[4] = __uint_as_float(w.z << 16); o[5] = __uint_as_float(w.z & 0xffff0000u); o[6] = __uint_as_float(w.w << 16); o[7] = __uint_as_float(w.w & 0xffff0000u);
}
__device__ __forceinline__ float wave_sum(float v) {
#pragma unroll
    for (int o = 1; o < 64; o <<= 1) v += __shfl_xor(v, o);
    return v;
}
__device__ __forceinline__ float gelu_tanh(float x) {
    const float u = 0.7978845608028654f * (x + 0.044715f * x * x * x);
    const float e = __expf(2.0f * u);
    const float t = 1.0f - 2.0f * __builtin_amdgcn_rcpf(1.0f + e);
    return 0.5f * x * (1.0f + t);
}
#define XB_TMO      128
#define XB_XCNT(j)  (256  + 64 * (j))
#define XB_XSUB(j)  (1280 + 64 * (j))
#define XB_XGEN(j)  (2304 + 64 * (j))
#define XB_TOP      3328
#define XB_TOPGEN   3392
#define XCD_BAR_WORDS 3456
#define XB_SPIN_CAP (1u << 18)

__device__ __forceinline__ unsigned xb_ld(unsigned* p)              { return __hip_atomic_load(p, __ATOMIC_RELAXED, __HIP_MEMORY_SCOPE_AGENT); }
__device__ __forceinline__ unsigned xb_add(unsigned* p, unsigned v) { return __hip_atomic_fetch_add(p, v, __ATOMIC_RELAXED, __HIP_MEMORY_SCOPE_AGENT); }
__device__ __forceinline__ unsigned xb_xcc_id() { return (unsigned)__builtin_amdgcn_s_getreg((3 << 11) | 20) & 0xFu; }
#define XB_SPIN(cond, bar) do { unsigned _sp = 0; while (cond) { __builtin_amdgcn_s_sleep(1); \
    if ((++_sp & 255u) == 0u) { if (xb_ld(&(bar)[XB_TMO])) break; if (_sp > XB_SPIN_CAP) { atomicAdd(&(bar)[XB_TMO], 1u); break; } } } } while (0)

struct XcdBarrier {
    unsigned* bar; unsigned x;
    volatile LAS unsigned* st;
};

__device__ __forceinline__ XcdBarrier xcd_barrier_post(unsigned* bar, volatile LAS unsigned* st) {
    XcdBarrier b; b.bar = bar; b.x = xb_xcc_id(); b.st = st;
    if (threadIdx.x == 0) (void)xb_add(&bar[XB_XCNT(b.x)], 1u);
    return b;
}
__device__ __forceinline__ void xcd_barrier_complete(unsigned* bar, unsigned x, unsigned& nloc, unsigned& nx) {
    const unsigned G = gridDim.x * gridDim.y * gridDim.z;
    unsigned sum, cnt, mine, sp = 0u;
    for (;;) {
        sum = 0u; cnt = 0u; mine = 0u;
#pragma unroll
        for (unsigned j = 0; j < 16; ++j) { const unsigned c = xb_ld(&bar[XB_XCNT(j)]); sum += c; cnt += (c > 0u) ? 1u : 0u; mine = (j == x) ? c : mine; }
        if (sum == G) break;
        __builtin_amdgcn_s_sleep(1);
        if ((++sp & 255u) == 0u) { if (xb_ld(&bar[XB_TMO])) break; if (sp > XB_SPIN_CAP) { atomicAdd(&bar[XB_TMO], 1u); break; } }
    }
    nloc = mine > 0u ? mine : 1u; nx = cnt > 0u ? cnt : 1u;
}

__device__ __forceinline__ void xcd_barrier(const XcdBarrier& b) {
    asm volatile("s_waitcnt vmcnt(0)" ::: "memory");
    __syncthreads();
    if (threadIdx.x == 0) {
        unsigned* bar = b.bar;
        __builtin_amdgcn_s_waitcnt(0);
        unsigned nloc = b.st[0], nx = b.st[1];
        if (nloc == 0u) { xcd_barrier_complete(bar, b.x, nloc, nx); b.st[0] = nloc; b.st[1] = nx; }
        const unsigned old = xb_add(&bar[XB_XSUB(b.x)], 1u);
        const unsigned gen = old / nloc;
        if (old + 1u == (gen + 1u) * nloc) {
            __builtin_amdgcn_fence(__ATOMIC_RELEASE, "agent");
            asm volatile("s_waitcnt vmcnt(0)" ::: "memory");
            const unsigned og = xb_add(&bar[XB_TOP], 1u);
            const unsigned tg = og / nx;
            if (og + 1u == (tg + 1u) * nx) xb_add(&bar[XB_TOPGEN], 1u);
            else XB_SPIN(xb_ld(&bar[XB_TOPGEN]) == tg, bar);
            __builtin_amdgcn_fence(__ATOMIC_ACQUIRE, "agent");
            xb_add(&bar[XB_XGEN(b.x)], 1u);
            asm volatile("s_waitcnt vmcnt(0)" ::: "memory");
        } else {
            XB_SPIN(xb_ld(&bar[XB_XGEN(b.x)]) == gen, bar);
            __builtin_amdgcn_fence(__ATOMIC_ACQUIRE, "agent");
            asm volatile("s_waitcnt vmcnt(0)" ::: "memory");
        }
    }
    __syncthreads();
}
__device__ __forceinline__ void tr_item(const float* __restrict__ W, int K, int N, bf16_t* __restrict__ WT, int k0, int n0, int drow0, LAS float* scr, int lane) {
    { const int kr = lane >> 3, c4 = (lane & 7) * 4;
      f32x4 v[8];
#pragma unroll
      for (int i = 0; i < 8; ++i) v[i] = __builtin_nontemporal_load((const f32x4*)(W + (size_t)(k0 + 8 * i + kr) * N + n0 + c4));
#pragma unroll
      for (int i = 0; i < 8; ++i) { LAS float* d = scr + (8 * i + kr) * 33 + c4; d[0] = v[i].x; d[1] = v[i].y; d[2] = v[i].z; d[3] = v[i].w; } }
    LDS_WAIT(); asm volatile("" ::: "memory");
    const int c = lane & 7;
#pragma unroll
    for (int j = 0; j < 4; ++j) { const int n = (lane >> 3) + 8 * j; const LAS float* s = scr + (8 * c) * 33 + n;
        u32x4 o; o.x = pk2(s[0 * 33], s[1 * 33]); o.y = pk2(s[2 * 33], s[3 * 33]); o.z = pk2(s[4 * 33], s[5 * 33]); o.w = pk2(s[6 * 33], s[7 * 33]);
        *(u32x4*)(WT + (size_t)(drow0 + n) * K + k0 + 8 * c) = o; }
    LDS_WAIT(); asm volatile("" ::: "memory");
}
__device__ __forceinline__ int win_drow(int n0) {
    if (n0 < 512) return (n0 >> 7) * 256 + (n0 & 127);
    if (n0 < 1024) return 1024 + (n0 - 512);
    if (n0 < 1536) { const int c = n0 - 1024; return (c >> 7) * 256 + 128 + (c & 127); }
    return n0;
}
constexpr int TR_IN = 32 * 120, TR_OUT = 32 * 64, TR_G = 32 * 176, TR_DN = 88 * 64, TR_P0L = TR_IN + TR_OUT;
__device__ __forceinline__ void p0_transposes(const float* w_in, const float* w_out, bf16_t* WIN, bf16_t* WOUT, LAS float* scr, int gw, int NGW, int lane) {
    for (int it = gw; it < TR_IN + TR_OUT; it += NGW) {
        int r = it;
        if (r < TR_IN) { const int kb = r / 120, nb = r % 120; tr_item(w_in, D, NPROJ, WIN, kb * 64, nb * 32, win_drow(nb * 32), scr, lane); continue; } r -= TR_IN;
        { const int kb = r / 64, nb = r % 64; tr_item(w_out, D, D, WOUT, kb * 64, nb * 32, nb * 32, scr, lane); }
    }
}
__device__ __forceinline__ void tr_wout123(const float* w_out, bf16_t* WOUT, LAS float* scr, int sw, int nsw, int lane) {
    for (int it = sw; it < 3 * TR_OUT; it += nsw) { const int l = 1 + it / TR_OUT, q = it % TR_OUT, kb = q / 64, nb = q % 64;
        tr_item(w_out + (size_t)l * D * D, D, D, WOUT + (size_t)l * D * D, kb * 64, nb * 32, nb * 32, scr, lane); }
}
__device__ __forceinline__ void tr_load(const float* __restrict__ W, int N, int k0, int n0, int lane, f32x4 (&v)[8]) {
    const int kr = lane >> 3, c4 = (lane & 7) * 4;
#pragma unroll
    for (int i = 0; i < 8; ++i) v[i] = __builtin_nontemporal_load((const f32x4*)(W + (size_t)(k0 + 8 * i + kr) * N + n0 + c4));
}
__device__ __forceinline__ void tr_emit(const f32x4 (&v)[8], int K, bf16_t* __restrict__ WT, int k0, int drow0, LAS float* scr, int lane) {
    { const int kr = lane >> 3, c4 = (lane & 7) * 4;
#pragma unroll
      for (int i = 0; i < 8; ++i) { LAS float* d = scr + (8 * i + kr) * 33 + c4; d[0] = v[i].x; d[1] = v[i].y; d[2] = v[i].z; d[3] = v[i].w; } }
    LDS_WAIT(); asm volatile("" ::: "memory");
    const int c = lane & 7;
#pragma unroll
    for (int j = 0; j < 4; ++j) { const int n = (lane >> 3) + 8 * j; const LAS float* sp = scr + (8 * c) * 33 + n;
        u32x4 o; o.x = pk2(sp[0 * 33], sp[1 * 33]); o.y = pk2(sp[2 * 33], sp[3 * 33]); o.z = pk2(sp[4 * 33], sp[5 * 33]); o.w = pk2(sp[6 * 33], sp[7 * 33]);
        *(u32x4*)(WT + (size_t)(drow0 + n) * K + k0 + 8 * c) = o; }
    LDS_WAIT(); asm volatile("" ::: "memory");
}
__device__ __forceinline__ void tr_gateup(const float* w_gate_l, const float* w_up_l, bf16_t* WGU_l, LAS float* scr, int sw, int nsw, int lane) {
    f32x4 v[8], vn[8]; int it = sw;
    if (it < 2 * TR_G) { const int up = it >= TR_G, r = up ? it - TR_G : it; tr_load(up ? w_up_l : w_gate_l, DFF, (r / 176) * 64, (r % 176) * 32, lane, v); }
    for (; it < 2 * TR_G; it += nsw) {
        const int nx = it + nsw;
        if (nx < 2 * TR_G) { const int up = nx >= TR_G, r = up ? nx - TR_G : nx; tr_load(up ? w_up_l : w_gate_l, DFF, (r / 176) * 64, (r % 176) * 32, lane, vn); }
        const int up = it >= TR_G, r = up ? it - TR_G : it, kb = r / 176, n0 = (r % 176) * 32;
        tr_emit(v, D, WGU_l, kb * 64, (n0 >> 7) * 256 + (up ? 128 : 0) + (n0 & 127), scr, lane);
#pragma unroll
        for (int i = 0; i < 8; ++i) v[i] = vn[i];
    }
}
__device__ __forceinline__ void tr_win(const float* w_in_l, bf16_t* WIN_l, LAS float* scr, int sw, int nsw, int lane) {
    f32x4 v[8], vn[8]; int it = sw;
    if (it < TR_IN) tr_load(w_in_l, NPROJ, (it / 120) * 64, (it % 120) * 32, lane, v);
    for (; it < TR_IN; it += nsw) {
        const int nx = it + nsw;
        if (nx < TR_IN) tr_load(w_in_l, NPROJ, (nx / 120) * 64, (nx % 120) * 32, lane, vn);
        tr_emit(v, D, WIN_l, (it / 120) * 64, win_drow((it % 120) * 32), scr, lane);
#pragma unroll
        for (int i = 0; i < 8; ++i) v[i] = vn[i];
    }
}
__device__ __forceinline__ void tr_down(const float* w_down_l, bf16_t* WDN_l, LAS float* scr, int sw, int nsw, int lane) {
    f32x4 v[8], vn[8]; int it = sw;
    if (it < TR_DN) tr_load(w_down_l, D, (it / 64) * 64, (it % 64) * 32, lane, v);
    for (; it < TR_DN; it += nsw) {
        const int nx = it + nsw;
        if (nx < TR_DN) tr_load(w_down_l, D, (nx / 64) * 64, (nx % 64) * 32, lane, vn);
        tr_emit(v, DFF, WDN_l, (it / 64) * 64, (it % 64) * 32, scr, lane);
#pragma unroll
        for (int i = 0; i < 8; ++i) v[i] = vn[i];
    }
}
__device__ __forceinline__ void p0_modp(const float* __restrict__ c, const float* __restrict__ c_ctx, const float* __restrict__ w_ada, float* __restrict__ modp, LAS float* scr  , int gw, int NGW, int lane) {
    for (int it = gw; it < DEPTH * 48 * 8; it += NGW) {
        const int l = it / 384, rem = it % 384, cc = rem >> 3, ks = rem & 7, k0 = ks * 256;
#pragma unroll
        for (int r = 0; r < 17; ++r)
#pragma unroll
            for (int j = 0; j < 4; ++j) { const int idx = j * 64 + lane; const float v = (r < 16) ? c[r * D + k0 + idx] : c_ctx[k0 + idx]; scr[r * 256 + idx] = v * (1.0f / (1.0f + __expf(-v))); }
        LDS_WAIT(); asm volatile("" ::: "memory");
        f32x4 acc[17];
#pragma unroll
        for (int r = 0; r < 17; ++r) acc[r] = (f32x4){0.f, 0.f, 0.f, 0.f};
        const float* wp = w_ada + ((size_t)l * D + k0) * MODW + cc * 256 + lane * 4;
#pragma unroll 2
        for (int k4 = 0; k4 < 64; ++k4) {
            const f32x4 w0 = *(const f32x4*)(wp + (size_t)(4 * k4 + 0) * MODW), w1 = *(const f32x4*)(wp + (size_t)(4 * k4 + 1) * MODW);
            const f32x4 w2 = *(const f32x4*)(wp + (size_t)(4 * k4 + 2) * MODW), w3 = *(const f32x4*)(wp + (size_t)(4 * k4 + 3) * MODW);
#pragma unroll
            for (int r = 0; r < 17; ++r) { const f32x4 s = *(const LAS f32x4*)(scr + r * 256 + 4 * k4); acc[r] = acc[r] + w0 * s.x + w1 * s.y + w2 * s.z + w3 * s.w; }
        }
#pragma unroll
        for (int r = 0; r < 17; ++r) *(f32x4*)(modp + ((size_t)((l * 8 + ks) * 17 + r)) * MODW + cc * 256 + lane * 4) = acc[r];
        LDS_WAIT(); asm volatile("" ::: "memory");
    }
}
__device__ __forceinline__ void p0_tables(bf16_t* DFTN, bf16_t* DFTC, bf16_t* CSBD, f32x2* ROPE, size_t gtid, size_t NT) {
    for (size_t i = gtid; i < (size_t)1024 * 128 / 8; i += NT) {
        const int r = (int)(i >> 4), c0 = (int)(i & 15) * 8, t = (r >> 7) & 1, m = r & 127; float v[8];
#pragma unroll
        for (int e = 0; e < 8; ++e) { const int j = (m * (c0 + e)) & 127; const float x = (float)j * (1.0f / 64.0f); v[e] = t == 0 ? cospif(x) : sinpif(x); }
        u32x4 o; o.x = pk2(v[0], v[1]); o.y = pk2(v[2], v[3]); o.z = pk2(v[4], v[5]); o.w = pk2(v[6], v[7]);
        *(u32x4*)(CSBD + i * 8) = o;
    }
    for (size_t i = gtid; i < (size_t)2048 * 4096 / 8; i += NT) {
        const int rho = (int)(i >> 9), n0 = (int)(i & 511) * 8, h = (rho >> 7) & 1, k = (rho >> 8) * 128 + (rho & 127); float v[8];
#pragma unroll
        for (int e = 0; e < 8; ++e) { const int np = n0 + e, n = np & 2047, j = (k * n) & 2047; const float x = (float)j * (1.0f / 1024.0f); v[e] = (np < 2048) ? (h == 0 ? cospif(x) : 0.f) : (h == 1 ? sinpif(x) : 0.f); }
        u32x4 o; o.x = pk2(v[0], v[1]); o.y = pk2(v[2], v[3]); o.z = pk2(v[4], v[5]); o.w = pk2(v[6], v[7]);
        *(u32x4*)(DFTN + i * 8) = o;
    }
    for (size_t i = gtid; i < (size_t)256 * 512 / 8; i += NT) {
        const int k = (int)(i >> 6), n0 = (int)(i & 63) * 8; float v[8];
#pragma unroll
        for (int e = 0; e < 8; ++e) { const int np = n0 + e, n = np & 255, j = (k * n) & 255; const float x = (float)j * (1.0f / 128.0f); v[e] = np < 256 ? cospif(x) : -sinpif(x); }
        u32x4 o; o.x = pk2(v[0], v[1]); o.y = pk2(v[2], v[3]); o.z = pk2(v[4], v[5]); o.w = pk2(v[6], v[7]);
        *(u32x4*)(DFTC + i * 8) = o;
    }
    for (size_t i = gtid; i < (size_t)96 * 16; i += NT) {
        const int c = (int)(i >> 4), fi = (int)(i & 15), coord = c < 32 ? c : c - 32;
        const float inv = exp2f(-(float)fi * (13.287712379549449f / 16.0f));
        const float xr = ((float)coord * inv) * 0.3183098861837907f;
        ROPE[i] = (f32x2){cospif(xr), sinpif(xr)};
    }
}
__device__ __forceinline__ void p1_wsb(const float* __restrict__ w_s, bf16_t* __restrict__ WSB, size_t gtid, size_t NT) {
    for (size_t i = gtid; i < (size_t)DEPTH * 4 * 128 * 128 / 8; i += NT) { const f32x4 a = ((const f32x4*)w_s)[2 * i], b = ((const f32x4*)w_s)[2 * i + 1];
        u32x4 w; w.x = pk2(a.x, a.y); w.y = pk2(a.z, a.w); w.z = pk2(b.x, b.y); w.w = pk2(b.z, b.w); ((u32x4*)WSB)[i] = w; }
}
__device__ __forceinline__ void p1_mod(const float* __restrict__ modp, const float* __restrict__ b_ada, float* __restrict__ mod, size_t gtid, size_t NT) {
    for (size_t i = gtid; i < (size_t)DEPTH * 17 * MODW; i += NT) {
        const int l = (int)(i / (17 * MODW)), rn = (int)(i % (17 * MODW)), n = rn % MODW;
        float s = b_ada[l * MODW + n];
#pragma unroll
        for (int ks = 0; ks < 8; ++ks) s += modp[(size_t)(l * 8 + ks) * 17 * MODW + rn];
        mod[i] = s;
    }
}
__device__ __forceinline__ void unpack8v(const u32x4 w, f32x4& lo, f32x4& hi) {
    lo = (f32x4){__uint_as_float(w.x << 16), __uint_as_float(w.x & 0xffff0000u), __uint_as_float(w.y << 16), __uint_as_float(w.y & 0xffff0000u)};
    hi = (f32x4){__uint_as_float(w.z << 16), __uint_as_float(w.z & 0xffff0000u), __uint_as_float(w.w << 16), __uint_as_float(w.w & 0xffff0000u)};
}
__device__ __forceinline__ u32x4 pack8v(const f32x4 lo, const f32x4 hi) { u32x4 w; w.x = pk2(lo.x, lo.y); w.y = pk2(lo.z, lo.w); w.z = pk2(hi.x, hi.y); w.w = pk2(hi.z, hi.w); return w; }
template <bool XF32, bool HAS_DELTA, bool WRITE_X>
__device__ __forceinline__ void resnorm_rows(const void* __restrict__ xlat, const void* __restrict__ xctx, const bf16_t* __restrict__ DL, bf16_t* __restrict__ xout, const float* __restrict__ gvec,
                                             const float* __restrict__ modl, int shoff, int scoff, bf16_t* __restrict__ H, int r0, int r1, int lane) {
    int bcur = -1; f32x4 gm[8], sh[8];
    for (int row = r0; row < r1; ) {
        const int b = row < ML ? (row >> 11) : 16, bn = (row + 1) < ML ? ((row + 1) >> 11) : 16;
        const bool two = (row + 1 < r1) && (bn == b) && ((row + 1 == ML) == false);
        if (b != bcur) { bcur = b; const float* mrow = modl + (size_t)b * MODW;
#pragma unroll
            for (int j = 0; j < 8; ++j) { const int col = 8 * lane + 512 * (j >> 1) + 4 * (j & 1); gm[j] = *(const f32x4*)(gvec + col) * (*(const f32x4*)(mrow + scoff + col) + 1.0f); sh[j] = *(const f32x4*)(mrow + shoff + col); } }
        const size_t roff = (row < ML) ? (size_t)row * D : (size_t)(row - ML) * D;
        f32x4 va[8], vb[8];
        if (XF32) { const float* xa = (const float*)(row < ML ? xlat : xctx) + roff + 8 * lane; const float* xb = two ? xa + D : xa;
#pragma unroll
            for (int j = 0; j < 8; ++j) { const int o = 512 * (j >> 1) + 4 * (j & 1); va[j] = __builtin_nontemporal_load((const f32x4*)(xa + o)); vb[j] = __builtin_nontemporal_load((const f32x4*)(xb + o)); } }
        else { const bf16_t* xa = (const bf16_t*)(row < ML ? xlat : xctx) + roff + 8 * lane; const bf16_t* xb = two ? xa + D : xa; u32x4 wa[4], wb[4];
#pragma unroll
            for (int j = 0; j < 4; ++j) { wa[j] = __builtin_nontemporal_load((const u32x4*)(xa + 512 * j)); wb[j] = __builtin_nontemporal_load((const u32x4*)(xb + 512 * j)); }
#pragma unroll
            for (int j = 0; j < 4; ++j) { unpack8v(wa[j], va[2 * j], va[2 * j + 1]); unpack8v(wb[j], vb[2 * j], vb[2 * j + 1]); } }
        if (HAS_DELTA) { const bf16_t* da = DL + (size_t)row * D + 8 * lane; const bf16_t* db = two ? da + D : da; u32x4 wa[4], wb[4];
#pragma unroll
            for (int j = 0; j < 4; ++j) { wa[j] = __builtin_nontemporal_load((const u32x4*)(da + 512 * j)); wb[j] = __builtin_nontemporal_load((const u32x4*)(db + 512 * j)); }
#pragma unroll
            for (int j = 0; j < 4; ++j) { f32x4 l0, h0, l1, h1; unpack8v(wa[j], l0, h0); unpack8v(wb[j], l1, h1);
                va[2 * j] = va[2 * j] + l0; va[2 * j + 1] = va[2 * j + 1] + h0; vb[2 * j] = vb[2 * j] + l1; vb[2 * j + 1] = vb[2 * j + 1] + h1; } }
        float sa = 0.f, sb = 0.f;
#pragma unroll
        for (int j = 0; j < 8; ++j) { sa += (va[j].x * va[j].x + va[j].y * va[j].y) + (va[j].z * va[j].z + va[j].w * va[j].w); sb += (vb[j].x * vb[j].x + vb[j].y * vb[j].y) + (vb[j].z * vb[j].z + vb[j].w * vb[j].w); }
#pragma unroll
        for (int o = 1; o < 64; o <<= 1) { sa += __shfl_xor(sa, o); sb += __shfl_xor(sb, o); }
        const float ra = 1.0f / sqrtf(sa * (1.0f / D) + EPS), rb = 1.0f / sqrtf(sb * (1.0f / D) + EPS);
        if (WRITE_X) { bf16_t* oa = xout + (size_t)row * D + 8 * lane;
#pragma unroll
            for (int j = 0; j < 4; ++j) { __builtin_nontemporal_store(pack8v(va[2 * j], va[2 * j + 1]), (u32x4*)(oa + 512 * j)); if (two) __builtin_nontemporal_store(pack8v(vb[2 * j], vb[2 * j + 1]), (u32x4*)(oa + D + 512 * j)); } }
        bf16_t* ha = H + (size_t)row * D + 8 * lane;
#pragma unroll
        for (int j = 0; j < 4; ++j) {
            *(u32x4*)(ha + 512 * j) = pack8v((va[2 * j] * ra) * gm[2 * j] + sh[2 * j], (va[2 * j + 1] * ra) * gm[2 * j + 1] + sh[2 * j + 1]);
            if (two) *(u32x4*)(ha + D + 512 * j) = pack8v((vb[2 * j] * rb) * gm[2 * j] + sh[2 * j], (vb[2 * j + 1] * rb) * gm[2 * j + 1] + sh[2 * j + 1]); }
        row += two ? 2 : 1;
    }
}
__device__ __forceinline__ void final_rows(const bf16_t* __restrict__ xs, const float* __restrict__ gvec, float* __restrict__ out, int gw, int NGW, int lane) {
    const int rpw = (ML + NGW - 1) / NGW, r0 = gw * rpw, r1 = (r0 + rpw < ML) ? r0 + rpw : ML;
    f32x4 g4[8];
#pragma unroll
    for (int j = 0; j < 8; ++j) g4[j] = *(const f32x4*)(gvec + 8 * lane + 512 * (j >> 1) + 4 * (j & 1));
    for (int row = r0; row < r1; ++row) {
        const bf16_t* xa = xs + (size_t)row * D + 8 * lane;
        u32x4 wx[4]; f32x4 v[8]; float ss = 0.f;
#pragma unroll
        for (int j = 0; j < 4; ++j) wx[j] = __builtin_nontemporal_load((const u32x4*)(xa + 512 * j));
#pragma unroll
        for (int j = 0; j < 4; ++j) unpack8v(wx[j], v[2 * j], v[2 * j + 1]);
#pragma unroll
        for (int j = 0; j < 8; ++j) ss += (v[j].x * v[j].x + v[j].y * v[j].y) + (v[j].z * v[j].z + v[j].w * v[j].w);
        const float rstd = 1.0f / sqrtf(wave_sum(ss) * (1.0f / D) + EPS);
        float* oa = out + (size_t)row * D + 8 * lane;
#pragma unroll
        for (int j = 0; j < 8; ++j) __builtin_nontemporal_store((v[j] * rstd) * g4[j], (f32x4*)(oa + 512 * (j >> 1) + 4 * (j & 1)));
    }
}
__device__ __forceinline__ void four_nyquist_rows(const bf16_t* __restrict__ TT, bf16_t* __restrict__ Y, int gw, int NGW, int lane) {
    for (int it = gw; it < NBATCH * 512; it += NGW) {
        const bf16_t* tr = TT + (size_t)it * 4096 + 8 * lane; float s = 0.f;
#pragma unroll
        for (int j = 0; j < 4; ++j) { float v[8]; unpack8(*(const u32x4*)(tr + 512 * j), v); s += ((v[0] - v[1]) + (v[2] - v[3])) + ((v[4] - v[5]) + (v[6] - v[7])); }
        s = wave_sum(s);
        if (lane == 0) Y[(size_t)((it >> 9) * 2048 + 1024) * D + 512 + (it & 511)] = (bf16_t)f2bf(s * (1.0f / 512.0f));
    }
}
__device__ __forceinline__ void mix_conv(const bf16_t* __restrict__ P, const float* __restrict__ wc  , bf16_t* __restrict__ Y, int nrows, size_t gtid, size_t NT) {
    const int R = (nrows * 64 + (int)NT - 1) / (int)NT > 0 ? (nrows + (int)(NT >> 6) - 1) / (int)(NT >> 6) : 1;
    const int run = (int)(gtid >> 6), c0 = (int)(gtid & 63) * 8;
    float w0[8], w1[8], w2[8];
#pragma unroll
    for (int e = 0; e < 8; ++e) { w0[e] = wc[c0 + e]; w1[e] = wc[512 + c0 + e]; w2[e] = wc[1024 + c0 + e]; }
    const int rbeg = run * R, rend = (rbeg + R < nrows) ? rbeg + R : nrows;
    for (int rb = rbeg; rb < rend; rb += 6) {
        u32x4 xr[8], br[6]; bool ok[8];
#pragma unroll
        for (int i = 0; i < 8; ++i) { const int row = rb - 1 + i;
            int n, L; if (row < ML) { n = row & 2047; L = 2048; } else { n = (row - ML) & 255; L = 256; }
            ok[i] = row >= 0 && row < nrows; (void)n; (void)L;
            const bf16_t* pr = P + (size_t)(ok[i] ? row : 0) * NPROJ;
            xr[i] = *(const u32x4*)(pr + OFF_Z + c0); }
#pragma unroll
        for (int i = 0; i < 6; ++i) { const int row = rb + i; br[i] = *(const u32x4*)(P + (size_t)(row < nrows ? row : 0) * NPROJ + OFF_AB + c0); }
        float z[8][8];
#pragma unroll
        for (int i = 0; i < 8; ++i) unpack8(xr[i], z[i]);
#pragma unroll
        for (int i = 0; i < 6; ++i) { const int row = rb + i; if (row < rend) {
            int n, L; if (row < ML) { n = row & 2047; L = 2048; } else { n = (row - ML) & 255; L = 256; }
            const float pm = n > 0 ? 1.f : 0.f, nm = n < L - 1 ? 1.f : 0.f;
            float gb[8], o[8]; unpack8(br[i], gb);
#pragma unroll
            for (int e = 0; e < 8; ++e) o[e] = gb[e] * ((pm * z[i][e]) * w0[e] + z[i + 1][e] * w1[e] + (nm * z[i + 2][e]) * w2[e]);
            u32x4 w; w.x = pk2(o[0], o[1]); w.y = pk2(o[2], o[3]); w.z = pk2(o[4], o[5]); w.w = pk2(o[6], o[7]);
            *(u32x4*)(Y + (size_t)row * D + c0) = w; } }
    }
}
typedef short bf16x8_t __attribute__((ext_vector_type(8)));
typedef short bf16x4_t __attribute__((ext_vector_type(4)));
constexpr int ATT_KLD = 72, ATT_VLD = 80  , ATT_KS = 0, ATT_VT = 128 * ATT_KLD * 2, ATT_BUF = ATT_VT + 128 * ATT_VLD * 2;
__device__ __forceinline__ void attn_item(const bf16_t* __restrict__ P, bf16_t* __restrict__ Y, const float* __restrict__ sinkl, int b, int kvh, int qb, bool isctx, LAS unsigned char* lds, int tid) {
    const int lane = tid & 63, wave = __builtin_amdgcn_readfirstlane(tid >> 6), fr = lane & 15, fq = lane >> 4;
    const int g = wave >> 1, h = kvh * 4 + g, p0 = qb * 128 + (wave & 1) * 64;
    const float L2E = 1.4426950408889634f, QS = 0.125f * L2E;
    const int t_hi = (qb == 15) ? 2 : 3;
    int t = isctx ? 3 : ((qb == 0) ? 1 : 0), buf = 0;
    const int sj = tid >> 3, part = tid & 7;
    u32x4 pv0, pv1, pk0, pk1;
#define ATT_PF(tt) do { const bool loc_ = (tt) < 3; const int k0_ = loc_ ? (qb - 1) * 128 + (tt) * 128 : ((tt) - 3) * 128; \
        const bf16_t* r_ = P + (loc_ ? (size_t)b * 2048 + k0_ + sj : (size_t)ML + b * 256 + k0_ + sj) * NPROJ + kvh * 64 + part * 8; \
        pk0 = *(const u32x4*)(r_ + OFF_K); pv0 = *(const u32x4*)(r_ + OFF_V); pk1 = *(const u32x4*)(r_ + (size_t)64 * NPROJ + OFF_K); pv1 = *(const u32x4*)(r_ + (size_t)64 * NPROJ + OFF_V); } while (0)
    ATT_PF(t);
    bf16x8_t Qf[4][2];
#pragma unroll
    for (int qblk = 0; qblk < 4; ++qblk) {
        const int qpos = p0 + qblk * 16 + fr;
        const size_t rowq = isctx ? (size_t)ML + b * 256 + qpos : (size_t)b * 2048 + qpos;
        const bf16_t* qp = P + rowq * NPROJ + OFF_Q + h * 64;
#pragma unroll
        for (int s = 0; s < 2; ++s) Qf[qblk][s] = *(const bf16x8_t*)(qp + 32 * s + 8 * fq);
    }
    f32x4 O[4][4]; float mrun[4], lsum[4];
    const float sk = sinkl[h] * L2E;
#pragma unroll
    for (int qblk = 0; qblk < 4; ++qblk) { mrun[qblk] = sk; lsum[qblk] = fq == 0 ? 1.0f : 0.0f;
#pragma unroll
        for (int db = 0; db < 4; ++db) O[qblk][db] = (f32x4){0.f, 0.f, 0.f, 0.f}; }
#pragma unroll 1
    for (;;) {
        const bool local = t < 3; const int k0 = local ? (qb - 1) * 128 + t * 128 : (t - 3) * 128;
        LAS bf16_t* Ks = (LAS bf16_t*)(lds + ATT_KS + buf * ATT_BUF); LAS bf16_t* Vt = (LAS bf16_t*)(lds + ATT_VT + buf * ATT_BUF);
        { *(LAS u32x4*)(Ks + sj * ATT_KLD + part * 8) = pk0; *(LAS u32x4*)(Ks + (sj + 64) * ATT_KLD + part * 8) = pk1;
          *(LAS u32x4*)(Vt + sj * ATT_VLD + part * 8) = pv0; *(LAS u32x4*)(Vt + (sj + 64) * ATT_VLD + part * 8) = pv1;
        }
        __syncthreads();
        const int tn = (t + 1 == t_hi) ? 3 : t + 1;
        if (tn < 5) ATT_PF(tn);
#pragma unroll 1
        for (int kb = 0; kb < 128; kb += 32) {
            const int kmin = k0 + kb;
            if (local && (kmin + 31 < p0 - 128 || kmin > p0 + 63 + 128)) continue;
            bf16x8_t Kf[2][2];
#pragma unroll
            for (int blk = 0; blk < 2; ++blk)
#pragma unroll
                for (int s = 0; s < 2; ++s) Kf[blk][s] = *(const LAS bf16x8_t*)(Ks + (kb + 16 * blk + fr) * ATT_KLD + 32 * s + 8 * fq);
            bf16x8_t Vf[4];
            int vlane = (4 * fq + (fr >> 2)) * ATT_VLD + 4 * (fr & 3); asm volatile("" : "+v"(vlane));
#pragma unroll
            for (int db = 0; db < 4; ++db) {
                const LAS bf16_t* vp = Vt + kb * ATT_VLD + vlane + 16 * db;
                const bf16x4_t lo = __builtin_amdgcn_ds_read_tr16_b64_v4i16((LAS bf16x4_t*)vp), hi = __builtin_amdgcn_ds_read_tr16_b64_v4i16((LAS bf16x4_t*)(vp + 16 * ATT_VLD));
                Vf[db] = __builtin_shufflevector(lo, hi, 0, 1, 2, 3, 4, 5, 6, 7); }
            const bool needmask = local && ((kmin + 31) - p0 > 128 || (p0 + 63) - kmin > 128);
            float sv[4][8], lm[4]; bool grow = false;
#pragma unroll
            for (int qblk = 0; qblk < 4; ++qblk) {
                f32x4 S0 = (f32x4){0.f, 0.f, 0.f, 0.f}, S1 = S0;
                S0 = __builtin_amdgcn_mfma_f32_16x16x32_bf16(Kf[0][0], Qf[qblk][0], S0, 0, 0, 0); S0 = __builtin_amdgcn_mfma_f32_16x16x32_bf16(Kf[0][1], Qf[qblk][1], S0, 0, 0, 0);
                S1 = __builtin_amdgcn_mfma_f32_16x16x32_bf16(Kf[1][0], Qf[qblk][0], S1, 0, 0, 0); S1 = __builtin_amdgcn_mfma_f32_16x16x32_bf16(Kf[1][1], Qf[qblk][1], S1, 0, 0, 0);
#pragma unroll
                for (int r = 0; r < 4; ++r) { sv[qblk][r] = S0[r]; sv[qblk][4 + r] = S1[r]; }
                if (needmask) { const int qpos = p0 + qblk * 16 + fr;
#pragma unroll
                    for (int r = 0; r < 4; ++r) { int d0 = qpos - (kmin + 4 * fq + r); d0 = d0 < 0 ? -d0 : d0; int d1 = qpos - (kmin + 16 + 4 * fq + r); d1 = d1 < 0 ? -d1 : d1;
                        sv[qblk][r] = d0 <= 128 ? sv[qblk][r] : -__builtin_inff(); sv[qblk][4 + r] = d1 <= 128 ? sv[qblk][4 + r] : -__builtin_inff(); } }
                lm[qblk] = fmaxf(fmaxf(fmaxf(sv[qblk][0], sv[qblk][1]), fmaxf(sv[qblk][2], sv[qblk][3])), fmaxf(fmaxf(sv[qblk][4], sv[qblk][5]), fmaxf(sv[qblk][6], sv[qblk][7]))) * QS;
                grow = grow || (lm[qblk] > mrun[qblk] + 8.0f);
            }
            if (__any(grow)) {
#pragma unroll
                for (int qblk = 0; qblk < 4; ++qblk) { float cm = lm[qblk];
                    { const u32x2 r16 = __builtin_amdgcn_permlane16_swap(__float_as_uint(cm), __float_as_uint(cm), false, false); cm = fmaxf(__uint_as_float(r16.x), __uint_as_float(r16.y));
                      const u32x2 r32 = __builtin_amdgcn_permlane32_swap(__float_as_uint(cm), __float_as_uint(cm), false, false); cm = fmaxf(__uint_as_float(r32.x), __uint_as_float(r32.y)); }
                    const float mnew = fmaxf(mrun[qblk], cm), sc = __builtin_amdgcn_exp2f(mrun[qblk] - mnew);
                    lsum[qblk] *= sc; mrun[qblk] = mnew;
#pragma unroll
                    for (int db = 0; db < 4; ++db) O[qblk][db] = O[qblk][db] * sc; }
            }
#pragma unroll
            for (int qblk = 0; qblk < 4; ++qblk) {
                float pp[8], ps = 0.f;
#pragma unroll
                for (int r = 0; r < 8; ++r) { pp[r] = __builtin_amdgcn_exp2f(__builtin_fmaf(sv[qblk][r], QS, -mrun[qblk])); ps += pp[r]; }
                lsum[qblk] += ps;
                u32x4 pw; pw.x = pk2(pp[0], pp[1]); pw.y = pk2(pp[2], pp[3]); pw.z = pk2(pp[4], pp[5]); pw.w = pk2(pp[6], pp[7]);
                const bf16x8_t Pf = __builtin_bit_cast(bf16x8_t, pw);
#pragma unroll
                for (int db = 0; db < 4; ++db) O[qblk][db] = __builtin_amdgcn_mfma_f32_16x16x32_bf16(Vf[db], Pf, O[qblk][db], 0, 0, 0);
            }
        }
        if (tn >= 5) break;
        t = tn; buf ^= 1;
    }
#undef ATT_PF
#pragma unroll
    for (int qblk = 0; qblk < 4; ++qblk) {
        float l = lsum[qblk]; l += __shfl_xor(l, 16); l += __shfl_xor(l, 32);
        const float rl = 1.0f / l;
        const int qpos = p0 + qblk * 16 + fr;
        const size_t rowq = isctx ? (size_t)ML + b * 256 + qpos : (size_t)b * 2048 + qpos;
        bf16_t* yp = Y + rowq * D + 1024 + h * 64 + 4 * fq;
#pragma unroll
        for (int db = 0; db < 4; ++db) { const f32x4 o = O[qblk][db] * rl; u32x2 w; w.x = pk2(o[0], o[1]); w.y = pk2(o[2], o[3]); *(u32x2*)(yp + 16 * db) = w; }
    }
}
__device__ __forceinline__ void mix_attn(const bf16_t* P, bf16_t* Y, const float* sinkl, int nitems, LAS unsigned char* lds, int vcu, int G, int tid) {
    for (int it = (G == 256) ? ((vcu + 192) & 255) : vcu; it < nitems; it += G) {

        if (it < 512) { const int b = it >> 5, kvh = (it >> 4) & 1, qb = it & 15; attn_item(P, Y, sinkl, b, kvh, qb, false, lds, tid); }
        else { const int r = it - 512, b = r >> 2, kvh = (r >> 1) & 1, qb = r & 1; attn_item(P, Y, sinkl, b, kvh, qb, true, lds, tid); }
        __syncthreads();
    }
    __syncthreads();
}
constexpr int MLP_LD = 136, MLP_BUF = 128 * MLP_LD * 2;
__device__ __forceinline__ void mix_mlp(const bf16_t* __restrict__ P, const bf16_t* __restrict__ WSB  , const float* __restrict__ b_s  , bf16_t* __restrict__ Y, int nrows, LAS unsigned char* lds, int vcu, int G, int tid) {
    const int lane = tid & 63, wave = __builtin_amdgcn_readfirstlane(tid >> 6), fr = lane & 15, fq = lane >> 4;
    const int nitems = (nrows / 128) * 4, q = tid >> 2, cp = tid & 3;
    u32x4 vr[4]; int buf = 0;
#define MLP_PF(itt) do { const bf16_t* pr_ = P + ((size_t)((itt) >> 2) * 128 + q) * NPROJ + OFF_MV + ((itt) & 3) * 128 + cp * 32; \
        _Pragma("unroll") for (int j_ = 0; j_ < 4; ++j_) vr[j_] = *(const u32x4*)(pr_ + 8 * j_); } while (0)
    int it = (G == 256) ? ((vcu + 128) & 255) : vcu;
    if (it < nitems) MLP_PF(it);
    for (; it < nitems; it += G) {
        const int ch = it >> 2, g = it & 3; const size_t row0 = (size_t)ch * 128;
        LAS bf16_t* VnT = (LAS bf16_t*)(lds + buf * MLP_BUF);
        { float vv[32];
#pragma unroll
          for (int j = 0; j < 4; ++j) unpack8(vr[j], vv + 8 * j);
          float s1 = 0.f;
#pragma unroll
          for (int i = 0; i < 32; ++i) { vv[i] = gelu_tanh(vv[i]); s1 += vv[i]; }
          s1 += __shfl_xor(s1, 1); s1 += __shfl_xor(s1, 2);
          const float mean = s1 * (1.0f / 128.0f); float qq = 0.f;
#pragma unroll
          for (int i = 0; i < 32; ++i) { vv[i] -= mean; qq += vv[i] * vv[i]; }
          qq += __shfl_xor(qq, 1); qq += __shfl_xor(qq, 2);
          const float rstd = 1.0f / sqrtf(qq * (1.0f / 128.0f) + EPS);
#pragma unroll
          for (int i = 0; i < 32; ++i) VnT[(cp * 32 + i) * MLP_LD + q] = (bf16_t)f2bf(vv[i] * rstd); }
        __syncthreads();
        if (it + G < nitems) MLP_PF(it + G);
        const int p = 16 * wave + fr;
        bf16x8_t Wf[4];
#pragma unroll
        for (int ks = 0; ks < 4; ++ks) Wf[ks] = *(const bf16x8_t*)(WSB + ((size_t)g * 128 + p) * 128 + 32 * ks + 8 * fq);
        const float bias = b_s[g * 128 + p];
        const bf16_t* ur = P + (row0 + p) * NPROJ + OFF_U + g * 128 + 4 * fq;
        bf16_t* yr = Y + (row0 + p) * D + 1536 + g * 128 + 4 * fq;
        u32x2 uw[8];
#pragma unroll
        for (int cb = 0; cb < 8; ++cb) uw[cb] = *(const u32x2*)(ur + 16 * cb);
#pragma unroll
        for (int cb = 0; cb < 8; ++cb) {
            f32x4 acc = (f32x4){0.f, 0.f, 0.f, 0.f};
#pragma unroll
            for (int ks = 0; ks < 4; ++ks) { const bf16x8_t Vf = *(const LAS bf16x8_t*)(VnT + (16 * cb + fr) * MLP_LD + 32 * ks + 8 * fq);
                acc = __builtin_amdgcn_mfma_f32_16x16x32_bf16(Vf, Wf[ks], acc, 0, 0, 0); }
            const float u0 = gelu_tanh(__uint_as_float(uw[cb].x << 16)), u1 = gelu_tanh(__uint_as_float(uw[cb].x & 0xffff0000u)), u2 = gelu_tanh(__uint_as_float(uw[cb].y << 16)), u3 = gelu_tanh(__uint_as_float(uw[cb].y & 0xffff0000u));
            u32x2 w; w.x = pk2(u0 * (acc[0] + bias), u1 * (acc[1] + bias)); w.y = pk2(u2 * (acc[2] + bias), u3 * (acc[3] + bias));
            *(u32x2*)(yr + 16 * cb) = w;
        }
        buf ^= 1;
    }
#undef MLP_PF
    __syncthreads();
}
constexpr int PH_LAYER0 = 2, PH_PER_LAYER = 10, PH_FINAL = PH_LAYER0 + DEPTH * PH_PER_LAYER, NPH = PH_FINAL + 1;
#ifndef PROBE_DUP
#define PROBE_DUP 0
#endif
#ifndef STAGGER_TICKS
#define STAGGER_TICKS 150
#endif
#ifndef MK_ONE_LAUNCH
#define MK_ONE_LAUNCH 1
#endif
struct Args { const float* in[18]; float* out; unsigned char* ws; int ph_lo, ph_hi, use_bar, pad; };
__global__ void __launch_bounds__(NTHREADS, 2) fwd(Args a) {
    extern __shared__ __attribute__((aligned(16))) unsigned char lds_raw[];
    LAS unsigned char* lds = (LAS unsigned char*)lds_raw;
    volatile LAS unsigned* MISC = (volatile LAS unsigned*)(lds + MISC_OFF);
    const int G = gridDim.x, bx = blockIdx.x, vcu = (G % 8 == 0) ? (bx % 8) * (G / 8) + bx / 8 : bx;
    const int NGW = G * NWAVES; const size_t NT = (size_t)G * NTHREADS;
#define TID_VARS int tid = threadIdx.x; asm volatile("" : "+v"(tid)); const int lane = tid & 63, wave = __builtin_amdgcn_readfirstlane(tid >> 6), gw = vcu * NWAVES + wave; const size_t gtid = (size_t)vcu * NTHREADS + tid; (void)lane; (void)gw; (void)gtid
    unsigned* ctl = (unsigned*)(a.ws + WS_CTL);
    for (int u = threadIdx.x; u < (LDS_BYTES - LDSCTL_OFF) / 4; u += NTHREADS) ((LAS unsigned*)(lds + LDSCTL_OFF))[u] = 0u;
    __syncthreads();
    XcdBarrier bar; bar.bar = ctl + CW_BAR; bar.x = 0; bar.st = nullptr;
    if (a.use_bar) bar = xcd_barrier_post(ctl + CW_BAR, MISC + 8);
    const int lo = a.ph_lo, hi = a.ph_hi;
#define IN(k) (lo <= (k) && (k) < hi)
#define SEAM(k) do { if (IN(k) && IN((k) + 1)) xcd_barrier(bar); } while (0)
#define STAGGER() do { if (STAGGER_TICKS) { const unsigned long long t0_ = __builtin_amdgcn_s_memrealtime(), w_ = (unsigned long long)(bx >> 5) * STAGGER_TICKS; while (__builtin_amdgcn_s_memrealtime() - t0_ < w_) __builtin_amdgcn_s_sleep(4); } } while (0)
#define REP(bit) for (int rep_ = 0; rep_ < (((PROBE_DUP) >> (bit)) & 1) + 1; ++rep_)
#define REPBAR() do { if (rep_ == 0 && a.use_bar && PROBE_DUP) xcd_barrier(bar); } while (0)
#define ARG_VARS const __attribute__((address_space(4))) Args* ap_ = (const __attribute__((address_space(4))) Args*)__builtin_amdgcn_kernarg_segment_ptr(); asm volatile("" : "+s"(ap_)); \
    unsigned char* const ws = ap_->ws; \
    const float* const x = ap_->in[0]; const float* const cvec = ap_->in[1]; const float* const ctx = ap_->in[2]; const float* const c_ctx = ap_->in[3]; const float* const w_ada = ap_->in[4]; const float* const b_ada = ap_->in[5]; \
    const float* const g_norm1 = ap_->in[6]; const float* const w_in = ap_->in[7]; const float* const w_conv = ap_->in[8]; const float* const sink = ap_->in[9]; const float* const w_s = ap_->in[10]; const float* const b_s = ap_->in[11]; \
    const float* const w_out = ap_->in[12]; const float* const g_norm2 = ap_->in[13]; const float* const w_gate = ap_->in[14]; const float* const w_up = ap_->in[15]; const float* const w_down = ap_->in[16]; const float* const g_final = ap_->in[17]; \
    bf16_t* const WIN = (bf16_t*)(ws + WS_WIN); bf16_t* const WOUT = (bf16_t*)(ws + WS_WOUT); bf16_t* const WGU = (bf16_t*)(ws + WS_WGU); bf16_t* const WDN = (bf16_t*)(ws + WS_WDN); \
    float* const MOD = (float*)(ws + WS_MOD); float* const MODP = (float*)(ws + WS_MODP); bf16_t* const XS = (bf16_t*)(ws + WS_XS); \
    bf16_t* const H = (bf16_t*)(ws + WS_H); bf16_t* const P = (bf16_t*)(ws + WS_P); bf16_t* const Y = (bf16_t*)(ws + WS_Y); bf16_t* const HF = (bf16_t*)(ws + WS_HF); \
    bf16_t* const TT = (bf16_t*)(ws + WS_TT); bf16_t* const TTC = (bf16_t*)(ws + WS_TTC); bf16_t* const DFTN = (bf16_t*)(ws + WS_DFTN); bf16_t* const DFTC = (bf16_t*)(ws + WS_DFTC); \
    f32x2* const ROPE = (f32x2*)(ws + WS_ROPE); bf16_t* const CSBD = (bf16_t*)(ws + WS_CSBD); bf16_t* const DL = (bf16_t*)(ws + WS_DL); bf16_t* const WSB = (bf16_t*)(ws + WS_WSB); \
    const float* const modl = MOD + (size_t)l * 17 * MODW; \
    (void)x; (void)cvec; (void)ctx; (void)c_ctx; (void)w_ada; (void)b_ada; (void)g_norm1; (void)w_in; (void)w_conv; (void)sink; (void)w_s; (void)b_s; (void)w_out; (void)g_norm2; (void)w_gate; (void)w_up; (void)w_down; (void)g_final; \
    (void)WIN; (void)WOUT; (void)WGU; (void)WDN; (void)MOD; (void)MODP; (void)XS; (void)H; (void)P; (void)Y; (void)HF; (void)TT; (void)TTC; (void)DFTN; (void)DFTC; (void)ROPE; (void)CSBD; (void)DL; (void)WSB; (void)modl

    REP(14) { if (rep_) xcd_barrier(bar);
    if (IN(0)) { const int l = 0; ARG_VARS; TID_VARS;
        LAS float* scr = (LAS float*)(lds + wave * 17408);
        p0_modp(cvec, c_ctx, w_ada, MODP, scr, gw, NGW, lane);
        p0_transposes(w_in, w_out, WIN, WOUT, scr, gw, NGW, lane);
        p0_tables(DFTN, DFTC, CSBD, ROPE, gtid, NT);
        SEAM(0);
    }
    if (IN(1)) { const int l = 0; ARG_VARS; TID_VARS; p1_mod(MODP, b_ada, MOD, gtid, NT); p1_wsb(w_s, WSB, gtid, NT); SEAM(1); } }

#define PASS_RANGE_LAT(ra) const int rw_ = (G == 256) ? ((bx < 128) ? (ra) : 256 - (ra)) : 0; \
        const int r0 = (G == 256) ? (((bx < 128) ? bx * (ra) : 128 * (ra) + (bx - 128) * (256 - (ra))) + wave * (rw_ >> 3)) : gw * ((ML + NGW - 1) / NGW); \
        const int r1 = (G == 256) ? r0 + (rw_ >> 3) : ((r0 + (ML + NGW - 1) / NGW < ML) ? r0 + (ML + NGW - 1) / NGW : ML)
#define PASS_RANGE_CTX() const int cr_ = (MC + NGW - 1) / NGW, r0 = ML + gw * cr_, r1 = (r0 + cr_ < MT) ? r0 + cr_ : MT
    for (int l = 0; l < DEPTH; ++l) {
        const int pb = PH_LAYER0 + l * PH_PER_LAYER;
        const bool lastl = (l == DEPTH - 1);
        const int Mrows = lastl ? ML : MT;
        if (IN(pb + 0)) { ARG_VARS;
            if (l == 0) { TID_VARS; const int rpw = (MT + NGW - 1) / NGW, r0 = gw * rpw, r1 = (r0 + rpw < MT) ? r0 + rpw : MT;
                resnorm_rows<true, false, true>(x, ctx, nullptr, XS, g_norm1, modl, 0, D, H, r0, r1, lane); }
            else {
                { pg8::Gemm g{HF + (size_t)ML * DFF, WDN + (size_t)(l - 1) * D * DFF, MC, D, DFF, DFF, DFF}; pg8::StaticOrder S; S.init(MC, D, G, bx);
                  pg8::EpiRes E{XS, modl - (size_t)17 * MODW, 5 * D, 128};
                  pg8::gemm_phase<pg8::EpiRes, pg8::StaticOrder, true, true>(lds, g, S, E); }
                TID_VARS; PASS_RANGE_LAT(0);
                resnorm_rows<false, false, false>(XS, XS, nullptr, nullptr, g_norm1 + l * D, modl, 0, D, H, r0, r1, lane);
                if (G != 256 || bx >= 128) { const int sw = (G == 256) ? (bx - 128) * NWAVES + wave : gw, nsw = (G == 256) ? 128 * NWAVES : NGW; LAS float* scr = (LAS float*)(lds + wave * 17408);
                    if (l == 1) tr_wout123(w_out, WOUT, scr, sw, nsw, lane);
                    else if (l == 2) tr_down(w_down + (size_t)3 * DFF * D, WDN + (size_t)3 * D * DFF, scr, sw, nsw, lane);
                    else tr_gateup(w_gate + (size_t)l * D * DFF, w_up + (size_t)l * D * DFF, WGU + (size_t)l * NGU * D, scr, sw, nsw, lane); } }
            SEAM(pb + 0); }
        if (IN(pb + 1)) { ARG_VARS; if (l > 0) { TID_VARS; PASS_RANGE_CTX();
                resnorm_rows<false, false, false>(XS, XS + (size_t)ML * D, nullptr, nullptr, g_norm1 + l * D, modl, 0, D, H, r0, r1, lane); }
            if (l > 0) SEAM(pb + 1); }
        REP(2) { if (rep_) xcd_barrier(bar);
        if (IN(pb + 2)) { ARG_VARS;
            pg8::Gemm g{H, WIN + (size_t)l * NPROJ * D, Mrows, NPROJ, D, D, D}; pg8::OrderIn S; S.init(Mrows, NPROJ, G, bx); S.extra = lastl ? 16 : 0;
            { int tt_ = threadIdx.x; asm volatile("" : "+v"(tt_)); for (int i = tt_; i < 96 * 16 * 2 / 4; i += NTHREADS) ((LAS f32x4*)(lds + ROPE_LDS_OFF))[i] = ((const f32x4*)ROPE)[i]; }
            pg8::EpiP E{P, NPROJ, (const LAS float*)(lds + ROPE_LDS_OFF)};
            pg8::gemm_phase<pg8::EpiP, pg8::OrderIn, true, true>(lds, g, S, E);
            if (!lastl) { const int rem = ((Mrows / 256) * 15) % G;
              if (rem != 0 && bx >= rem) { TID_VARS; tr_gateup(w_gate + (size_t)l * D * DFF, w_up + (size_t)l * D * DFF, WGU + (size_t)l * NGU * D, (LAS float*)(lds + wave * 17408), (bx - rem) * NWAVES + wave, (G - rem) * NWAVES, lane); }
              else if (rem == 0) { TID_VARS; tr_gateup(w_gate + (size_t)l * D * DFF, w_up + (size_t)l * D * DFF, WGU + (size_t)l * NGU * D, (LAS float*)(lds + wave * 17408), gw, NGW, lane); }
            }
            SEAM(pb + 2);
        } }
        REP(3) { if (rep_) xcd_barrier(bar);
        if (IN(pb + 3)) { ARG_VARS;
            REP(16) { int kf = 128; asm volatile("" : "+s"(kf));
              pg8::Gemm g{CSBD, P + OFF_F, 1024, Mrows, kf, 128, NPROJ}; pg8::OrderFour1 S; S.init(Mrows / 256, G, bx);
              pg8::EpiFour1 E{TT, TTC};
              pg8::gemm_phase<pg8::EpiFour1, pg8::OrderFour1, true, true>(lds, g, S, E); }
            TID_VARS;
            const bool conv_last = ((bx >> 3) & 1) != 0;
            if (!conv_last) { REP(17) mix_conv(P, w_conv + (size_t)l * 3 * 512, Y, Mrows, gtid, NT); }
            REP(18) mix_attn(P, Y, sink + l * 8, lastl ? 512 : 576, lds, bx, G, tid);
            REP(19) mix_mlp(P, WSB + (size_t)l * 4 * 128 * 128, b_s + (size_t)l * 4 * 128, Y, Mrows, lds, bx, G, tid);
            if (conv_last) { REP(17) mix_conv(P, w_conv + (size_t)l * 3 * 512, Y, Mrows, gtid, NT); }
            SEAM(pb + 3);
        } }
        REP(4) { if (rep_) xcd_barrier(bar);
        if (IN(pb + 4)) { ARG_VARS;
            { pg8::Gemm g{DFTN, TT, 2048, 8192, 4096, 4096, 4096}; pg8::StaticOrder S; S.init(2048, 8192, G, bx);
              pg8::EpiFourEO E{Y, 1.0f / 512.0f};
              pg8::gemm_phase<pg8::EpiFourEO, pg8::StaticOrder, true, true, true>(lds, g, S, E); }
            { TID_VARS; four_nyquist_rows(TT, Y, gw, NGW, lane); }
            if (!lastl) { pg8::Gemm g{DFTC, TTC, 256, 8192, 512, 512, 512}; pg8::StaticOrder S; S.init(256, 8192, G, bx);
              pg8::EpiFour E{Y, 0.005524271728019903f  , ML, 256};
              pg8::gemm_phase<pg8::EpiFour, pg8::StaticOrder, true, true>(lds, g, S, E); }
            if (!lastl && bx >= 32 && G > 32) { TID_VARS;
                tr_down(w_down + (size_t)l * DFF * D, WDN + (size_t)l * D * DFF, (LAS float*)(lds + wave * 17408), (bx - 32) * NWAVES + wave, (G - 32) * NWAVES, lane); }
            else if (!lastl && G <= 32) { TID_VARS; tr_down(w_down + (size_t)l * DFF * D, WDN + (size_t)l * D * DFF, (LAS float*)(lds + wave * 17408), gw, NGW, lane); }
            SEAM(pb + 4);
        } }
        REP(5) { if (rep_) xcd_barrier(bar);
        if (IN(pb + 5)) { ARG_VARS;
            pg8::Gemm g{Y, WOUT + (size_t)l * D * D, ML, D, D, D, D}; pg8::StaticOrder S; S.init(ML, D, G, bx);
            pg8::EpiRes E{XS, modl, 2 * D, 0};
            pg8::gemm_phase<pg8::EpiRes, pg8::StaticOrder, true, true>(lds, g, S, E);
            SEAM(pb + 5);
        } }
        if (IN(pb + 6)) { ARG_VARS;
            if (!lastl) { pg8::Gemm g{Y + (size_t)ML * D, WOUT + (size_t)l * D * D, MC, D, D, D, D}; pg8::StaticOrder S; S.init(MC, D, G, bx);
              pg8::EpiRes E{XS, modl, 2 * D, 128};
              pg8::gemm_phase<pg8::EpiRes, pg8::StaticOrder, true, true>(lds, g, S, E); }
            TID_VARS; PASS_RANGE_LAT(lastl ? 128 : 40);
            resnorm_rows<false, false, false>(XS, XS, nullptr, nullptr, g_norm2 + l * D, modl, 3 * D, 4 * D, H, r0, r1, lane);
            if (PROBE_DUP & (1 << 20)) resnorm_rows<false, false, false>(XS, XS, nullptr, nullptr, g_norm2 + l * D, modl, 3 * D, 4 * D, H, r0, r1, lane);
            SEAM(pb + 6); }
        if (IN(pb + 7)) { ARG_VARS; if (!lastl) { TID_VARS; PASS_RANGE_CTX();
                resnorm_rows<false, false, false>(XS, XS + (size_t)ML * D, nullptr, nullptr, g_norm2 + l * D, modl, 3 * D, 4 * D, H, r0, r1, lane); }
            if (!lastl) SEAM(pb + 7); }
        REP(8) { if (rep_) xcd_barrier(bar);
        if (IN(pb + 8)) { ARG_VARS;
            pg8::Gemm g{H, WGU + (size_t)l * NGU * D, Mrows, NGU, D, D, D}; pg8::StaticOrder S; S.init(Mrows, NGU, G, bx);
            pg8::EpiGU E{HF};
            pg8::gemm_phase<pg8::EpiGU, pg8::StaticOrder, true, true>(lds, g, S, E);
            if (!lastl) { const int rem = ((Mrows / 256) * 44) % G;
              if (rem != 0 && bx >= rem) { TID_VARS; tr_win(w_in + (size_t)(l + 1) * D * NPROJ, WIN + (size_t)(l + 1) * NPROJ * D, (LAS float*)(lds + wave * 17408), (bx - rem) * NWAVES + wave, (G - rem) * NWAVES, lane); }
              else if (rem == 0) { TID_VARS; tr_win(w_in + (size_t)(l + 1) * D * NPROJ, WIN + (size_t)(l + 1) * NPROJ * D, (LAS float*)(lds + wave * 17408), gw, NGW, lane); }
            }
            SEAM(pb + 8);
        } }
        REP(9) { if (rep_) xcd_barrier(bar);
        if (IN(pb + 9)) { ARG_VARS;
            pg8::Gemm g{HF, WDN + (size_t)l * D * DFF, ML, D, DFF, DFF, DFF}; pg8::StaticOrder S; S.init(ML, D, G, bx);
            pg8::EpiRes E{XS, modl, 5 * D, 0};
            pg8::gemm_phase<pg8::EpiRes, pg8::StaticOrder, true, true>(lds, g, S, E);
            SEAM(pb + 9);
        } }
    }
    if (IN(PH_FINAL)) { const int l = 0; ARG_VARS; TID_VARS; final_rows(XS, g_final, a.out, gw, NGW, lane); }
#undef IN
#undef SEAM
}

extern "C" void kernel_launch(void* const* d_in, const int* in_sizes, int n_in, void* d_out, int out_size, void* d_ws, size_t ws_size, hipStream_t stream) {
    static int grid = 0;
    if (grid == 0) {
        if (n_in != 18 || in_sizes[0] != ML * D || out_size != ML * D || ws_size < WS_END) { fprintf(stderr, "kernel_launch: unexpected shapes: n_in %d in0 %d out %d ws %zu (need %zu)\n", n_in, n_in > 0 ? in_sizes[0] : -1, out_size, ws_size, (size_t)WS_END); grid = -1; return; }
        int dev = 0, cus = 0, per_cu = 0;
        if (hipGetDevice(&dev) != hipSuccess || hipDeviceGetAttribute(&cus, hipDeviceAttributeMultiprocessorCount, dev) != hipSuccess) { fprintf(stderr, "kernel_launch: device query failed\n"); grid = -1; return; }
        if (hipFuncSetAttribute((const void*)fwd, hipFuncAttributeMaxDynamicSharedMemorySize, LDS_BYTES) != hipSuccess) { fprintf(stderr, "kernel_launch: hipFuncSetAttribute failed\n"); grid = -1; return; }
        if (hipOccupancyMaxActiveBlocksPerMultiprocessor(&per_cu, (const void*)fwd, NTHREADS, LDS_BYTES) != hipSuccess || per_cu < 1) fprintf(stderr, "kernel_launch: note: occupancy query reports %d workgroups per CU\n", per_cu);
        (void)hipGetLastError();
        grid = cus;
    }
    if (grid < 0) return;
    if (hipMemsetAsync((char*)d_ws + WS_CTL, 0, 32768  , stream) != hipSuccess) { fprintf(stderr, "kernel_launch: memset failed\n"); return; }
    Args a{};
    for (int i = 0; i < 18; ++i) a.in[i] = (const float*)d_in[i];
    a.out = (float*)d_out; a.ws = (unsigned char*)d_ws; a.pad = 0;
#if MK_ONE_LAUNCH
    a.ph_lo = 0; a.ph_hi = NPH; a.use_bar = 1;
    hipLaunchKernelGGL(fwd, dim3(grid), dim3(NTHREADS), LDS_BYTES, stream, a);
#else
    for (int ph = 0; ph < NPH; ++ph) { a.ph_lo = ph; a.ph_hi = ph + 1; a.use_bar = 0; hipLaunchKernelGGL(fwd, dim3(grid), dim3(NTHREADS), LDS_BYTES, stream, a); }
#endif
    const hipError_t le = hipPeekAtLastError();
    if (le != hipSuccess) fprintf(stderr, "kernel_launch: launch failed: %s\n", hipGetErrorName(le));
}
```

```cpp
#include <hip/hip_runtime.h>
#include <cstdio>
#include <cstdint>
namespace pg8 {
#define PG8_LAS __attribute__((address_space(3)))
typedef unsigned short bf16_t;
typedef short bf16x8 __attribute__((ext_vector_type(8)));
typedef float f32x4 __attribute__((ext_vector_type(4)));
typedef unsigned u32x4 __attribute__((ext_vector_type(4)));
constexpr int BM = 256, BK = 64, HALF = 128, HTB = HALF * BK * 2  , STAGE_BYTES = 8 * HTB, NXCD = 8, WGM = 8;

__host__ __device__ __forceinline__ int lds_byte(int r, int c) { const int st = (r >> 4) * 2 + (c >> 5), rr = r & 15, cc = c & 31, ob = rr * 64 + cc * 2; return st * 1024 + (ob ^ (((ob >> 9) & 1) << 5)); }
__host__ __device__ __forceinline__ void stage_rc(int b, int& R, int& C) { const int st = b / 1024, sb = b % 1024, swz = sb ^ (((sb >> 9) & 1) << 5); R = (st >> 1) * 16 + swz / 64; C = (st & 1) * 32 + (swz % 64) / 2; }
__host__ __device__ __forceinline__ int perm32(int rho) { const int n = rho >> 4, i = rho & 15; return 8 * (i >> 2) + 4 * n + (i & 3); }

struct Unit { int pm, pn, bo; };
struct Gemm { const bf16_t* A; const bf16_t* Bt; int M, N, K, lda, ldb; };

struct StaticOrder {
    int nM, nN, nwg, G, c;
    __host__ __device__ void init(int M, int N, int G_, int c_) { nM = M / BM; nN = N / BM; nwg = nM * nN; G = G_; c = c_; }
    __host__ __device__ bool next(int i, Unit& u) const {
        const long L = (long)i * G + c; if (L >= nwg) return false;
        int wgid = (int)L; { const int q = nwg / NXCD, r = nwg % NXCD, xcd = wgid % NXCD, off = wgid / NXCD; wgid = (xcd < r ? xcd * (q + 1) : r * (q + 1) + (xcd - r) * q) + off; }
        const int nig = WGM * nN, gid = wgid / nig, fm = gid * WGM, gsz = (nM - fm) < WGM ? (nM - fm) : WGM;
        u.pm = fm + ((wgid % nig) % gsz); u.pn = (wgid % nig) / gsz; u.bo = 0; return true;
    }
    __device__ __forceinline__ void a_ready(const Unit&) const {}
    __device__ __forceinline__ void done(const Unit&) const {}
};

struct OrderIn : StaticOrder {
    int extra;
    __host__ __device__ bool next(int i, Unit& u) const {
        const long L = (long)i * G + c; if (L < nwg) return StaticOrder::next(i, u);
        const long j = L - nwg; if (j >= extra) return false;
        u.pm = 128 + (int)j; u.pn = 10; u.bo = 0; return true;
    }
};
struct OrderFour1 {
    int nwg, G, c;
    __host__ __device__ void init(int npanels, int G_, int c_) { nwg = 4 * npanels; G = G_; c = c_; }
    __host__ __device__ bool next(int i, Unit& u) const { const long L = (long)i * G + c; if (L >= nwg) return false; u.pm = (int)(L & 3); u.pn = (int)(L >> 2); u.bo = u.pm * 128; return true; }
    __device__ __forceinline__ void a_ready(const Unit&) const {}
    __device__ __forceinline__ void done(const Unit&) const {}
};
typedef float f32x2 __attribute__((ext_vector_type(2)));
typedef unsigned u32x2 __attribute__((ext_vector_type(2)));
typedef __bf16 bf16x2_hw __attribute__((ext_vector_type(2)));
__device__ __forceinline__ unsigned cvt_pk_bf16(float lo, float hi) { const f32x2 v = {lo, hi}; const bf16x2_hw b = __builtin_convertvector(v, bf16x2_hw); return __builtin_bit_cast(unsigned, b); }
__device__ __forceinline__ float silu_f(float x) { return x * __builtin_amdgcn_rcpf(1.0f + __expf(-x)); }
struct EpiP {
    static constexpr bool PERM = true, AFTER_DRAIN = false; static constexpr int NSTORES = 16;
    bf16_t* O; int ldc; const PG8_LAS float* rope;
    __device__ __forceinline__ void operator()(const f32x4 (&acc)[2][2][4][2], const Unit& u, int wr, int wc, int fr, int fq) const {
        const int row0 = u.pm * BM + wr * 64 + fr;
        if (u.pn < 4) {
            bf16_t* zp = O + (size_t)row0 * ldc + u.pn * HALF + wc * 32 + 8 * fq;
#pragma unroll
            for (int ai = 0; ai < 2; ++ai)
#pragma unroll
                for (int m = 0; m < 4; ++m) { const f32x4 v0 = acc[ai][0][m][0] * acc[ai][1][m][0], v1 = acc[ai][0][m][1] * acc[ai][1][m][1];
                    u32x4 w; w.x = cvt_pk_bf16(v0[0], v0[1]); w.y = cvt_pk_bf16(v0[2], v0[3]); w.z = cvt_pk_bf16(v1[0], v1[1]); w.w = cvt_pk_bf16(v1[2], v1[3]);
                    *(u32x4*)(zp + (size_t)(ai * HALF + m * 16) * ldc) = w; }
            return;
        }
        const int col0 = (u.pn < 6 ? u.pn - 2 : u.pn) * BM + wc * 32 + 8 * fq;
        const bool qk = (u.pm < 128) && (u.pn >= 8) && (u.pn <= 10);
        const float sgn = (fq >> 1) ? 1.0f : -1.0f; const bool lo = fq < 2;
#pragma unroll
        for (int ai = 0; ai < 2; ++ai)
#pragma unroll
            for (int m = 0; m < 4; ++m) { const int row = row0 + ai * HALF + m * 16; bf16_t* rowp = O + (size_t)row * ldc + col0;
                f32x4 cs[4];
                if (qk) { const int pos = row & 2047, coord = (wc & 1) ? 32 + (pos & 63) : (pos >> 6); const PG8_LAS float* rp = rope + (coord * 16 + (fq & 1) * 8) * 2;
#pragma unroll
                    for (int k = 0; k < 4; ++k) cs[k] = *(const PG8_LAS f32x4*)(rp + 4 * k); }
#pragma unroll
                for (int bj = 0; bj < 2; ++bj) { f32x4 v0 = acc[ai][bj][m][0], v1 = acc[ai][bj][m][1];
                    if (qk && (u.pn != 10 || bj == 0)) {
                        f32x4 p0, p1;
#pragma unroll
                        for (int e = 0; e < 4; ++e) {
                            const u32x2 s0 = __builtin_amdgcn_permlane32_swap(__float_as_uint(v0[e]), __float_as_uint(v0[e]), false, false); p0[e] = __uint_as_float(lo ? s0.y : s0.x);
                            const u32x2 s1 = __builtin_amdgcn_permlane32_swap(__float_as_uint(v1[e]), __float_as_uint(v1[e]), false, false); p1[e] = __uint_as_float(lo ? s1.y : s1.x); }
                        v0[0] = v0[0] * cs[0].x + sgn * (p0[0] * cs[0].y); v0[1] = v0[1] * cs[0].z + sgn * (p0[1] * cs[0].w);
                        v0[2] = v0[2] * cs[1].x + sgn * (p0[2] * cs[1].y); v0[3] = v0[3] * cs[1].z + sgn * (p0[3] * cs[1].w);
                        v1[0] = v1[0] * cs[2].x + sgn * (p1[0] * cs[2].y); v1[1] = v1[1] * cs[2].z + sgn * (p1[1] * cs[2].w);
                        v1[2] = v1[2] * cs[3].x + sgn * (p1[2] * cs[3].y); v1[3] = v1[3] * cs[3].z + sgn * (p1[3] * cs[3].w);
                    }
                    u32x4 w; w.x = cvt_pk_bf16(v0[0], v0[1]); w.y = cvt_pk_bf16(v0[2], v0[3]); w.z = cvt_pk_bf16(v1[0], v1[1]); w.w = cvt_pk_bf16(v1[2], v1[3]);
                    *(u32x4*)(rowp + bj * HALF) = w; } }
    }
};
struct EpiRes {
    static constexpr bool PERM = true, AFTER_DRAIN = false; static constexpr int NSTORES = 16;
    bf16_t* XS; const float* modl; int goff, pm_off;
    __device__ __forceinline__ void operator()(const f32x4 (&acc)[2][2][4][2], const Unit& u, int wr, int wc, int fr, int fq) const {
        const int pm = u.pm + pm_off, b = pm < 128 ? (pm >> 3) : 16;
        const int row0 = pm * BM + wr * 64 + fr, col0 = u.pn * BM + wc * 32 + 8 * fq;
        const float* gate = modl + (size_t)b * 12288 + goff;
        f32x4 gv[2][2];
#pragma unroll
        for (int bj = 0; bj < 2; ++bj)
#pragma unroll
            for (int n = 0; n < 2; ++n) gv[bj][n] = *(const f32x4*)(gate + col0 + bj * HALF + 4 * n);
#pragma unroll
        for (int ai = 0; ai < 2; ++ai) {
            u32x4 xw[4][2];
#pragma unroll
            for (int m = 0; m < 4; ++m)
#pragma unroll
                for (int bj = 0; bj < 2; ++bj) xw[m][bj] = *(const u32x4*)(XS + (size_t)(row0 + ai * HALF + m * 16) * 2048 + col0 + bj * HALF);
#pragma unroll
            for (int m = 0; m < 4; ++m) { bf16_t* rowp = XS + (size_t)(row0 + ai * HALF + m * 16) * 2048 + col0;
#pragma unroll
                for (int bj = 0; bj < 2; ++bj) { const u32x4 xv = xw[m][bj];
                    const f32x4 x0 = {__uint_as_float(xv.x << 16), __uint_as_float(xv.x & 0xffff0000u), __uint_as_float(xv.y << 16), __uint_as_float(xv.y & 0xffff0000u)};
                    const f32x4 x1 = {__uint_as_float(xv.z << 16), __uint_as_float(xv.z & 0xffff0000u), __uint_as_float(xv.w << 16), __uint_as_float(xv.w & 0xffff0000u)};
                    const f32x4 v0 = x0 + acc[ai][bj][m][0] * gv[bj][0], v1 = x1 + acc[ai][bj][m][1] * gv[bj][1];
                    u32x4 w; w.x = cvt_pk_bf16(v0[0], v0[1]); w.y = cvt_pk_bf16(v0[2], v0[3]); w.z = cvt_pk_bf16(v1[0], v1[1]); w.w = cvt_pk_bf16(v1[2], v1[3]);
                    *(u32x4*)(rowp + bj * HALF) = w; } }
        }
    }
};
struct EpiGU {
    static constexpr bool PERM = true, AFTER_DRAIN = false; static constexpr int NSTORES = 8;
    bf16_t* O;
    __device__ __forceinline__ void operator()(const f32x4 (&acc)[2][2][4][2], const Unit& u, int wr, int wc, int fr, int fq) const {
        const int row0 = u.pm * BM + wr * 64 + fr, col0 = u.pn * HALF + wc * 32 + 8 * fq;
#pragma unroll
        for (int ai = 0; ai < 2; ++ai)
#pragma unroll
            for (int mp = 0; mp < 4; mp += 2) {
                f32x2 gg[8], uu[8], e[8];
#pragma unroll
                for (int q = 0; q < 2; ++q)
#pragma unroll
                    for (int n = 0; n < 2; ++n) { const f32x4 ga = acc[ai][0][mp + q][n], ua = acc[ai][1][mp + q][n];
                        gg[q * 4 + n * 2] = (f32x2){ga[0], ga[1]}; gg[q * 4 + n * 2 + 1] = (f32x2){ga[2], ga[3]}; uu[q * 4 + n * 2] = (f32x2){ua[0], ua[1]}; uu[q * 4 + n * 2 + 1] = (f32x2){ua[2], ua[3]}; }
#pragma unroll
                for (int i = 0; i < 8; ++i) { const f32x2 t = gg[i] * -1.4426950408889634f; e[i] = (f32x2){__builtin_amdgcn_exp2f(t[0]), __builtin_amdgcn_exp2f(t[1])}; }
#pragma unroll
                for (int i = 0; i < 8; ++i) { const f32x2 d = e[i] + 1.0f; e[i] = (f32x2){__builtin_amdgcn_rcpf(d[0]), __builtin_amdgcn_rcpf(d[1])}; }
#pragma unroll
                for (int i = 0; i < 8; ++i) e[i] = (gg[i] * uu[i]) * e[i];
#pragma unroll
                for (int q = 0; q < 2; ++q) { bf16_t* rowp = O + (size_t)(row0 + ai * HALF + (mp + q) * 16) * 5632 + col0;
                    u32x4 w; w.x = cvt_pk_bf16(e[q * 4 + 0][0], e[q * 4 + 0][1]); w.y = cvt_pk_bf16(e[q * 4 + 1][0], e[q * 4 + 1][1]); w.z = cvt_pk_bf16(e[q * 4 + 2][0], e[q * 4 + 2][1]); w.w = cvt_pk_bf16(e[q * 4 + 3][0], e[q * 4 + 3][1]);
                    *(u32x4*)rowp = w; }
            }
    }
};
struct EpiFour {
    static constexpr bool PERM = true, AFTER_DRAIN = false; static constexpr int NSTORES = 16;
    bf16_t* Y; float scale; int row_base, rows_per_batch;
    __device__ __forceinline__ void operator()(const f32x4 (&acc)[2][2][4][2], const Unit& u, int wr, int wc, int fr, int fq) const {
        const int row0 = row_base + (u.pn >> 1) * rows_per_batch + u.pm * BM + wr * 64 + fr, col0 = 512 + (u.pn & 1) * BM + wc * 32 + 8 * fq;
#pragma unroll
        for (int ai = 0; ai < 2; ++ai)
#pragma unroll
            for (int m = 0; m < 4; ++m) { bf16_t* rowp = Y + (size_t)(row0 + ai * HALF + m * 16) * 2048 + col0;
#pragma unroll
                for (int bj = 0; bj < 2; ++bj) { const f32x4 v0 = acc[ai][bj][m][0] * scale, v1 = acc[ai][bj][m][1] * scale;
                    u32x4 w; w.x = cvt_pk_bf16(v0[0], v0[1]); w.y = cvt_pk_bf16(v0[2], v0[3]); w.z = cvt_pk_bf16(v1[0], v1[1]); w.w = cvt_pk_bf16(v1[2], v1[3]);
                    *(u32x4*)(rowp + bj * HALF) = w; } }
    }
};
struct EpiFourEO {
    static constexpr bool PERM = true, AFTER_DRAIN = false; static constexpr int NSTORES = 16;
    bf16_t* Y; float scale;
    __device__ __forceinline__ void operator()(const f32x4 (&acc)[2][2][4][2], const Unit& u, int wr, int wc, int fr, int fq) const {
        const int rowb = (u.pn >> 1) * 2048, col0 = 512 + (u.pn & 1) * BM + wc * 32 + 8 * fq;
#pragma unroll
        for (int m = 0; m < 4; ++m) { const int k = u.pm * HALF + wr * 64 + m * 16 + fr;
            bf16_t* ra = Y + (size_t)(rowb + k) * 2048 + col0; bf16_t* rb = Y + (size_t)(rowb + 2048 - k) * 2048 + col0;
#pragma unroll
            for (int bj = 0; bj < 2; ++bj) { const f32x4 e0 = acc[0][bj][m][0] * scale, e1 = acc[0][bj][m][1] * scale, o0 = acc[1][bj][m][0] * scale, o1 = acc[1][bj][m][1] * scale;
                const f32x4 a0 = e0 - o0, a1 = e1 - o1, b0 = e0 + o0, b1 = e1 + o1;
                u32x4 w; w.x = cvt_pk_bf16(a0[0], a0[1]); w.y = cvt_pk_bf16(a0[2], a0[3]); w.z = cvt_pk_bf16(a1[0], a1[1]); w.w = cvt_pk_bf16(a1[2], a1[3]);
                *(u32x4*)(ra + bj * HALF) = w;
                u32x4 v; v.x = cvt_pk_bf16(b0[0], b0[1]); v.y = cvt_pk_bf16(b0[2], b0[3]); v.z = cvt_pk_bf16(b1[0], b1[1]); v.w = cvt_pk_bf16(b1[2], b1[3]);
                if (k > 0) *(u32x4*)(rb + bj * HALF) = v; } }
    }
};
struct EpiFour1 {
    static constexpr bool PERM = true, AFTER_DRAIN = false; static constexpr int NSTORES = 16;
    bf16_t* TT; bf16_t* TTC;
    __device__ __forceinline__ void operator()(const f32x4 (&acc)[2][2][4][2], const Unit& u, int wr, int wc, int fr, int fq) const {
        const int g = u.pm; bf16_t* base; size_t chs, half;
        if (u.pn < 128) { const int b = u.pn >> 3, n0 = (u.pn & 7) * BM + wc * 32 + 8 * fq; base = TT + (size_t)(b * 512 + g * 128) * 4096 + n0; chs = 4096; half = 2048; }
        else { const int b = u.pn - 128, n0 = wc * 32 + 8 * fq; base = TTC + (size_t)(b * 512 + g * 128) * 512 + n0; chs = 512; half = 256; }
#pragma unroll
        for (int ai = 0; ai < 2; ++ai)
#pragma unroll
            for (int m = 0; m < 4; ++m) { bf16_t* rowp = base + (size_t)(wr * 64 + m * 16 + fr) * chs + ai * half;
#pragma unroll
                for (int bj = 0; bj < 2; ++bj) { const f32x4 v0 = acc[ai][bj][m][0], v1 = acc[ai][bj][m][1];
                    u32x4 w; w.x = cvt_pk_bf16(v0[0], v0[1]); w.y = cvt_pk_bf16(v0[2], v0[3]); w.z = cvt_pk_bf16(v1[0], v1[1]); w.w = cvt_pk_bf16(v1[2], v1[3]);
                    *(u32x4*)(rowp + bj * HALF) = w; } }
    }
};
template <class Epi, class Sched, bool ALIGN_EPI = false, bool SP2 = false, bool EO = false>
__device__ __forceinline__ void gemm_phase(PG8_LAS unsigned char* lds, const Gemm g, const Sched& S, const Epi& E) {
    int tid_ = threadIdx.x; asm volatile("" : "+v"(tid_));
    const int tid = tid_, wid = __builtin_amdgcn_readfirstlane(tid >> 6), lane = tid & 63, wr = wid >> 2, wc = wid & 3, fr = lane & 15, fq = lane >> 4;
    const int K = g.K, nt = K / BK;
    unsigned voffA[2], voffB[2];
#pragma unroll
    for (int i = 0; i < 2; ++i) { int R, C; stage_rc(tid * 16 + i * 8192, R, C); const int Rb = Epi::PERM ? ((R & ~31) + perm32(R & 31)) : R;
        voffA[i] = (unsigned)(R * g.lda + C) * 2u; voffB[i] = (unsigned)(Rb * g.ldb + C) * 2u; }
    const size_t kstep = (size_t)(BK * 2);
    const size_t hstepA = (size_t)HALF * g.lda * 2, hstepB = (size_t)HALF * g.ldb * 2;
    const size_t tstepA = 2 * hstepA, tstepB = 2 * hstepB;
    const unsigned ldsw = (unsigned)wid * 1024u;
    const int aoff = lds_byte(wr * 64 + fr, fq * 8), boff = lds_byte(wc * 32 + fr, fq * 8);
#define PG8_SA(b, h) (((b) * 2 + (h)) * HTB)
#define PG8_SB(b, h) ((4 + (b) * 2 + (h)) * HTB)
#define PG8_STAGE(bufoff, gbase, voff) do { _Pragma("unroll") for (int _i = 0; _i < 2; ++_i) \
        __builtin_amdgcn_global_load_lds((const unsigned*)((const char*)(gbase) + (voff)[_i]), (PG8_LAS unsigned*)(lds + (bufoff) + ldsw + _i * 8192), 16, 0, 0); } while (0)
#define PG8_LDA(dst, b, h) do { _Pragma("unroll") for (int m = 0; m < 4; ++m) _Pragma("unroll") for (int k = 0; k < 2; ++k) dst[m][k] = *(const PG8_LAS bf16x8*)(lds + PG8_SA(b, h) + aoff + m * 2048 + k * 1024); } while (0)
#define PG8_LDB(dst, b, h) do { _Pragma("unroll") for (int n = 0; n < 2; ++n) _Pragma("unroll") for (int k = 0; k < 2; ++k) dst[n][k] = *(const PG8_LAS bf16x8*)(lds + PG8_SB(b, h) + boff + n * 2048 + k * 1024); } while (0)
#define PG8_MMA(ai, bj, At, Bt) do { __builtin_amdgcn_s_setprio(1); _Pragma("unroll") for (int m = 0; m < 4; ++m) _Pragma("unroll") for (int n = 0; n < 2; ++n) _Pragma("unroll") for (int k = 0; k < 2; ++k) \
        acc[ai][bj][m][n] = __builtin_amdgcn_mfma_f32_16x16x32_bf16(Bt[n][k], At[m][k], acc[ai][bj][m][n], 0, 0, 0); __builtin_amdgcn_s_setprio(0); } while (0)
#define PG8_WAIT_V(n) asm volatile("s_waitcnt vmcnt(" #n ")" ::: "memory")
#define PG8_WAIT_L(n) asm volatile("s_waitcnt lgkmcnt(" #n ")" ::: "memory")
#define PG8_BAR __builtin_amdgcn_s_barrier()
#define PG8_SCHED __builtin_amdgcn_sched_barrier(0)
    Unit cur, nxt; int ui = 0;
    if (!S.next(0, cur)) return;
    f32x4 acc[2][2][4][2];
#pragma unroll
    for (int a = 0; a < 2; ++a)
#pragma unroll
        for (int b = 0; b < 2; ++b)
#pragma unroll
            for (int m = 0; m < 4; ++m)
#pragma unroll
                for (int n = 0; n < 2; ++n) acc[a][b][m][n] = (f32x4){0.f, 0.f, 0.f, 0.f};
    bf16x8 At[4][2], B0[2][2], B1[2][2];
    const char* cA = (const char*)g.A + (size_t)cur.pm * tstepA; const char* cB = (const char*)g.Bt + (size_t)cur.pn * tstepB + (size_t)cur.bo * 2;
    S.a_ready(cur);
    if constexpr (SP2) {
        PG8_STAGE(PG8_SB(0, 0), cB, voffB); PG8_STAGE(PG8_SB(0, 1), cB + hstepB, voffB); PG8_STAGE(PG8_SA(0, 0), cA, voffA); PG8_STAGE(PG8_SA(0, 1), cA + hstepA, voffA);
        if (wr == 1) PG8_BAR;
        PG8_WAIT_V(2); PG8_BAR;
        PG8_STAGE(PG8_SB(1, 0), cB + kstep, voffB); PG8_STAGE(PG8_SA(1, 0), cA + kstep, voffA); PG8_STAGE(PG8_SB(1, 1), cB + hstepB + kstep, voffB);
        PG8_WAIT_V(6); PG8_BAR;
    } else {
        PG8_STAGE(PG8_SB(0, 0), cB, voffB); PG8_STAGE(PG8_SA(0, 0), cA, voffA); PG8_STAGE(PG8_SB(0, 1), cB + hstepB, voffB); PG8_STAGE(PG8_SA(0, 1), cA + hstepA, voffA);
        if (wr == 1) PG8_BAR;
        PG8_WAIT_V(4); PG8_BAR;
        PG8_STAGE(PG8_SB(1, 0), cB + kstep, voffB); PG8_STAGE(PG8_SA(1, 0), cA + kstep, voffA); PG8_STAGE(PG8_SB(1, 1), cB + hstepB + kstep, voffB);
        PG8_WAIT_V(6); PG8_BAR;
    }
    for (;;) {
        const bool has_next = S.next(ui + 1, nxt);
        const char* nA = has_next ? (const char*)g.A + (size_t)nxt.pm * tstepA : cA; const char* nB = has_next ? (const char*)g.Bt + (size_t)nxt.pn * tstepB + (size_t)nxt.bo * 2 : cB;
        for (int t = 0; t < nt; t += 2) {
            const bool last = (t == nt - 2);
            const char* a1 = cA + (size_t)(t + 1) * kstep;
            const char* a2 = last ? nA : cA + (size_t)(t + 2) * kstep; const char* b2 = last ? nB : cB + (size_t)(t + 2) * kstep;
            const char* a3 = a2 + kstep; const char* b3 = b2 + kstep;
            if (last && has_next) S.a_ready(nxt);
            const bool eo1 = 2 * t < nt;
            if constexpr (SP2) {
#define PG8_WAIT_K() do { if constexpr (EO) { if (t == nt / 2 - 2) PG8_WAIT_V(4); else PG8_WAIT_V(6); } else PG8_WAIT_V(8); } while (0)
            const bool eo2 = last || (2 * (t + 2) < nt);
            PG8_LDB(B0, 0, 0); PG8_LDB(B1, 0, 1); PG8_SCHED; if (!EO || eo1) PG8_LDA(At, 0, 0); if (!EO || !eo1) PG8_STAGE(PG8_SA(1, 1), a1 + hstepA, voffA);
            PG8_WAIT_K(); PG8_WAIT_L(0); PG8_BAR; if (!EO || eo1) { PG8_MMA(0, 0, At, B0); PG8_MMA(0, 1, At, B1); } PG8_BAR; PG8_SCHED;
            if (!EO || !eo1) PG8_LDA(At, 0, 1); PG8_STAGE(PG8_SB(0, 0), b2, voffB); PG8_STAGE(PG8_SB(0, 1), b2 + hstepB, voffB); if (!EO || eo2) PG8_STAGE(PG8_SA(0, 0), a2, voffA);
            PG8_WAIT_K(); PG8_WAIT_L(0); PG8_BAR; if (!EO || !eo1) { PG8_MMA(1, 0, At, B0); PG8_MMA(1, 1, At, B1); } PG8_BAR; PG8_SCHED;
            PG8_LDB(B0, 1, 0); PG8_LDB(B1, 1, 1); PG8_SCHED; if (!EO || eo1) PG8_LDA(At, 1, 0); if (!EO || !eo2) PG8_STAGE(PG8_SA(0, 1), a2 + hstepA, voffA);
            PG8_WAIT_K(); PG8_WAIT_L(0); PG8_BAR; if (!EO || eo1) { PG8_MMA(0, 0, At, B0); PG8_MMA(0, 1, At, B1); } PG8_BAR; PG8_SCHED;
            if (!EO || !eo1) PG8_LDA(At, 1, 1); PG8_STAGE(PG8_SB(1, 0), b3, voffB); PG8_STAGE(PG8_SB(1, 1), b3 + hstepB, voffB); if (!EO || eo2) PG8_STAGE(PG8_SA(1, 0), a3, voffA);
            PG8_WAIT_K(); PG8_WAIT_L(0); PG8_BAR; if (!EO || !eo1) { PG8_MMA(1, 0, At, B0); PG8_MMA(1, 1, At, B1); } PG8_BAR; PG8_SCHED;
#undef PG8_WAIT_K
            } else {
            PG8_LDB(B0, 0, 0); PG8_SCHED; PG8_LDA(At, 0, 0); PG8_STAGE(PG8_SA(1, 1), a1 + hstepA, voffA);
            PG8_WAIT_L(8); PG8_BAR; PG8_WAIT_L(0); PG8_MMA(0, 0, At, B0); PG8_BAR; PG8_SCHED;
            PG8_LDB(B1, 0, 1); PG8_STAGE(PG8_SB(0, 0), b2, voffB);
            PG8_BAR; PG8_WAIT_L(0); PG8_MMA(0, 1, At, B1); PG8_BAR;
            PG8_LDA(At, 0, 1); PG8_STAGE(PG8_SA(0, 0), a2, voffA);
            PG8_BAR; PG8_WAIT_L(0); PG8_MMA(1, 0, At, B0); PG8_BAR; PG8_SCHED;
            PG8_STAGE(PG8_SB(0, 1), b2 + hstepB, voffB);
            PG8_WAIT_V(6); PG8_BAR; PG8_MMA(1, 1, At, B1); PG8_BAR;
            PG8_LDB(B0, 1, 0); PG8_SCHED; PG8_LDA(At, 1, 0); PG8_STAGE(PG8_SA(0, 1), a2 + hstepA, voffA);
            PG8_WAIT_L(8); PG8_BAR; PG8_WAIT_L(0); PG8_MMA(0, 0, At, B0); PG8_BAR; PG8_SCHED;
            PG8_LDB(B1, 1, 1); PG8_STAGE(PG8_SB(1, 0), b3, voffB);
            PG8_BAR; PG8_WAIT_L(0); PG8_MMA(0, 1, At, B1); PG8_BAR;
            PG8_LDA(At, 1, 1); PG8_STAGE(PG8_SA(1, 0), a3, voffA);
            PG8_BAR; PG8_WAIT_L(0); PG8_MMA(1, 0, At, B0); PG8_BAR; PG8_SCHED;
            PG8_STAGE(PG8_SB(1, 1), b3 + hstepB, voffB);
            PG8_WAIT_V(6); PG8_BAR; PG8_MMA(1, 1, At, B1); PG8_BAR;
            }
        }
        if constexpr (ALIGN_EPI) { if (wr == 0) PG8_BAR; }
        if constexpr (!Epi::AFTER_DRAIN) { E(acc, cur, wr, wc, fr, fq); S.done(cur); }
        if (!has_next) break;
#pragma unroll
        for (int a = 0; a < 2; ++a)
#pragma unroll
            for (int b = 0; b < 2; ++b)
#pragma unroll
                for (int m = 0; m < 4; ++m)
#pragma unroll
                    for (int n = 0; n < 2; ++n) acc[a][b][m][n] = (f32x4){0.f, 0.f, 0.f, 0.f};
        cur = nxt; cA = nA; cB = nB; ++ui;
        if constexpr (ALIGN_EPI) { if (wr == 1) PG8_BAR; }
    }
    PG8_WAIT_V(0);
    if constexpr (!ALIGN_EPI) { if (wr == 0) PG8_BAR; }
    PG8_BAR;
    if constexpr (Epi::AFTER_DRAIN) { E.fused(acc, cur, wr, wc, fr, fq, lds, wid, lane); S.done(cur); }
#undef PG8_SA
#undef PG8_SB
#undef PG8_STAGE
#undef PG8_LDA
#undef PG8_LDB
#undef PG8_MMA
#undef PG8_WAIT_V
#undef PG8_WAIT_L
#undef PG8_BAR
#undef PG8_SCHED
}
}
#define GAS __attribute__((address_space(1)))
#define LAS __attribute__((address_space(3)))
typedef unsigned short bf16_t;
typedef unsigned u32x4 __attribute__((ext_vector_type(4)));
typedef unsigned u32x2 __attribute__((ext_vector_type(2)));
typedef float f32x4 __attribute__((ext_vector_type(4)));
typedef float f32x2 __attribute__((ext_vector_type(2)));

constexpr int D = 2048, NBATCH = 16, SEQ = 2048, DEPTH = 4, CTXL = 256;
constexpr int ML = NBATCH * SEQ, MC = NBATCH * CTXL, MT = ML + MC;
constexpr int NPROJ = 3840, DFF = 5632, NGU = 2 * DFF, MODW = 6 * D;
constexpr int OFF_Z = 0  , OFF_AX = 0, OFF_AB = 512, OFF_AC = 1024, OFF_F = 1536, OFF_Q = 2048, OFF_K = 2560, OFF_V = 2688, OFF_U = 2816, OFF_MV = 3328;
constexpr float EPS = 1e-6f;
constexpr int NWAVES = 8, NTHREADS = 512;

constexpr size_t al256(size_t x) { return (x + 255) & ~(size_t)255; }
constexpr size_t WS_CTL = 0, CTL_ZERO_BYTES = 1u << 20;
constexpr size_t WS_WIN = CTL_ZERO_BYTES;
constexpr size_t WS_WOUT = WS_WIN + (size_t)DEPTH * NPROJ * D * 2;
constexpr size_t WS_WGU = WS_WOUT + (size_t)DEPTH * D * D * 2;
constexpr size_t WS_WDN = WS_WGU + (size_t)DEPTH * NGU * D * 2;
constexpr size_t WS_MOD = WS_WDN + (size_t)DEPTH * D * DFF * 2;
constexpr size_t WS_MODP = al256(WS_MOD + (size_t)DEPTH * 17 * MODW * 4);
constexpr size_t WS_XS = al256(WS_MODP + (size_t)DEPTH * 8 * 17 * MODW * 4);
constexpr size_t WS_H = WS_XS + (size_t)MT * D * 2;
constexpr size_t WS_P = WS_H + (size_t)MT * D * 2;
constexpr size_t WS_Y = WS_P + (size_t)MT * NPROJ * 2;
constexpr size_t WS_HF = WS_P;
constexpr size_t WS_TT = WS_Y + (size_t)MT * D * 2;
static_assert(WS_HF + (size_t)MT * DFF * 2 <= WS_TT, "hf overlay");
constexpr size_t WS_TTC = WS_TT + (size_t)NBATCH * 512 * 4096 * 2;
constexpr size_t WS_DFTN = WS_TTC + (size_t)NBATCH * 512 * 512 * 2;
constexpr size_t WS_DFTC = WS_DFTN + (size_t)2048 * 4096 * 2;
constexpr size_t WS_ROPE = WS_DFTC + (size_t)256 * 512 * 2;
constexpr size_t WS_CSBD = WS_ROPE + (size_t)2048 * 32 * 8;
constexpr size_t WS_DL = WS_CSBD + (size_t)1024 * 512 * 2;
constexpr size_t WS_WSB = WS_DL + (size_t)MT * D * 2;
constexpr size_t WS_END = WS_WSB + (size_t)DEPTH * 4 * 128 * 128 * 2;
constexpr int CW_BAR = 4096;

constexpr int LDS_BYTES = 147456;
constexpr int ROPE_LDS_OFF = 131072;
constexpr int LDSCTL_OFF = 146432, MISC_OFF = LDSCTL_OFF;

#define LDS_WAIT() asm volatile("s_waitcnt lgkmcnt(0)" ::: "memory")
__device__ __forceinline__ float bf2f(unsigned b) { return __uint_as_float(b << 16); }
__device__ __forceinline__ unsigned f2bf(float f) { unsigned u = __float_as_uint(f); return (u + 0x7fffu + ((u >> 16) & 1u)) >> 16; }
typedef __bf16 bf16x2_hw __attribute__((ext_vector_type(2)));
__device__ __forceinline__ unsigned pk2(float lo, float hi) { const f32x2 v = {lo, hi}; const bf16x2_hw b = __builtin_convertvector(v, bf16x2_hw); return __builtin_bit_cast(unsigned, b); }
__device__ __forceinline__ void unpack8(const u32x4 w, float* o) {
    o[0] = __uint_as_float(w.x << 16); o[1] = __uint_as_float(w.x & 0xffff0000u); o[2] = __uint_as_float(w.y << 16); o[3] = __uint_as_float(w.y & 0xffff0000u);
    o[4] = __uint_as_float(w.z << 16); o[5] = __uint_as_float(w.z & 0xffff0000u); o[6] = __uint_as_float(w.w << 16); o[7] = __uint_as_float(w.w & 0xffff0000u);
}
__device__ __forceinline__ float wave_sum(float v) {
#pragma unroll
    for (int o = 1; o < 64; o <<= 1) v += __shfl_xor(v, o);
    return v;
}
__device__ __forceinline__ float gelu_tanh(float x) {
    const float u = 0.7978845608028654f * (x + 0.044715f * x * x * x);
    const float e = __expf(2.0f * u);
    const float t = 1.0f - 2.0f * __builtin_amdgcn_rcpf(1.0f + e);
    return 0.5f * x * (1.0f + t);
}
#define XB_TMO      128
#define XB_XCNT(j)  (256  + 64 * (j))
#define XB_XSUB(j)  (1280 + 64 * (j))
#define XB_XGEN(j)  (2304 + 64 * (j))
#define XB_TOP      3328
#define XB_TOPGEN   3392
#define XCD_BAR_WORDS 3456
#define XB_SPIN_CAP (1u << 18)

__device__ __forceinline__ unsigned xb_ld(unsigned* p)              { return __hip_atomic_load(p, __ATOMIC_RELAXED, __HIP_MEMORY_SCOPE_AGENT); }
__device__ __forceinline__ unsigned xb_add(unsigned* p, unsigned v) { return __hip_atomic_fetch_add(p, v, __ATOMIC_RELAXED, __HIP_MEMORY_SCOPE_AGENT); }
__device__ __forceinline__ unsigned xb_xcc_id() { return (unsigned)__builtin_amdgcn_s_getreg((3 << 11) | 20) & 0xFu; }
#define XB_SPIN(cond, bar) do { unsigned _sp = 0; while (cond) { __builtin_amdgcn_s_sleep(1); \
    if ((++_sp & 255u) == 0u) { if (xb_ld(&(bar)[XB_TMO])) break; if (_sp > XB_SPIN_CAP) { atomicAdd(&(bar)[XB_TMO], 1u); break; } } } } while (0)

struct XcdBarrier {
    unsigned* bar; unsigned x;
    volatile LAS unsigned* st;
};

__device__ __forceinline__ XcdBarrier xcd_barrier_post(unsigned* bar, volatile LAS unsigned* st) {
    XcdBarrier b; b.bar = bar; b.x = xb_xcc_id(); b.st = st;
    if (threadIdx.x == 0) (void)xb_add(&bar[XB_XCNT(b.x)], 1u);
    return b;
}
__device__ __forceinline__ void xcd_barrier_complete(unsigned* bar, unsigned x, unsigned& nloc, unsigned& nx) {
    const unsigned G = gridDim.x * gridDim.y * gridDim.z;
    unsigned sum, cnt, mine, sp = 0u;
    for (;;) {
        sum = 0u; cnt = 0u; mine = 0u;
#pragma unroll
        for (unsigned j = 0; j < 16; ++j) { const unsigned c = xb_ld(&bar[XB_XCNT(j)]); sum += c; cnt += (c > 0u) ? 1u : 0u; mine = (j == x) ? c : mine; }
        if (sum == G) break;
        __builtin_amdgcn_s_sleep(1);
        if ((++sp & 255u) == 0u) { if (xb_ld(&bar[XB_TMO])) break; if (sp > XB_SPIN_CAP) { atomicAdd(&bar[XB_TMO], 1u); break; } }
    }
    nloc = mine > 0u ? mine : 1u; nx = cnt > 0u ? cnt : 1u;
}

__device__ __forceinline__ void xcd_barrier(const XcdBarrier& b) {
    asm volatile("s_waitcnt vmcnt(0)" ::: "memory");
    __syncthreads();
    if (threadIdx.x == 0) {
        unsigned* bar = b.bar;
        __builtin_amdgcn_s_waitcnt(0);
        unsigned nloc = b.st[0], nx = b.st[1];
        if (nloc == 0u) { xcd_barrier_complete(bar, b.x, nloc, nx); b.st[0] = nloc; b.st[1] = nx; }
        const unsigned old = xb_add(&bar[XB_XSUB(b.x)], 1u);
        const unsigned gen = old / nloc;
        if (old + 1u == (gen + 1u) * nloc) {
            __builtin_amdgcn_fence(__ATOMIC_RELEASE, "agent");
            asm volatile("s_waitcnt vmcnt(0)" ::: "memory");
            const unsigned og = xb_add(&bar[XB_TOP], 1u);
            const unsigned tg = og / nx;
            if (og + 1u == (tg + 1u) * nx) xb_add(&bar[XB_TOPGEN], 1u);
            else XB_SPIN(xb_ld(&bar[XB_TOPGEN]) == tg, bar);
            __builtin_amdgcn_fence(__ATOMIC_ACQUIRE, "agent");
            xb_add(&bar[XB_XGEN(b.x)], 1u);
            asm volatile("s_waitcnt vmcnt(0)" ::: "memory");
        } else {
            XB_SPIN(xb_ld(&bar[XB_XGEN(b.x)]) == gen, bar);
            __builtin_amdgcn_fence(__ATOMIC_ACQUIRE, "agent");
            asm volatile("s_waitcnt vmcnt(0)" ::: "memory");
        }
    }
    __syncthreads();
}
__device__ __forceinline__ void tr_item(const float* __restrict__ W, int K, int N, bf16_t* __restrict__ WT, int k0, int n0, int drow0, LAS float* scr, int lane) {
    { const int kr = lane >> 3, c4 = (lane & 7) * 4;
      f32x4 v[8];
#pragma unroll
      for (int i = 0; i < 8; ++i) v[i] = __builtin_nontemporal_load((const f32x4*)(W + (size_t)(k0 + 8 * i + kr) * N + n0 + c4));
#pragma unroll
      for (int i = 0; i < 8; ++i) { LAS float* d = scr + (8 * i + kr) * 33 + c4; d[0] = v[i].x; d[1] = v[i].y; d[2] = v[i].z; d[3] = v[i].w; } }
    LDS_WAIT(); asm volatile("" ::: "memory");
    const int c = lane & 7;
#pragma unroll
    for (int j = 0; j < 4; ++j) { const int n = (lane >> 3) + 8 * j; const LAS float* s = scr + (8 * c) * 33 + n;
        u32x4 o; o.x = pk2(s[0 * 33], s[1 * 33]); o.y = pk2(s[2 * 33], s[3 * 33]); o.z = pk2(s[4 * 33], s[5 * 33]); o.w = pk2(s[6 * 33], s[7 * 33]);
        *(u32x4*)(WT + (size_t)(drow0 + n) * K + k0 + 8 * c) = o; }
    LDS_WAIT(); asm volatile("" ::: "memory");
}
__device__ __forceinline__ int win_drow(int n0) {
    if (n0 < 512) return (n0 >> 7) * 256 + (n0 & 127);
    if (n0 < 1024) return 1024 + (n0 - 512);
    if (n0 < 1536) { const int c = n0 - 1024; return (c >> 7) * 256 + 128 + (c & 127); }
    return n0;
}
constexpr int TR_IN = 32 * 120, TR_OUT = 32 * 64, TR_G = 32 * 176, TR_DN = 88 * 64, TR_P0L = TR_IN + TR_OUT;
__device__ __forceinline__ void p0_transposes(const float* w_in, const float* w_out, bf16_t* WIN, bf16_t* WOUT, LAS float* scr, int gw, int NGW, int lane) {
    for (int it = gw; it < TR_IN + TR_OUT; it += NGW) {
        int r = it;
        if (r < TR_IN) { const int kb = r / 120, nb = r % 120; tr_item(w_in, D, NPROJ, WIN, kb * 64, nb * 32, win_drow(nb * 32), scr, lane); continue; } r -= TR_IN;
        { const int kb = r / 64, nb = r % 64; tr_item(w_out, D, D, WOUT, kb * 64, nb * 32, nb * 32, scr, lane); }
    }
}
__device__ __forceinline__ void tr_wout123(const float* w_out, bf16_t* WOUT, LAS float* scr, int sw, int nsw, int lane) {
    for (int it = sw; it < 3 * TR_OUT; it += nsw) { const int l = 1 + it / TR_OUT, q = it % TR_OUT, kb = q / 64, nb = q % 64;
        tr_item(w_out + (size_t)l * D * D, D, D, WOUT + (size_t)l * D * D, kb * 64, nb * 32, nb * 32, scr, lane); }
}
__device__ __forceinline__ void tr_load(const float* __restrict__ W, int N, int k0, int n0, int lane, f32x4 (&v)[8]) {
    const int kr = lane >> 3, c4 = (lane & 7) * 4;
#pragma unroll
    for (int i = 0; i < 8; ++i) v[i] = __builtin_nontemporal_load((const f32x4*)(W + (size_t)(k0 + 8 * i + kr) * N + n0 + c4));
}
__device__ __forceinline__ void tr_emit(const f32x4 (&v)[8], int K, bf16_t* __restrict__ WT, int k0, int drow0, LAS float* scr, int lane) {
    { const int kr = lane >> 3, c4 = (lane & 7) * 4;
#pragma unroll
      for (int i = 0; i < 8; ++i) { LAS float* d = scr + (8 * i + kr) * 33 + c4; d[0] = v[i].x; d[1] = v[i].y; d[2] = v[i].z; d[3] = v[i].w; } }
    LDS_WAIT(); asm volatile("" ::: "memory");
    const int c = lane & 7;
#pragma unroll
    for (int j = 0; j < 4; ++j) { const int n = (lane >> 3) + 8 * j; const LAS float* sp = scr + (8 * c) * 33 + n;
        u32x4 o; o.x = pk2(sp[0 * 33], sp[1 * 33]); o.y = pk2(sp[2 * 33], sp[3 * 33]); o.z = pk2(sp[4 * 33], sp[5 * 33]); o.w = pk2(sp[6 * 33], sp[7 * 33]);
        *(u32x4*)(WT + (size_t)(drow0 + n) * K + k0 + 8 * c) = o; }
    LDS_WAIT(); asm volatile("" ::: "memory");
}
__device__ __forceinline__ void tr_gateup(const float* w_gate_l, const float* w_up_l, bf16_t* WGU_l, LAS float* scr, int sw, int nsw, int lane) {
    f32x4 v[8], vn[8]; int it = sw;
    if (it < 2 * TR_G) { const int up = it >= TR_G, r = up ? it - TR_G : it; tr_load(up ? w_up_l : w_gate_l, DFF, (r / 176) * 64, (r % 176) * 32, lane, v); }
    for (; it < 2 * TR_G; it += nsw) {
        const int nx = it + nsw;
        if (nx < 2 * TR_G) { const int up = nx >= TR_G, r = up ? nx - TR_G : nx; tr_load(up ? w_up_l : w_gate_l, DFF, (r / 176) * 64, (r % 176) * 32, lane, vn); }
        const int up = it >= TR_G, r = up ? it - TR_G : it, kb = r / 176, n0 = (r % 176) * 32;
        tr_emit(v, D, WGU_l, kb * 64, (n0 >> 7) * 256 + (up ? 128 : 0) + (n0 & 127), scr, lane);
#pragma unroll
        for (int i = 0; i < 8; ++i) v[i] = vn[i];
    }
}
__device__ __forceinline__ void tr_win(const float* w_in_l, bf16_t* WIN_l, LAS float* scr, int sw, int nsw, int lane) {
    f32x4 v[8], vn[8]; int it = sw;
    if (it < TR_IN) tr_load(w_in_l, NPROJ, (it / 120) * 64, (it % 120) * 32, lane, v);
    for (; it < TR_IN; it += nsw) {
        const int nx = it + nsw;
        if (nx < TR_IN) tr_load(w_in_l, NPROJ, (nx / 120) * 64, (nx % 120) * 32, lane, vn);
        tr_emit(v, D, WIN_l, (it / 120) * 64, win_drow((it % 120) * 32), scr, lane);
#pragma unroll
        for (int i = 0; i < 8; ++i) v[i] = vn[i];
    }
}
__device__ __forceinline__ void tr_down(const float* w_down_l, bf16_t* WDN_l, LAS float* scr, int sw, int nsw, int lane) {
    f32x4 v[8], vn[8]; int it = sw;
    if (it < TR_DN) tr_load(w_down_l, D, (it / 64) * 64, (it % 64) * 32, lane, v);
    for (; it < TR_DN; it += nsw) {
        const int nx = it + nsw;
        if (nx < TR_DN) tr_load(w_down_l, D, (nx / 64) * 64, (nx % 64) * 32, lane, vn);
        tr_emit(v, DFF, WDN_l, (it / 64) * 64, (it % 64) * 32, scr, lane);
#pragma unroll
        for (int i = 0; i < 8; ++i) v[i] = vn[i];
    }
}
__device__ __forceinline__ void p0_modp(const float* __restrict__ c, const float* __restrict__ c_ctx, const float* __restrict__ w_ada, float* __restrict__ modp, LAS float* scr  , int gw, int NGW, int lane) {
    for (int it = gw; it < DEPTH * 48 * 8; it += NGW) {
        const int l = it / 384, rem = it % 384, cc = rem >> 3, ks = rem & 7, k0 = ks * 256;
#pragma unroll
        for (int r = 0; r < 17; ++r)
#pragma unroll
            for (int j = 0; j < 4; ++j) { const int idx = j * 64 + lane; const float v = (r < 16) ? c[r * D + k0 + idx] : c_ctx[k0 + idx]; scr[r * 256 + idx] = v * (1.0f / (1.0f + __expf(-v))); }
        LDS_WAIT(); asm volatile("" ::: "memory");
        f32x4 acc[17];
#pragma unroll
        for (int r = 0; r < 17; ++r) acc[r] = (f32x4){0.f, 0.f, 0.f, 0.f};
        const float* wp = w_ada + ((size_t)l * D + k0) * MODW + cc * 256 + lane * 4;
#pragma unroll 2
        for (int k4 = 0; k4 < 64; ++k4) {
            const f32x4 w0 = *(const f32x4*)(wp + (size_t)(4 * k4 + 0) * MODW), w1 = *(const f32x4*)(wp + (size_t)(4 * k4 + 1) * MODW);
            const f32x4 w2 = *(const f32x4*)(wp + (size_t)(4 * k4 + 2) * MODW), w3 = *(const f32x4*)(wp + (size_t)(4 * k4 + 3) * MODW);
#pragma unroll
            for (int r = 0; r < 17; ++r) { const f32x4 s = *(const LAS f32x4*)(scr + r * 256 + 4 * k4); acc[r] = acc[r] + w0 * s.x + w1 * s.y + w2 * s.z + w3 * s.w; }
        }
#pragma unroll
        for (int r = 0; r < 17; ++r) *(f32x4*)(modp + ((size_t)((l * 8 + ks) * 17 + r)) * MODW + cc * 256 + lane * 4) = acc[r];
        LDS_WAIT(); asm volatile("" ::: "memory");
    }
}
__device__ __forceinline__ void p0_tables(bf16_t* DFTN, bf16_t* DFTC, bf16_t* CSBD, f32x2* ROPE, size_t gtid, size_t NT) {
    for (size_t i = gtid; i < (size_t)1024 * 128 / 8; i += NT) {
        const int r = (int)(i >> 4), c0 = (int)(i & 15) * 8, t = (r >> 7) & 1, m = r & 127; float v[8];
#pragma unroll
        for (int e = 0; e < 8; ++e) { const int j = (m * (c0 + e)) & 127; const float x = (float)j * (1.0f / 64.0f); v[e] = t == 0 ? cospif(x) : sinpif(x); }
        u32x4 o; o.x = pk2(v[0], v[1]); o.y = pk2(v[2], v[3]); o.z = pk2(v[4], v[5]); o.w = pk2(v[6], v[7]);
        *(u32x4*)(CSBD + i * 8) = o;
    }
    for (size_t i = gtid; i < (size_t)2048 * 4096 / 8; i += NT) {
        const int rho = (int)(i >> 9), n0 = (int)(i & 511) * 8, h = (rho >> 7) & 1, k = (rho >> 8) * 128 + (rho & 127); float v[8];
#pragma unroll
        for (int e = 0; e < 8; ++e) { const int np = n0 + e, n = np & 2047, j = (k * n) & 2047; const float x = (float)j * (1.0f / 1024.0f); v[e] = (np < 2048) ? (h == 0 ? cospif(x) : 0.f) : (h == 1 ? sinpif(x) : 0.f); }
        u32x4 o; o.x = pk2(v[0], v[1]); o.y = pk2(v[2], v[3]); o.z = pk2(v[4], v[5]); o.w = pk2(v[6], v[7]);
        *(u32x4*)(DFTN + i * 8) = o;
    }
    for (size_t i = gtid; i < (size_t)256 * 512 / 8; i += NT) {
        const int k = (int)(i >> 6), n0 = (int)(i & 63) * 8; float v[8];
#pragma unroll
        for (int e = 0; e < 8; ++e) { const int np = n0 + e, n = np & 255, j = (k * n) & 255; const float x = (float)j * (1.0f / 128.0f); v[e] = np < 256 ? cospif(x) : -sinpif(x); }
        u32x4 o; o.x = pk2(v[0], v[1]); o.y = pk2(v[2], v[3]); o.z = pk2(v[4], v[5]); o.w = pk2(v[6], v[7]);
        *(u32x4*)(DFTC + i * 8) = o;
    }
    for (size_t i = gtid; i < (size_t)96 * 16; i += NT) {
        const int c = (int)(i >> 4), fi = (int)(i & 15), coord = c < 32 ? c : c - 32;
        const float inv = exp2f(-(float)fi * (13.287712379549449f / 16.0f));
        const float xr = ((float)coord * inv) * 0.3183098861837907f;
        ROPE[i] = (f32x2){cospif(xr), sinpif(xr)};
    }
}
__device__ __forceinline__ void p1_wsb(const float* __restrict__ w_s, bf16_t* __restrict__ WSB, size_t gtid, size_t NT) {
    for (size_t i = gtid; i < (size_t)DEPTH * 4 * 128 * 128 / 8; i += NT) { const f32x4 a = ((const f32x4*)w_s)[2 * i], b = ((const f32x4*)w_s)[2 * i + 1];
        u32x4 w; w.x = pk2(a.x, a.y); w.y = pk2(a.z, a.w); w.z = pk2(b.x, b.y); w.w = pk2(b.z, b.w); ((u32x4*)WSB)[i] = w; }
}
__device__ __forceinline__ void p1_mod(const float* __restrict__ modp, const float* __restrict__ b_ada, float* __restrict__ mod, size_t gtid, size_t NT) {
    for (size_t i = gtid; i < (size_t)DEPTH * 17 * MODW; i += NT) {
        const int l = (int)(i / (17 * MODW)), rn = (int)(i % (17 * MODW)), n = rn % MODW;
        float s = b_ada[l * MODW + n];
#pragma unroll
        for (int ks = 0; ks < 8; ++ks) s += modp[(size_t)(l * 8 + ks) * 17 * MODW + rn];
        mod[i] = s;
    }
}
__device__ __forceinline__ void unpack8v(const u32x4 w, f32x4& lo, f32x4& hi) {
    lo = (f32x4){__uint_as_float(w.x << 16), __uint_as_float(w.x & 0xffff0000u), __uint_as_float(w.y << 16), __uint_as_float(w.y & 0xffff0000u)};
    hi = (f32x4){__uint_as_float(w.z << 16), __uint_as_float(w.z & 0xffff0000u), __uint_as_float(w.w << 16), __uint_as_float(w.w & 0xffff0000u)};
}
__device__ __forceinline__ u32x4 pack8v(const f32x4 lo, const f32x4 hi) { u32x4 w; w.x = pk2(lo.x, lo.y); w.y = pk2(lo.z, lo.w); w.z = pk2(hi.x, hi.y); w.w = pk2(hi.z, hi.w); return w; }
template <bool XF32, bool HAS_DELTA, bool WRITE_X>
__device__ __forceinline__ void resnorm_rows(const void* __restrict__ xlat, const void* __restrict__ xctx, const bf16_t* __restrict__ DL, bf16_t* __restrict__ xout, const float* __restrict__ gvec,
                                             const float* __restrict__ modl, int shoff, int scoff, bf16_t* __restrict__ H, int r0, int r1, int lane) {
    int bcur = -1; f32x4 gm[8], sh[8];
    for (int row = r0; row < r1; ) {
        const int b = row < ML ? (row >> 11) : 16, bn = (row + 1) < ML ? ((row + 1) >> 11) : 16;
        const bool two = (row + 1 < r1) && (bn == b) && ((row + 1 == ML) == false);
        if (b != bcur) { bcur = b; const float* mrow = modl + (size_t)b * MODW;
#pragma unroll
            for (int j = 0; j < 8; ++j) { const int col = 8 * lane + 512 * (j >> 1) + 4 * (j & 1); gm[j] = *(const f32x4*)(gvec + col) * (*(const f32x4*)(mrow + scoff + col) + 1.0f); sh[j] = *(const f32x4*)(mrow + shoff + col); } }
        const size_t roff = (row < ML) ? (size_t)row * D : (size_t)(row - ML) * D;
        f32x4 va[8], vb[8];
        if (XF32) { const float* xa = (const float*)(row < ML ? xlat : xctx) + roff + 8 * lane; const float* xb = two ? xa + D : xa;
#pragma unroll
            for (int j = 0; j < 8; ++j) { const int o = 512 * (j >> 1) + 4 * (j & 1); va[j] = __builtin_nontemporal_load((const f32x4*)(xa + o)); vb[j] = __builtin_nontemporal_load((const f32x4*)(xb + o)); } }
        else { const bf16_t* xa = (const bf16_t*)(row < ML ? xlat : xctx) + roff + 8 * lane; const bf16_t* xb = two ? xa + D : xa; u32x4 wa[4], wb[4];
#pragma unroll
            for (int j = 0; j < 4; ++j) { wa[j] = __builtin_nontemporal_load((const u32x4*)(xa + 512 * j)); wb[j] = __builtin_nontemporal_load((const u32x4*)(xb + 512 * j)); }
#pragma unroll
            for (int j = 0; j < 4; ++j) { unpack8v(wa[j], va[2 * j], va[2 * j + 1]); unpack8v(wb[j], vb[2 * j], vb[2 * j + 1]); } }
        if (HAS_DELTA) { const bf16_t* da = DL + (size_t)row * D + 8 * lane; const bf16_t* db = two ? da + D : da; u32x4 wa[4], wb[4];
#pragma unroll
            for (int j = 0; j < 4; ++j) { wa[j] = __builtin_nontemporal_load((const u32x4*)(da + 512 * j)); wb[j] = __builtin_nontemporal_load((const u32x4*)(db + 512 * j)); }
#pragma unroll
            for (int j = 0; j < 4; ++j) { f32x4 l0, h0, l1, h1; unpack8v(wa[j], l0, h0); unpack8v(wb[j], l1, h1);
                va[2 * j] = va[2 * j] + l0; va[2 * j + 1] = va[2 * j + 1] + h0; vb[2 * j] = vb[2 * j] + l1; vb[2 * j + 1] = vb[2 * j + 1] + h1; } }
        float sa = 0.f, sb = 0.f;
#pragma unroll
        for (int j = 0; j < 8; ++j) { sa += (va[j].x * va[j].x + va[j].y * va[j].y) + (va[j].z * va[j].z + va[j].w * va[j].w); sb += (vb[j].x * vb[j].x + vb[j].y * vb[j].y) + (vb[j].z * vb[j].z + vb[j].w * vb[j].w); }
#pragma unroll
        for (int o = 1; o < 64; o <<= 1) { sa += __shfl_xor(sa, o); sb += __shfl_xor(sb, o); }
        const float ra = 1.0f / sqrtf(sa * (1.0f / D) + EPS), rb = 1.0f / sqrtf(sb * (1.0f / D) + EPS);
        if (WRITE_X) { bf16_t* oa = xout + (size_t)row * D + 8 * lane;
#pragma unroll
            for (int j = 0; j < 4; ++j) { __builtin_nontemporal_store(pack8v(va[2 * j], va[2 * j + 1]), (u32x4*)(oa + 512 * j)); if (two) __builtin_nontemporal_store(pack8v(vb[2 * j], vb[2 * j + 1]), (u32x4*)(oa + D + 512 * j)); } }
        bf16_t* ha = H + (size_t)row * D + 8 * lane;
#pragma unroll
        for (int j = 0; j < 4; ++j) {
            *(u32x4*)(ha + 512 * j) = pack8v((va[2 * j] * ra) * gm[2 * j] + sh[2 * j], (va[2 * j + 1] * ra) * gm[2 * j + 1] + sh[2 * j + 1]);
            if (two) *(u32x4*)(ha + D + 512 * j) = pack8v((vb[2 * j] * rb) * gm[2 * j] + sh[2 * j], (vb[2 * j + 1] * rb) * gm[2 * j + 1] + sh[2 * j + 1]); }
        row += two ? 2 : 1;
    }
}
__device__ __forceinline__ void final_rows(const bf16_t* __restrict__ xs, const float* __restrict__ gvec, float* __restrict__ out, int gw, int NGW, int lane) {
    const int rpw = (ML + NGW - 1) / NGW, r0 = gw * rpw, r1 = (r0 + rpw < ML) ? r0 + rpw : ML;
    f32x4 g4[8];
#pragma unroll
    for (int j = 0; j < 8; ++j) g4[j] = *(const f32x4*)(gvec + 8 * lane + 512 * (j >> 1) + 4 * (j & 1));
    for (int row = r0; row < r1; ++row) {
        const bf16_t* xa = xs + (size_t)row * D + 8 * lane;
        u32x4 wx[4]; f32x4 v[8]; float ss = 0.f;
#pragma unroll
        for (int j = 0; j < 4; ++j) wx[j] = __builtin_nontemporal_load((const u32x4*)(xa + 512 * j));
#pragma unroll
        for (int j = 0; j < 4; ++j) unpack8v(wx[j], v[2 * j], v[2 * j + 1]);
#pragma unroll
        for (int j = 0; j < 8; ++j) ss += (v[j].x * v[j].x + v[j].y * v[j].y) + (v[j].z * v[j].z + v[j].w * v[j].w);
        const float rstd = 1.0f / sqrtf(wave_sum(ss) * (1.0f / D) + EPS);
        float* oa = out + (size_t)row * D + 8 * lane;
#pragma unroll
        for (int j = 0; j < 8; ++j) __builtin_nontemporal_store((v[j] * rstd) * g4[j], (f32x4*)(oa + 512 * (j >> 1) + 4 * (j & 1)));
    }
}
__device__ __forceinline__ void four_nyquist_rows(const bf16_t* __restrict__ TT, bf16_t* __restrict__ Y, int gw, int NGW, int lane) {
    for (int it = gw; it < NBATCH * 512; it += NGW) {
        const bf16_t* tr = TT + (size_t)it * 4096 + 8 * lane; float s = 0.f;
#pragma unroll
        for (int j = 0; j < 4; ++j) { float v[8]; unpack8(*(const u32x4*)(tr + 512 * j), v); s += ((v[0] - v[1]) + (v[2] - v[3])) + ((v[4] - v[5]) + (v[6] - v[7])); }
        s = wave_sum(s);
        if (lane == 0) Y[(size_t)((it >> 9) * 2048 + 1024) * D + 512 + (it & 511)] = (bf16_t)f2bf(s * (1.0f / 512.0f));
    }
}
__device__ __forceinline__ void mix_conv(const bf16_t* __restrict__ P, const float* __restrict__ wc  , bf16_t* __restrict__ Y, int nrows, size_t gtid, size_t NT) {
    const int R = (nrows * 64 + (int)NT - 1) / (int)NT > 0 ? (nrows + (int)(NT >> 6) - 1) / (int)(NT >> 6) : 1;
    const int run = (int)(gtid >> 6), c0 = (int)(gtid & 63) * 8;
    float w0[8], w1[8], w2[8];
#pragma unroll
    for (int e = 0; e < 8; ++e) { w0[e] = wc[c0 + e]; w1[e] = wc[512 + c0 + e]; w2[e] = wc[1024 + c0 + e]; }
    const int rbeg = run * R, rend = (rbeg + R < nrows) ? rbeg + R : nrows;
    for (int rb = rbeg; rb < rend; rb += 6) {
        u32x4 xr[8], br[6]; bool ok[8];
#pragma unroll
        for (int i = 0; i < 8; ++i) { const int row = rb - 1 + i;
            int n, L; if (row < ML) { n = row & 2047; L = 2048; } else { n = (row - ML) & 255; L = 256; }
            ok[i] = row >= 0 && row < nrows; (void)n; (void)L;
            const bf16_t* pr = P + (size_t)(ok[i] ? row : 0) * NPROJ;
            xr[i] = *(const u32x4*)(pr + OFF_Z + c0); }
#pragma unroll
        for (int i = 0; i < 6; ++i) { const int row = rb + i; br[i] = *(const u32x4*)(P + (size_t)(row < nrows ? row : 0) * NPROJ + OFF_AB + c0); }
        float z[8][8];
#pragma unroll
        for (int i = 0; i < 8; ++i) unpack8(xr[i], z[i]);
#pragma unroll
        for (int i = 0; i < 6; ++i) { const int row = rb + i; if (row < rend) {
            int n, L; if (row < ML) { n = row & 2047; L = 2048; } else { n = (row - ML) & 255; L = 256; }
            const float pm = n > 0 ? 1.f : 0.f, nm = n < L - 1 ? 1.f : 0.f;
            float gb[8], o[8]; unpack8(br[i], gb);
#pragma unroll
            for (int e = 0; e < 8; ++e) o[e] = gb[e] * ((pm * z[i][e]) * w0[e] + z[i + 1][e] * w1[e] + (nm * z[i + 2][e]) * w2[e]);
            u32x4 w; w.x = pk2(o[0], o[1]); w.y = pk2(o[2], o[3]); w.z = pk2(o[4], o[5]); w.w = pk2(o[6], o[7]);
            *(u32x4*)(Y + (size_t)row * D + c0) = w; } }
    }
}
typedef short bf16x8_t __attribute__((ext_vector_type(8)));
typedef short bf16x4_t __attribute__((ext_vector_type(4)));
constexpr int ATT_KLD = 72, ATT_VLD = 80  , ATT_KS = 0, ATT_VT = 128 * ATT_KLD * 2, ATT_BUF = ATT_VT + 128 * ATT_VLD * 2;
__device__ __forceinline__ void attn_item(const bf16_t* __restrict__ P, bf16_t* __restrict__ Y, const float* __restrict__ sinkl, int b, int kvh, int qb, bool isctx, LAS unsigned char* lds, int tid) {
    const int lane = tid & 63, wave = __builtin_amdgcn_readfirstlane(tid >> 6), fr = lane & 15, fq = lane >> 4;
    const int g = wave >> 1, h = kvh * 4 + g, p0 = qb * 128 + (wave & 1) * 64;
    const float L2E = 1.4426950408889634f, QS = 0.125f * L2E;
    const int t_hi = (qb == 15) ? 2 : 3;
    int t = isctx ? 3 : ((qb == 0) ? 1 : 0), buf = 0;
    const int sj = tid >> 3, part = tid & 7;
    u32x4 pv0, pv1, pk0, pk1;
#define ATT_PF(tt) do { const bool loc_ = (tt) < 3; const int k0_ = loc_ ? (qb - 1) * 128 + (tt) * 128 : ((tt) - 3) * 128; \
        const bf16_t* r_ = P + (loc_ ? (size_t)b * 2048 + k0_ + sj : (size_t)ML + b * 256 + k0_ + sj) * NPROJ + kvh * 64 + part * 8; \
        pk0 = *(const u32x4*)(r_ + OFF_K); pv0 = *(const u32x4*)(r_ + OFF_V); pk1 = *(const u32x4*)(r_ + (size_t)64 * NPROJ + OFF_K); pv1 = *(const u32x4*)(r_ + (size_t)64 * NPROJ + OFF_V); } while (0)
    ATT_PF(t);
    bf16x8_t Qf[4][2];
#pragma unroll
    for (int qblk = 0; qblk < 4; ++qblk) {
        const int qpos = p0 + qblk * 16 + fr;
        const size_t rowq = isctx ? (size_t)ML + b * 256 + qpos : (size_t)b * 2048 + qpos;
        const bf16_t* qp = P + rowq * NPROJ + OFF_Q + h * 64;
#pragma unroll
        for (int s = 0; s < 2; ++s) Qf[qblk][s] = *(const bf16x8_t*)(qp + 32 * s + 8 * fq);
    }
    f32x4 O[4][4]; float mrun[4], lsum[4];
    const float sk = sinkl[h] * L2E;
#pragma unroll
    for (int qblk = 0; qblk < 4; ++qblk) { mrun[qblk] = sk; lsum[qblk] = fq == 0 ? 1.0f : 0.0f;
#pragma unroll
        for (int db = 0; db < 4; ++db) O[qblk][db] = (f32x4){0.f, 0.f, 0.f, 0.f}; }
#pragma unroll 1
    for (;;) {
        const bool local = t < 3; const int k0 = local ? (qb - 1) * 128 + t * 128 : (t - 3) * 128;
        LAS bf16_t* Ks = (LAS bf16_t*)(lds + ATT_KS + buf * ATT_BUF); LAS bf16_t* Vt = (LAS bf16_t*)(lds + ATT_VT + buf * ATT_BUF);
        { *(LAS u32x4*)(Ks + sj * ATT_KLD + part * 8) = pk0; *(LAS u32x4*)(Ks + (sj + 64) * ATT_KLD + part * 8) = pk1;
          *(LAS u32x4*)(Vt + sj * ATT_VLD + part * 8) = pv0; *(LAS u32x4*)(Vt + (sj + 64) * ATT_VLD + part * 8) = pv1;
        }
        __syncthreads();
        const int tn = (t + 1 == t_hi) ? 3 : t + 1;
        if (tn < 5) ATT_PF(tn);
#pragma unroll 1
        for (int kb = 0; kb < 128; kb += 32) {
            const int kmin = k0 + kb;
            if (local && (kmin + 31 < p0 - 128 || kmin > p0 + 63 + 128)) continue;
            bf16x8_t Kf[2][2];
#pragma unroll
            for (int blk = 0; blk < 2; ++blk)
#pragma unroll
                for (int s = 0; s < 2; ++s) Kf[blk][s] = *(const LAS bf16x8_t*)(Ks + (kb + 16 * blk + fr) * ATT_KLD + 32 * s + 8 * fq);
            bf16x8_t Vf[4];
            int vlane = (4 * fq + (fr >> 2)) * ATT_VLD + 4 * (fr & 3); asm volatile("" : "+v"(vlane));
#pragma unroll
            for (int db = 0; db < 4; ++db) {
                const LAS bf16_t* vp = Vt + kb * ATT_VLD + vlane + 16 * db;
                const bf16x4_t lo = __builtin_amdgcn_ds_read_tr16_b64_v4i16((LAS bf16x4_t*)vp), hi = __builtin_amdgcn_ds_read_tr16_b64_v4i16((LAS bf16x4_t*)(vp + 16 * ATT_VLD));
                Vf[db] = __builtin_shufflevector(lo, hi, 0, 1, 2, 3, 4, 5, 6, 7); }
            const bool needmask = local && ((kmin + 31) - p0 > 128 || (p0 + 63) - kmin > 128);
            float sv[4][8], lm[4]; bool grow = false;
#pragma unroll
            for (int qblk = 0; qblk < 4; ++qblk) {
                f32x4 S0 = (f32x4){0.f, 0.f, 0.f, 0.f}, S1 = S0;
                S0 = __builtin_amdgcn_mfma_f32_16x16x32_bf16(Kf[0][0], Qf[qblk][0], S0, 0, 0, 0); S0 = __builtin_amdgcn_mfma_f32_16x16x32_bf16(Kf[0][1], Qf[qblk][1], S0, 0, 0, 0);
                S1 = __builtin_amdgcn_mfma_f32_16x16x32_bf16(Kf[1][0], Qf[qblk][0], S1, 0, 0, 0); S1 = __builtin_amdgcn_mfma_f32_16x16x32_bf16(Kf[1][1], Qf[qblk][1], S1, 0, 0, 0);
#pragma unroll
                for (int r = 0; r < 4; ++r) { sv[qblk][r] = S0[r]; sv[qblk][4 + r] = S1[r]; }
                if (needmask) { const int qpos = p0 + qblk * 16 + fr;
#pragma unroll
                    for (int r = 0; r < 4; ++r) { int d0 = qpos - (kmin + 4 * fq + r); d0 = d0 < 0 ? -d0 : d0; int d1 = qpos - (kmin + 16 + 4 * fq + r); d1 = d1 < 0 ? -d1 : d1;
                        sv[qblk][r] = d0 <= 128 ? sv[qblk][r] : -__builtin_inff(); sv[qblk][4 + r] = d1 <= 128 ? sv[qblk][4 + r] : -__builtin_inff(); } }
                lm[qblk] = fmaxf(fmaxf(fmaxf(sv[qblk][0], sv[qblk][1]), fmaxf(sv[qblk][2], sv[qblk][3])), fmaxf(fmaxf(sv[qblk][4], sv[qblk][5]), fmaxf(sv[qblk][6], sv[qblk][7]))) * QS;
                grow = grow || (lm[qblk] > mrun[qblk] + 8.0f);
            }
            if (__any(grow)) {
#pragma unroll
                for (int qblk = 0; qblk < 4; ++qblk) { float cm = lm[qblk];
                    { const u32x2 r16 = __builtin_amdgcn_permlane16_swap(__float_as_uint(cm), __float_as_uint(cm), false, false); cm = fmaxf(__uint_as_float(r16.x), __uint_as_float(r16.y));
                      const u32x2 r32 = __builtin_amdgcn_permlane32_swap(__float_as_uint(cm), __float_as_uint(cm), false, false); cm = fmaxf(__uint_as_float(r32.x), __uint_as_float(r32.y)); }
                    const float mnew = fmaxf(mrun[qblk], cm), sc = __builtin_amdgcn_exp2f(mrun[qblk] - mnew);
                    lsum[qblk] *= sc; mrun[qblk] = mnew;
#pragma unroll
                    for (int db = 0; db < 4; ++db) O[qblk][db] = O[qblk][db] * sc; }
            }
#pragma unroll
            for (int qblk = 0; qblk < 4; ++qblk) {
                float pp[8], ps = 0.f;
#pragma unroll
                for (int r = 0; r < 8; ++r) { pp[r] = __builtin_amdgcn_exp2f(__builtin_fmaf(sv[qblk][r], QS, -mrun[qblk])); ps += pp[r]; }
                lsum[qblk] += ps;
                u32x4 pw; pw.x = pk2(pp[0], pp[1]); pw.y = pk2(pp[2], pp[3]); pw.z = pk2(pp[4], pp[5]); pw.w = pk2(pp[6], pp[7]);
                const bf16x8_t Pf = __builtin_bit_cast(bf16x8_t, pw);
#pragma unroll
                for (int db = 0; db < 4; ++db) O[qblk][db] = __builtin_amdgcn_mfma_f32_16x16x32_bf16(Vf[db], Pf, O[qblk][db], 0, 0, 0);
            }
        }
        if (tn >= 5) break;
        t = tn; buf ^= 1;
    }
#undef ATT_PF
#pragma unroll
    for (int qblk = 0; qblk < 4; ++qblk) {
        float l = lsum[qblk]; l += __shfl_xor(l, 16); l += __shfl_xor(l, 32);
        const float rl = 1.0f / l;
        const int qpos = p0 + qblk * 16 + fr;
        const size_t rowq = isctx ? (size_t)ML + b * 256 + qpos : (size_t)b * 2048 + qpos;
        bf16_t* yp = Y + rowq * D + 1024 + h * 64 + 4 * fq;
#pragma unroll
        for (int db = 0; db < 4; ++db) { const f32x4 o = O[qblk][db] * rl; u32x2 w; w.x = pk2(o[0], o[1]); w.y = pk2(o[2], o[3]); *(u32x2*)(yp + 16 * db) = w; }
    }
}
__device__ __forceinline__ void mix_attn(const bf16_t* P, bf16_t* Y, const float* sinkl, int nitems, LAS unsigned char* lds, int vcu, int G, int tid) {
    for (int it = (G == 256) ? ((vcu + 192) & 255) : vcu; it < nitems; it += G) {

        if (it < 512) { const int b = it >> 5, kvh = (it >> 4) & 1, qb = it & 15; attn_item(P, Y, sinkl, b, kvh, qb, false, lds, tid); }
        else { const int r = it - 512, b = r >> 2, kvh = (r >> 1) & 1, qb = r & 1; attn_item(P, Y, sinkl, b, kvh, qb, true, lds, tid); }
        __syncthreads();
    }
    __syncthreads();
}
constexpr int MLP_LD = 136, MLP_BUF = 128 * MLP_LD * 2;
__device__ __forceinline__ void mix_mlp(const bf16_t* __restrict__ P, const bf16_t* __restrict__ WSB  , const float* __restrict__ b_s  , bf16_t* __restrict__ Y, int nrows, LAS unsigned char* lds, int vcu, int G, int tid) {
    const int lane = tid & 63, wave = __builtin_amdgcn_readfirstlane(tid >> 6), fr = lane & 15, fq = lane >> 4;
    const int nitems = (nrows / 128) * 4, q = tid >> 2, cp = tid & 3;
    u32x4 vr[4]; int buf = 0;
#define MLP_PF(itt) do { const bf16_t* pr_ = P + ((size_t)((itt) >> 2) * 128 + q) * NPROJ + OFF_MV + ((itt) & 3) * 128 + cp * 32; \
        _Pragma("unroll") for (int j_ = 0; j_ < 4; ++j_) vr[j_] = *(const u32x4*)(pr_ + 8 * j_); } while (0)
    int it = (G == 256) ? ((vcu + 128) & 255) : vcu;
    if (it < nitems) MLP_PF(it);
    for (; it < nitems; it += G) {
        const int ch = it >> 2, g = it & 3; const size_t row0 = (size_t)ch * 128;
        LAS bf16_t* VnT = (LAS bf16_t*)(lds + buf * MLP_BUF);
        { float vv[32];
#pragma unroll
          for (int j = 0; j < 4; ++j) unpack8(vr[j], vv + 8 * j);
          float s1 = 0.f;
#pragma unroll
          for (int i = 0; i < 32; ++i) { vv[i] = gelu_tanh(vv[i]); s1 += vv[i]; }
          s1 += __shfl_xor(s1, 1); s1 += __shfl_xor(s1, 2);
          const float mean = s1 * (1.0f / 128.0f); float qq = 0.f;
#pragma unroll
          for (int i = 0; i < 32; ++i) { vv[i] -= mean; qq += vv[i] * vv[i]; }
          qq += __shfl_xor(qq, 1); qq += __shfl_xor(qq, 2);
          const float rstd = 1.0f / sqrtf(qq * (1.0f / 128.0f) + EPS);
#pragma unroll
          for (int i = 0; i < 32; ++i) VnT[(cp * 32 + i) * MLP_LD + q] = (bf16_t)f2bf(vv[i] * rstd); }
        __syncthreads();
        if (it + G < nitems) MLP_PF(it + G);
        const int p = 16 * wave + fr;
        bf16x8_t Wf[4];
#pragma unroll
        for (int ks = 0; ks < 4; ++ks) Wf[ks] = *(const bf16x8_t*)(WSB + ((size_t)g * 128 + p) * 128 + 32 * ks + 8 * fq);
        const float bias = b_s[g * 128 + p];
        const bf16_t* ur = P + (row0 + p) * NPROJ + OFF_U + g * 128 + 4 * fq;
        bf16_t* yr = Y + (row0 + p) * D + 1536 + g * 128 + 4 * fq;
        u32x2 uw[8];
#pragma unroll
        for (int cb = 0; cb < 8; ++cb) uw[cb] = *(const u32x2*)(ur + 16 * cb);
#pragma unroll
        for (int cb = 0; cb < 8; ++cb) {
            f32x4 acc = (f32x4){0.f, 0.f, 0.f, 0.f};
#pragma unroll
            for (int ks = 0; ks < 4; ++ks) { const bf16x8_t Vf = *(const LAS bf16x8_t*)(VnT + (16 * cb + fr) * MLP_LD + 32 * ks + 8 * fq);
                acc = __builtin_amdgcn_mfma_f32_16x16x32_bf16(Vf, Wf[ks], acc, 0, 0, 0); }
            const float u0 = gelu_tanh(__uint_as_float(uw[cb].x << 16)), u1 = gelu_tanh(__uint_as_float(uw[cb].x & 0xffff0000u)), u2 = gelu_tanh(__uint_as_float(uw[cb].y << 16)), u3 = gelu_tanh(__uint_as_float(uw[cb].y & 0xffff0000u));
            u32x2 w; w.x = pk2(u0 * (acc[0] + bias), u1 * (acc[1] + bias)); w.y = pk2(u2 * (acc[2] + bias), u3 * (acc[3] + bias));
            *(u32x2*)(yr + 16 * cb) = w;
        }
        buf ^= 1;
    }
#undef MLP_PF
    __syncthreads();
}
constexpr int PH_LAYER0 = 2, PH_PER_LAYER = 10, PH_FINAL = PH_LAYER0 + DEPTH * PH_PER_LAYER, NPH = PH_FINAL + 1;
#ifndef PROBE_DUP
#define PROBE_DUP 0
#endif
#ifndef STAGGER_TICKS
#define STAGGER_TICKS 150
#endif
#ifndef MK_ONE_LAUNCH
#define MK_ONE_LAUNCH 1
#endif
struct Args { const float* in[18]; float* out; unsigned char* ws; int ph_lo, ph_hi, use_bar, pad; };
__global__ void __launch_bounds__(NTHREADS, 2) fwd(Args a) {
    extern __shared__ __attribute__((aligned(16))) unsigned char lds_raw[];
    LAS unsigned char* lds = (LAS unsigned char*)lds_raw;
    volatile LAS unsigned* MISC = (volatile LAS unsigned*)(lds + MISC_OFF);
    const int G = gridDim.x, bx = blockIdx.x, vcu = (G % 8 == 0) ? (bx % 8) * (G / 8) + bx / 8 : bx;
    const int NGW = G * NWAVES; const size_t NT = (size_t)G * NTHREADS;
#define TID_VARS int tid = threadIdx.x; asm volatile("" : "+v"(tid)); const int lane = tid & 63, wave = __builtin_amdgcn_readfirstlane(tid >> 6), gw = vcu * NWAVES + wave; const size_t gtid = (size_t)vcu * NTHREADS + tid; (void)lane; (void)gw; (void)gtid
    unsigned* ctl = (unsigned*)(a.ws + WS_CTL);
    for (int u = threadIdx.x; u < (LDS_BYTES - LDSCTL_OFF) / 4; u += NTHREADS) ((LAS unsigned*)(lds + LDSCTL_OFF))[u] = 0u;
    __syncthreads();
    XcdBarrier bar; bar.bar = ctl + CW_BAR; bar.x = 0; bar.st = nullptr;
    if (a.use_bar) bar = xcd_barrier_post(ctl + CW_BAR, MISC + 8);
    const int lo = a.ph_lo, hi = a.ph_hi;
#define IN(k) (lo <= (k) && (k) < hi)
#define SEAM(k) do { if (IN(k) && IN((k) + 1)) xcd_barrier(bar); } while (0)
#define STAGGER() do { if (STAGGER_TICKS) { const unsigned long long t0_ = __builtin_amdgcn_s_memrealtime(), w_ = (unsigned long long)(bx >> 5) * STAGGER_TICKS; while (__builtin_amdgcn_s_memrealtime() - t0_ < w_) __builtin_amdgcn_s_sleep(4); } } while (0)
#define REP(bit) for (int rep_ = 0; rep_ < (((PROBE_DUP) >> (bit)) & 1) + 1; ++rep_)
#define REPBAR() do { if (rep_ == 0 && a.use_bar && PROBE_DUP) xcd_barrier(bar); } while (0)
#define ARG_VARS const __attribute__((address_space(4))) Args* ap_ = (const __attribute__((address_space(4))) Args*)__builtin_amdgcn_kernarg_segment_ptr(); asm volatile("" : "+s"(ap_)); \
    unsigned char* const ws = ap_->ws; \
    const float* const x = ap_->in[0]; const float* const cvec = ap_->in[1]; const float* const ctx = ap_->in[2]; const float* const c_ctx = ap_->in[3]; const float* const w_ada = ap_->in[4]; const float* const b_ada = ap_->in[5]; \
    const float* const g_norm1 = ap_->in[6]; const float* const w_in = ap_->in[7]; const float* const w_conv = ap_->in[8]; const float* const sink = ap_->in[9]; const float* const w_s = ap_->in[10]; const float* const b_s = ap_->in[11]; \
    const float* const w_out = ap_->in[12]; const float* const g_norm2 = ap_->in[13]; const float* const w_gate = ap_->in[14]; const float* const w_up = ap_->in[15]; const float* const w_down = ap_->in[16]; const float* const g_final = ap_->in[17]; \
    bf16_t* const WIN = (bf16_t*)(ws + WS_WIN); bf16_t* const WOUT = (bf16_t*)(ws + WS_WOUT); bf16_t* const WGU = (bf16_t*)(ws + WS_WGU); bf16_t* const WDN = (bf16_t*)(ws + WS_WDN); \
    float* const MOD = (float*)(ws + WS_MOD); float* const MODP = (float*)(ws + WS_MODP); bf16_t* const XS = (bf16_t*)(ws + WS_XS); \
    bf16_t* const H = (bf16_t*)(ws + WS_H); bf16_t* const P = (bf16_t*)(ws + WS_P); bf16_t* const Y = (bf16_t*)(ws + WS_Y); bf16_t* const HF = (bf16_t*)(ws + WS_HF); \
    bf16_t* const TT = (bf16_t*)(ws + WS_TT); bf16_t* const TTC = (bf16_t*)(ws + WS_TTC); bf16_t* const DFTN = (bf16_t*)(ws + WS_DFTN); bf16_t* const DFTC = (bf16_t*)(ws + WS_DFTC); \
    f32x2* const ROPE = (f32x2*)(ws + WS_ROPE); bf16_t* const CSBD = (bf16_t*)(ws + WS_CSBD); bf16_t* const DL = (bf16_t*)(ws + WS_DL); bf16_t* const WSB = (bf16_t*)(ws + WS_WSB); \
    const float* const modl = MOD + (size_t)l * 17 * MODW; \
    (void)x; (void)cvec; (void)ctx; (void)c_ctx; (void)w_ada; (void)b_ada; (void)g_norm1; (void)w_in; (void)w_conv; (void)sink; (void)w_s; (void)b_s; (void)w_out; (void)g_norm2; (void)w_gate; (void)w_up; (void)w_down; (void)g_final; \
    (void)WIN; (void)WOUT; (void)WGU; (void)WDN; (void)MOD; (void)MODP; (void)XS; (void)H; (void)P; (void)Y; (void)HF; (void)TT; (void)TTC; (void)DFTN; (void)DFTC; (void)ROPE; (void)CSBD; (void)DL; (void)WSB; (void)modl

    REP(14) { if (rep_) xcd_barrier(bar);
    if (IN(0)) { const int l = 0; ARG_VARS; TID_VARS;
        LAS float* scr = (LAS float*)(lds + wave * 17408);
        p0_modp(cvec, c_ctx, w_ada, MODP, scr, gw, NGW, lane);
        p0_transposes(w_in, w_out, WIN, WOUT, scr, gw, NGW, lane);
        p0_tables(DFTN, DFTC, CSBD, ROPE, gtid, NT);
        SEAM(0);
    }
    if (IN(1)) { const int l = 0; ARG_VARS; TID_VARS; p1_mod(MODP, b_ada, MOD, gtid, NT); p1_wsb(w_s, WSB, gtid, NT); SEAM(1); } }

#define PASS_RANGE_LAT(ra) const int rw_ = (G == 256) ? ((bx < 128) ? (ra) : 256 - (ra)) : 0; \
        const int r0 = (G == 256) ? (((bx < 128) ? bx * (ra) : 128 * (ra) + (bx - 128) * (256 - (ra))) + wave * (rw_ >> 3)) : gw * ((ML + NGW - 1) / NGW); \
        const int r1 = (G == 256) ? r0 + (rw_ >> 3) : ((r0 + (ML + NGW - 1) / NGW < ML) ? r0 + (ML + NGW - 1) / NGW : ML)
#define PASS_RANGE_CTX() const int cr_ = (MC + NGW - 1) / NGW, r0 = ML + gw * cr_, r1 = (r0 + cr_ < MT) ? r0 + cr_ : MT
    for (int l = 0; l < DEPTH; ++l) {
        const int pb = PH_LAYER0 + l * PH_PER_LAYER;
        const bool lastl = (l == DEPTH - 1);
        const int Mrows = lastl ? ML : MT;
        if (IN(pb + 0)) { ARG_VARS;
            if (l == 0) { TID_VARS; const int rpw = (MT + NGW - 1) / NGW, r0 = gw * rpw, r1 = (r0 + rpw < MT) ? r0 + rpw : MT;
                resnorm_rows<true, false, true>(x, ctx, nullptr, XS, g_norm1, modl, 0, D, H, r0, r1, lane); }
            else {
                { pg8::Gemm g{HF + (size_t)ML * DFF, WDN + (size_t)(l - 1) * D * DFF, MC, D, DFF, DFF, DFF}; pg8::StaticOrder S; S.init(MC, D, G, bx);
                  pg8::EpiRes E{XS, modl - (size_t)17 * MODW, 5 * D, 128};
                  pg8::gemm_phase<pg8::EpiRes, pg8::StaticOrder, true, true>(lds, g, S, E); }
                TID_VARS; PASS_RANGE_LAT(0);
                resnorm_rows<false, false, false>(XS, XS, nullptr, nullptr, g_norm1 + l * D, modl, 0, D, H, r0, r1, lane);
                if (G != 256 || bx >= 128) { const int sw = (G == 256) ? (bx - 128) * NWAVES + wave : gw, nsw = (G == 256) ? 128 * NWAVES : NGW; LAS float* scr = (LAS float*)(lds + wave * 17408);
                    if (l == 1) tr_wout123(w_out, WOUT, scr, sw, nsw, lane);
                    else if (l == 2) tr_down(w_down + (size_t)3 * DFF * D, WDN + (size_t)3 * D * DFF, scr, sw, nsw, lane);
                    else tr_gateup(w_gate + (size_t)l * D * DFF, w_up + (size_t)l * D * DFF, WGU + (size_t)l * NGU * D, scr, sw, nsw, lane); } }
            SEAM(pb + 0); }
        if (IN(pb + 1)) { ARG_VARS; if (l > 0) { TID_VARS; PASS_RANGE_CTX();
                resnorm_rows<false, false, false>(XS, XS + (size_t)ML * D, nullptr, nullptr, g_norm1 + l * D, modl, 0, D, H, r0, r1, lane); }
            if (l > 0) SEAM(pb + 1); }
        REP(2) { if (rep_) xcd_barrier(bar);
        if (IN(pb + 2)) { ARG_VARS;
            pg8::Gemm g{H, WIN + (size_t)l * NPROJ * D, Mrows, NPROJ, D, D, D}; pg8::OrderIn S; S.init(Mrows, NPROJ, G, bx); S.extra = lastl ? 16 : 0;
            { int tt_ = threadIdx.x; asm volatile("" : "+v"(tt_)); for (int i = tt_; i < 96 * 16 * 2 / 4; i += NTHREADS) ((LAS f32x4*)(lds + ROPE_LDS_OFF))[i] = ((const f32x4*)ROPE)[i]; }
            pg8::EpiP E{P, NPROJ, (const LAS float*)(lds + ROPE_LDS_OFF)};
            pg8::gemm_phase<pg8::EpiP, pg8::OrderIn, true, true>(lds, g, S, E);
            if (!lastl) { const int rem = ((Mrows / 256) * 15) % G;
              if (rem != 0 && bx >= rem) { TID_VARS; tr_gateup(w_gate + (size_t)l * D * DFF, w_up + (size_t)l * D * DFF, WGU + (size_t)l * NGU * D, (LAS float*)(lds + wave * 17408), (bx - rem) * NWAVES + wave, (G - rem) * NWAVES, lane); }
              else if (rem == 0) { TID_VARS; tr_gateup(w_gate + (size_t)l * D * DFF, w_up + (size_t)l * D * DFF, WGU + (size_t)l * NGU * D, (LAS float*)(lds + wave * 17408), gw, NGW, lane); }
            }
            SEAM(pb + 2);
        } }
        REP(3) { if (rep_) xcd_barrier(bar);
        if (IN(pb + 3)) { ARG_VARS;
            REP(16) { int kf = 128; asm volatile("" : "+s"(kf));
              pg8::Gemm g{CSBD, P + OFF_F, 1024, Mrows, kf, 128, NPROJ}; pg8::OrderFour1 S; S.init(Mrows / 256, G, bx);
              pg8::EpiFour1 E{TT, TTC};
              pg8::gemm_phase<pg8::EpiFour1, pg8::OrderFour1, true, true>(lds, g, S, E); }
            TID_VARS;
            const bool conv_last = ((bx >> 3) & 1) != 0;
            if (!conv_last) { REP(17) mix_conv(P, w_conv + (size_t)l * 3 * 512, Y, Mrows, gtid, NT); }
            REP(18) mix_attn(P, Y, sink + l * 8, lastl ? 512 : 576, lds, bx, G, tid);
            REP(19) mix_mlp(P, WSB + (size_t)l * 4 * 128 * 128, b_s + (size_t)l * 4 * 128, Y, Mrows, lds, bx, G, tid);
            if (conv_last) { REP(17) mix_conv(P, w_conv + (size_t)l * 3 * 512, Y, Mrows, gtid, NT); }
            SEAM(pb + 3);
        } }
        REP(4) { if (rep_) xcd_barrier(bar);
        if (IN(pb + 4)) { ARG_VARS;
            { pg8::Gemm g{DFTN, TT, 2048, 8192, 4096, 4096, 4096}; pg8::StaticOrder S; S.init(2048, 8192, G, bx);
              pg8::EpiFourEO E{Y, 1.0f / 512.0f};
              pg8::gemm_phase<pg8::EpiFourEO, pg8::StaticOrder, true, true, true>(lds, g, S, E); }
            { TID_VARS; four_nyquist_rows(TT, Y, gw, NGW, lane); }
            if (!lastl) { pg8::Gemm g{DFTC, TTC, 256, 8192, 512, 512, 512}; pg8::StaticOrder S; S.init(256, 8192, G, bx);
              pg8::EpiFour E{Y, 0.005524271728019903f  , ML, 256};
              pg8::gemm_phase<pg8::EpiFour, pg8::StaticOrder, true, true>(lds, g, S, E); }
            if (!lastl && bx >= 32 && G > 32) { TID_VARS;
                tr_down(w_down + (size_t)l * DFF * D, WDN + (size_t)l * D * DFF, (LAS float*)(lds + wave * 17408), (bx - 32) * NWAVES + wave, (G - 32) * NWAVES, lane); }
            else if (!lastl && G <= 32) { TID_VARS; tr_down(w_down + (size_t)l * DFF * D, WDN + (size_t)l * D * DFF, (LAS float*)(lds + wave * 17408), gw, NGW, lane); }
            SEAM(pb + 4);
        } }
        REP(5) { if (rep_) xcd_barrier(bar);
        if (IN(pb + 5)) { ARG_VARS;
            pg8::Gemm g{Y, WOUT + (size_t)l * D * D, ML, D, D, D, D}; pg8::StaticOrder S; S.init(ML, D, G, bx);
            pg8::EpiRes E{XS, modl, 2 * D, 0};
            pg8::gemm_phase<pg8::EpiRes, pg8::StaticOrder, true, true>(lds, g, S, E);
            SEAM(pb + 5);
        } }
        if (IN(pb + 6)) { ARG_VARS;
            if (!lastl) { pg8::Gemm g{Y + (size_t)ML * D, WOUT + (size_t)l * D * D, MC, D, D, D, D}; pg8::StaticOrder S; S.init(MC, D, G, bx);
              pg8::EpiRes E{XS, modl, 2 * D, 128};
              pg8::gemm_phase<pg8::EpiRes, pg8::StaticOrder, true, true>(lds, g, S, E); }
            TID_VARS; PASS_RANGE_LAT(lastl ? 128 : 40);
            resnorm_rows<false, false, false>(XS, XS, nullptr, nullptr, g_norm2 + l * D, modl, 3 * D, 4 * D, H, r0, r1, lane);
            if (PROBE_DUP & (1 << 20)) resnorm_rows<false, false, false>(XS, XS, nullptr, nullptr, g_norm2 + l * D, modl, 3 * D, 4 * D, H, r0, r1, lane);
            SEAM(pb + 6); }
        if (IN(pb + 7)) { ARG_VARS; if (!lastl) { TID_VARS; PASS_RANGE_CTX();
                resnorm_rows<false, false, false>(XS, XS + (size_t)ML * D, nullptr, nullptr, g_norm2 + l * D, modl, 3 * D, 4 * D, H, r0, r1, lane); }
            if (!lastl) SEAM(pb + 7); }
        REP(8) { if (rep_) xcd_barrier(bar);
        if (IN(pb + 8)) { ARG_VARS;
            pg8::Gemm g{H, WGU + (size_t)l * NGU * D, Mrows, NGU, D, D, D}; pg8::StaticOrder S; S.init(Mrows, NGU, G, bx);
            pg8::EpiGU E{HF};
            pg8::gemm_phase<pg8::EpiGU, pg8::StaticOrder, true, true>(lds, g, S, E);
            if (!lastl) { const int rem = ((Mrows / 256) * 44) % G;
              if (rem != 0 && bx >= rem) { TID_VARS; tr_win(w_in + (size_t)(l + 1) * D * NPROJ, WIN + (size_t)(l + 1) * NPROJ * D, (LAS float*)(lds + wave * 17408), (bx - rem) * NWAVES + wave, (G - rem) * NWAVES, lane); }
              else if (rem == 0) { TID_VARS; tr_win(w_in + (size_t)(l + 1) * D * NPROJ, WIN + (size_t)(l + 1) * NPROJ * D, (LAS float*)(lds + wave * 17408), gw, NGW, lane); }
            }
            SEAM(pb + 8);
        } }
        REP(9) { if (rep_) xcd_barrier(bar);
        if (IN(pb + 9)) { ARG_VARS;
            pg8::Gemm g{HF, WDN + (size_t)l * D * DFF, ML, D, DFF, DFF, DFF}; pg8::StaticOrder S; S.init(ML, D, G, bx);
            pg8::EpiRes E{XS, modl, 5 * D, 0};
            pg8::gemm_phase<pg8::EpiRes, pg8::StaticOrder, true, true>(lds, g, S, E);
            SEAM(pb + 9);
        } }
    }
    if (IN(PH_FINAL)) { const int l = 0; ARG_VARS; TID_VARS; final_rows(XS, g_final, a.out, gw, NGW, lane); }
#undef IN
#undef SEAM
}

extern "C" void kernel_launch(void* const* d_in, const int* in_sizes, int n_in, void* d_out, int out_size, void* d_ws, size_t ws_size, hipStream_t stream) {
    static int grid = 0;
    if (grid == 0) {
        if (n_in != 18 || in_sizes[0] != ML * D || out_size != ML * D || ws_size < WS_END) { fprintf(stderr, "kernel_launch: unexpected shapes: n_in %d in0 %d out %d ws %zu (need %zu)\n", n_in, n_in > 0 ? in_sizes[0] : -1, out_size, ws_size, (size_t)WS_END); grid = -1; return; }
        int dev = 0, cus = 0, per_cu = 0;
        if (hipGetDevice(&dev) != hipSuccess || hipDeviceGetAttribute(&cus, hipDeviceAttributeMultiprocessorCount, dev) != hipSuccess) { fprintf(stderr, "kernel_launch: device query failed\n"); grid = -1; return; }
        if (hipFuncSetAttribute((const void*)fwd, hipFuncAttributeMaxDynamicSharedMemorySize, LDS_BYTES) != hipSuccess) { fprintf(stderr, "kernel_launch: hipFuncSetAttribute failed\n"); grid = -1; return; }
        if (hipOccupancyMaxActiveBlocksPerMultiprocessor(&per_cu, (const void*)fwd, NTHREADS, LDS_BYTES) != hipSuccess || per_cu < 1) fprintf(stderr, "kernel_launch: note: occupancy query reports %d workgroups per CU\n", per_cu);
        (void)hipGetLastError();
        grid = cus;
    }
    if (grid < 0) return;
    if (hipMemsetAsync((char*)d_ws + WS_CTL, 0, 32768  , stream) != hipSuccess) { fprintf(stderr, "kernel_launch: memset failed\n"); return; }
    Args a{};
    for (int i = 0; i < 18; ++i) a.in[i] = (const float*)d_in[i];
    a.out = (float*)d_out; a.ws = (unsigned char*)d_ws; a.pad = 0;
#if MK_ONE_LAUNCH
    a.ph_lo = 0; a.ph_hi = NPH; a.use_bar = 1;
    hipLaunchKernelGGL(fwd, dim3(grid), dim3(NTHREADS), LDS_BYTES, stream, a);
#else
    for (int ph = 0; ph < NPH; ++ph) { a.ph_lo = ph; a.ph_hi = ph + 1; a.use_bar = 0; hipLaunchKernelGGL(fwd, dim3(grid), dim3(NTHREADS), LDS_BYTES, stream, a); }
#endif
    const hipError_t le = hipPeekAtLastError();
    if (le != hipSuccess) fprintf(stderr, "kernel_launch: launch failed: %s\n", hipGetErrorName(le));
}
```

```cpp
#include <hip/hip_runtime.h>
#include <cstdio>
#include <cstdint>
namespace pg8 {
#define PG8_LAS __attribute__((address_space(3)))
typedef unsigned short bf16_t;
typedef short bf16x8 __attribute__((ext_vector_type(8)));
typedef float f32x4 __attribute__((ext_vector_type(4)));
typedef unsigned u32x4 __attribute__((ext_vector_type(4)));
constexpr int BM = 256, BK = 64, HALF = 128, HTB = HALF * BK * 2  , STAGE_BYTES = 8 * HTB, NXCD = 8, WGM = 8;

__host__ __device__ __forceinline__ int lds_byte(int r, int c) { const int st = (r >> 4) * 2 + (c >> 5), rr = r & 15, cc = c & 31, ob = rr * 64 + cc * 2; return st * 1024 + (ob ^ (((ob >> 9) & 1) << 5)); }
__host__ __device__ __forceinline__ void stage_rc(int b, int& R, int& C) { const int st = b / 1024, sb = b % 1024, swz = sb ^ (((sb >> 9) & 1) << 5); R = (st >> 1) * 16 + swz / 64; C = (st & 1) * 32 + (swz % 64) / 2; }
__host__ __device__ __forceinline__ int perm32(int rho) { const int n = rho >> 4, i = rho & 15; return 8 * (i >> 2) + 4 * n + (i & 3); }

struct Unit { int pm, pn, bo; };
struct Gemm { const bf16_t* A; const bf16_t* Bt; int M, N, K, lda, ldb; };

struct StaticOrder {
    int nM, nN, nwg, G, c;
    __host__ __device__ void init(int M, int N, int G_, int c_) { nM = M / BM; nN = N / BM; nwg = nM * nN; G = G_; c = c_; }
    __host__ __device__ bool next(int i, Unit& u) const {
        const long L = (long)i * G + c; if (L >= nwg) return false;
        int wgid = (int)L; { const int q = nwg / NXCD, r = nwg % NXCD, xcd = wgid % NXCD, off = wgid / NXCD; wgid = (xcd < r ? xcd * (q + 1) : r * (q + 1) + (xcd - r) * q) + off; }
        const int nig = WGM * nN, gid = wgid / nig, fm = gid * WGM, gsz = (nM - fm) < WGM ? (nM - fm) : WGM;
        u.pm = fm + ((wgid % nig) % gsz); u.pn = (wgid % nig) / gsz; u.bo = 0; return true;
    }
    __device__ __forceinline__ void a_ready(const Unit&) const {}
    __device__ __forceinline__ void done(const Unit&) const {}
};

struct OrderIn : StaticOrder {
    int extra;
    __host__ __device__ bool next(int i, Unit& u) const {
        const long L = (long)i * G + c; if (L < nwg) return StaticOrder::next(i, u);
        const long j = L - nwg; if (j >= extra) return false;
        u.pm = 128 + (int)j; u.pn = 10; u.bo = 0; return true;
    }
};
struct OrderFour1 {
    int nwg, G, c;
    __host__ __device__ void init(int npanels, int G_, int c_) { nwg = 4 * npanels; G = G_; c = c_; }
    __host__ __device__ bool next(int i, Unit& u) const { const long L = (long)i * G + c; if (L >= nwg) return false; u.pm = (int)(L & 3); u.pn = (int)(L >> 2); u.bo = u.pm * 128; return true; }
    __device__ __forceinline__ void a_ready(const Unit&) const {}
    __device__ __forceinline__ void done(const Unit&) const {}
};
typedef float f32x2 __attribute__((ext_vector_type(2)));
typedef unsigned u32x2 __attribute__((ext_vector_type(2)));
typedef __bf16 bf16x2_hw __attribute__((ext_vector_type(2)));
__device__ __forceinline__ unsigned cvt_pk_bf16(float lo, float hi) { const f32x2 v = {lo, hi}; const bf16x2_hw b = __builtin_convertvector(v, bf16x2_hw); return __builtin_bit_cast(unsigned, b); }
__device__ __forceinline__ float silu_f(float x) { return x * __builtin_amdgcn_rcpf(1.0f + __expf(-x)); }
struct EpiP {
    static constexpr bool PERM = true, AFTER_DRAIN = false; static constexpr int NSTORES = 16;
    bf16_t* O; int ldc; const PG8_LAS float* rope;
    __device__ __forceinline__ void operator()(const f32x4 (&acc)[2][2][4][2], const Unit& u, int wr, int wc, int fr, int fq) const {
        const int row0 = u.pm * BM + wr * 64 + fr;
        if (u.pn < 4) {
            bf16_t* zp = O + (size_t)row0 * ldc + u.pn * HALF + wc * 32 + 8 * fq;
#pragma unroll
            for (int ai = 0; ai < 2; ++ai)
#pragma unroll
                for (int m = 0; m < 4; ++m) { const f32x4 v0 = acc[ai][0][m][0] * acc[ai][1][m][0], v1 = acc[ai][0][m][1] * acc[ai][1][m][1];
                    u32x4 w; w.x = cvt_pk_bf16(v0[0], v0[1]); w.y = cvt_pk_bf16(v0[2], v0[3]); w.z = cvt_pk_bf16(v1[0], v1[1]); w.w = cvt_pk_bf16(v1[2], v1[3]);
                    *(u32x4*)(zp + (size_t)(ai * HALF + m * 16) * ldc) = w; }
            return;
        }
        const int col0 = (u.pn < 6 ? u.pn - 2 : u.pn) * BM + wc * 32 + 8 * fq;
        const bool qk = (u.pm < 128) && (u.pn >= 8) && (u.pn <= 10);
        const float sgn = (fq >> 1) ? 1.0f : -1.0f; const bool lo = fq < 2;
#pragma unroll
        for (int ai = 0; ai < 2; ++ai)
#pragma unroll
            for (int m = 0; m < 4; ++m) { const int row = row0 + ai * HALF + m * 16; bf16_t* rowp = O + (size_t)row * ldc + col0;
                f32x4 cs[4];
                if (qk) { const int pos = row & 2047, coord = (wc & 1) ? 32 + (pos & 63) : (pos >> 6); const PG8_LAS float* rp = rope + (coord * 16 + (fq & 1) * 8) * 2;
#pragma unroll
                    for (int k = 0; k < 4; ++k) cs[k] = *(const PG8_LAS f32x4*)(rp + 4 * k); }
#pragma unroll
                for (int bj = 0; bj < 2; ++bj) { f32x4 v0 = acc[ai][bj][m][0], v1 = acc[ai][bj][m][1];
                    if (qk && (u.pn != 10 || bj == 0)) {
                        f32x4 p0, p1;
#pragma unroll
                        for (int e = 0; e < 4; ++e) {
                            const u32x2 s0 = __builtin_amdgcn_permlane32_swap(__float_as_uint(v0[e]), __float_as_uint(v0[e]), false, false); p0[e] = __uint_as_float(lo ? s0.y : s0.x);
                            const u32x2 s1 = __builtin_amdgcn_permlane32_swap(__float_as_uint(v1[e]), __float_as_uint(v1[e]), false, false); p1[e] = __uint_as_float(lo ? s1.y : s1.x); }
                        v0[0] = v0[0] * cs[0].x + sgn * (p0[0] * cs[0].y); v0[1] = v0[1] * cs[0].z + sgn * (p0[1] * cs[0].w);
                        v0[2] = v0[2] * cs[1].x + sgn * (p0[2] * cs[1].y); v0[3] = v0[3] * cs[1].z + sgn * (p0[3] * cs[1].w);
                        v1[0] = v1[0] * cs[2].x + sgn * (p1[0] * cs[2].y); v1[1] = v1[1] * cs[2].z + sgn * (p1[1] * cs[2].w);
                        v1[2] = v1[2] * cs[3].x + sgn * (p1[2] * cs[3].y); v1[3] = v1[3] * cs[3].z + sgn * (p1[3] * cs[3].w);
                    }
                    u32x4 w; w.x = cvt_pk_bf16(v0[0], v0[1]); w.y = cvt_pk_bf16(v0[2], v0[3]); w.z = cvt_pk_bf16(v1[0], v1[1]); w.w = cvt_pk_bf16(v1[2], v1[3]);
                    *(u32x4*)(rowp + bj * HALF) = w; } }
    }
};
struct EpiRes {
    static constexpr bool PERM = true, AFTER_DRAIN = false; static constexpr int NSTORES = 16;
    bf16_t* XS; const float* modl; int goff, pm_off;
    __device__ __forceinline__ void operator()(const f32x4 (&acc)[2][2][4][2], const Unit& u, int wr, int wc, int fr, int fq) const {
        const int pm = u.pm + pm_off, b = pm < 128 ? (pm >> 3) : 16;
        const int row0 = pm * BM + wr * 64 + fr, col0 = u.pn * BM + wc * 32 + 8 * fq;
        const float* gate = modl + (size_t)b * 12288 + goff;
        f32x4 gv[2][2];
#pragma unroll
        for (int bj = 0; bj < 2; ++bj)
#pragma unroll
            for (int n = 0; n < 2; ++n) gv[bj][n] = *(const f32x4*)(gate + col0 + bj * HALF + 4 * n);
#pragma unroll
        for (int ai = 0; ai < 2; ++ai) {
            u32x4 xw[4][2];
#pragma unroll
            for (int m = 0; m < 4; ++m)
#pragma unroll
                for (int bj = 0; bj < 2; ++bj) xw[m][bj] = *(const u32x4*)(XS + (size_t)(row0 + ai * HALF + m * 16) * 2048 + col0 + bj * HALF);
#pragma unroll
            for (int m = 0; m < 4; ++m) { bf16_t* rowp = XS + (size_t)(row0 + ai * HALF + m * 16) * 2048 + col0;
#pragma unroll
                for (int bj = 0; bj < 2; ++bj) { const u32x4 xv = xw[m][bj];
                    const f32x4 x0 = {__uint_as_float(xv.x << 16), __uint_as_float(xv.x & 0xffff0000u), __uint_as_float(xv.y << 16), __uint_as_float(xv.y & 0xffff0000u)};
                    const f32x4 x1 = {__uint_as_float(xv.z << 16), __uint_as_float(xv.z & 0xffff0000u), __uint_as_float(xv.w << 16), __uint_as_float(xv.w & 0xffff0000u)};
                    const f32x4 v0 = x0 + acc[ai][bj][m][0] * gv[bj][0], v1 = x1 + acc[ai][bj][m][1] * gv[bj][1];
                    u32x4 w; w.x = cvt_pk_bf16(v0[0], v0[1]); w.y = cvt_pk_bf16(v0[2], v0[3]); w.z = cvt_pk_bf16(v1[0], v1[1]); w.w = cvt_pk_bf16(v1[2], v1[3]);
                    *(u32x4*)(rowp + bj * HALF) = w; } }
        }
    }
};
struct EpiGU {
    static constexpr bool PERM = true, AFTER_DRAIN = false; static constexpr int NSTORES = 8;
    bf16_t* O;
    __device__ __forceinline__ void operator()(const f32x4 (&acc)[2][2][4][2], const Unit& u, int wr, int wc, int fr, int fq) const {
        const int row0 = u.pm * BM + wr * 64 + fr, col0 = u.pn * HALF + wc * 32 + 8 * fq;
#pragma unroll
        for (int ai = 0; ai < 2; ++ai)
#pragma unroll
            for (int mp = 0; mp < 4; mp += 2) {
                f32x2 gg[8], uu[8], e[8];
#pragma unroll
                for (int q = 0; q < 2; ++q)
#pragma unroll
                    for (int n = 0; n < 2; ++n) { const f32x4 ga = acc[ai][0][mp + q][n], ua = acc[ai][1][mp + q][n];
                        gg[q * 4 + n * 2] = (f32x2){ga[0], ga[1]}; gg[q * 4 + n * 2 + 1] = (f32x2){ga[2], ga[3]}; uu[q * 4 + n * 2] = (f32x2){ua[0], ua[1]}; uu[q * 4 + n * 2 + 1] = (f32x2){ua[2], ua[3]}; }
#pragma unroll
                for (int i = 0; i < 8; ++i) { const f32x2 t = gg[i] * -1.4426950408889634f; e[i] = (f32x2){__builtin_amdgcn_exp2f(t[0]), __builtin_amdgcn_exp2f(t[1])}; }
#pragma unroll
                for (int i = 0; i < 8; ++i) { const f32x2 d = e[i] + 1.0f; e[i] = (f32x2){__builtin_amdgcn_rcpf(d[0]), __builtin_amdgcn_rcpf(d[1])}; }
#pragma unroll
                for (int i = 0; i < 8; ++i) e[i] = (gg[i] * uu[i]) * e[i];
#pragma unroll
                for (int q = 0; q < 2; ++q) { bf16_t* rowp = O + (size_t)(row0 + ai * HALF + (mp + q) * 16) * 5632 + col0;
                    u32x4 w; w.x = cvt_pk_bf16(e[q * 4 + 0][0], e[q * 4 + 0][1]); w.y = cvt_pk_bf16(e[q * 4 + 1][0], e[q * 4 + 1][1]); w.z = cvt_pk_bf16(e[q * 4 + 2][0], e[q * 4 + 2][1]); w.w = cvt_pk_bf16(e[q * 4 + 3][0], e[q * 4 + 3][1]);
                    *(u32x4*)rowp = w; }
            }
    }
};
struct EpiFour {
    static constexpr bool PERM = true, AFTER_DRAIN = false; static constexpr int NSTORES = 16;
    bf16_t* Y; float scale; int row_base, rows_per_batch;
    __device__ __forceinline__ void operator()(const f32x4 (&acc)[2][2][4][2], const Unit& u, int wr, int wc, int fr, int fq) const {
        const int row0 = row_base + (u.pn >> 1) * rows_per_batch + u.pm * BM + wr * 64 + fr, col0 = 512 + (u.pn & 1) * BM + wc * 32 + 8 * fq;
#pragma unroll
        for (int ai = 0; ai < 2; ++ai)
#pragma unroll
            for (int m = 0; m < 4; ++m) { bf16_t* rowp = Y + (size_t)(row0 + ai * HALF + m * 16) * 2048 + col0;
#pragma unroll
                for (int bj = 0; bj < 2; ++bj) { const f32x4 v0 = acc[ai][bj][m][0] * scale, v1 = acc[ai][bj][m][1] * scale;
                    u32x4 w; w.x = cvt_pk_bf16(v0[0], v0[1]); w.y = cvt_pk_bf16(v0[2], v0[3]); w.z = cvt_pk_bf16(v1[0], v1[1]); w.w = cvt_pk_bf16(v1[2], v1[3]);
                    *(u32x4*)(rowp + bj * HALF) = w; } }
    }
};
struct EpiFourEO {
    static constexpr bool PERM = true, AFTER_DRAIN = false; static constexpr int NSTORES = 16;
    bf16_t* Y; float scale;
    __device__ __forceinline__ void operator()(const f32x4 (&acc)[2][2][4][2], const Unit& u, int wr, int wc, int fr, int fq) const {
        const int rowb = (u.pn >> 1) * 2048, col0 = 512 + (u.pn & 1) * BM + wc * 32 + 8 * fq;
#pragma unroll
        for (int m = 0; m < 4; ++m) { const int k = u.pm * HALF + wr * 64 + m * 16 + fr;
            bf16_t* ra = Y + (size_t)(rowb + k) * 2048 + col0; bf16_t* rb = Y + (size_t)(rowb + 2048 - k) * 2048 + col0;
#pragma unroll
            for (int bj = 0; bj < 2; ++bj) { const f32x4 e0 = acc[0][bj][m][0] * scale, e1 = acc[0][bj][m][1] * scale, o0 = acc[1][bj][m][0] * scale, o1 = acc[1][bj][m][1] * scale;
                const f32x4 a0 = e0 - o0, a1 = e1 - o1, b0 = e0 + o0, b1 = e1 + o1;
                u32x4 w; w.x = cvt_pk_bf16(a0[0], a0[1]); w.y = cvt_pk_bf16(a0[2], a0[3]); w.z = cvt_pk_bf16(a1[0], a1[1]); w.w = cvt_pk_bf16(a1[2], a1[3]);
                *(u32x4*)(ra + bj * HALF) = w;
                u32x4 v; v.x = cvt_pk_bf16(b0[0], b0[1]); v.y = cvt_pk_bf16(b0[2], b0[3]); v.z = cvt_pk_bf16(b1[0], b1[1]); v.w = cvt_pk_bf16(b1[2], b1[3]);
                if (k > 0) *(u32x4*)(rb + bj * HALF) = v; } }
    }
};
struct EpiFour1 {
    static constexpr bool PERM = true, AFTER_DRAIN = false; static constexpr int NSTORES = 16;
    bf16_t* TT; bf16_t* TTC;
    __device__ __forceinline__ void operator()(const f32x4 (&acc)[2][2][4][2], const Unit& u, int wr, int wc, int fr, int fq) const {
        const int g = u.pm; bf16_t* base; size_t chs, half;
        if (u.pn < 128) { const int b = u.pn >> 3, n0 = (u.pn & 7) * BM + wc * 32 + 8 * fq; base = TT + (size_t)(b * 512 + g * 128) * 4096 + n0; chs = 4096; half = 2048; }
        else { const int b = u.pn - 128, n0 = wc * 32 + 8 * fq; base = TTC + (size_t)(b * 512 + g * 128) * 512 + n0; chs = 512; half = 256; }
#pragma unroll
        for (int ai = 0; ai < 2; ++ai)
#pragma unroll
            for (int m = 0; m < 4; ++m) { bf16_t* rowp = base + (size_t)(wr * 64 + m * 16 + fr) * chs + ai * half;
#pragma unroll
                for (int bj = 0; bj < 2; ++bj) { const f32x4 v0 = acc[ai][bj][m][0], v1 = acc[ai][bj][m][1];
                    u32x4 w; w.x = cvt_pk_bf16(v0[0], v0[1]); w.y = cvt_pk_bf16(v0[2], v0[3]); w.z = cvt_pk_bf16(v1[0], v1[1]); w.w = cvt_pk_bf16(v1[2], v1[3]);
                    *(u32x4*)(rowp + bj * HALF) = w; } }
    }
};
template <class Epi, class Sched, bool ALIGN_EPI = false, bool SP2 = false, bool EO = false>
__device__ __forceinline__ void gemm_phase(PG8_LAS unsigned char* lds, const Gemm g, const Sched& S, const Epi& E) {
    int tid_ = threadIdx.x; asm volatile("" : "+v"(tid_));
    const int tid = tid_, wid = __builtin_amdgcn_readfirstlane(tid >> 6), lane = tid & 63, wr = wid >> 2, wc = wid & 3, fr = lane & 15, fq = lane >> 4;
    const int K = g.K, nt = K / BK;
    unsigned voffA[2], voffB[2];
#pragma unroll
    for (int i = 0; i < 2; ++i) { int R, C; stage_rc(tid * 16 + i * 8192, R, C); const int Rb = Epi::PERM ? ((R & ~31) + perm32(R & 31)) : R;
        voffA[i] = (unsigned)(R * g.lda + C) * 2u; voffB[i] = (unsigned)(Rb * g.ldb + C) * 2u; }
    const size_t kstep = (size_t)(BK * 2);
    const size_t hstepA = (size_t)HALF * g.lda * 2, hstepB = (size_t)HALF * g.ldb * 2;
    const size_t tstepA = 2 * hstepA, tstepB = 2 * hstepB;
    const unsigned ldsw = (unsigned)wid * 1024u;
    const int aoff = lds_byte(wr * 64 + fr, fq * 8), boff = lds_byte(wc * 32 + fr, fq * 8);
#define PG8_SA(b, h) (((b) * 2 + (h)) * HTB)
#define PG8_SB(b, h) ((4 + (b) * 2 + (h)) * HTB)
#define PG8_STAGE(bufoff, gbase, voff) do { _Pragma("unroll") for (int _i = 0; _i < 2; ++_i) \
        __builtin_amdgcn_global_load_lds((const unsigned*)((const char*)(gbase) + (voff)[_i]), (PG8_LAS unsigned*)(lds + (bufoff) + ldsw + _i * 8192), 16, 0, 0); } while (0)
#define PG8_LDA(dst, b, h) do { _Pragma("unroll") for (int m = 0; m < 4; ++m) _Pragma("unroll") for (int k = 0; k < 2; ++k) dst[m][k] = *(const PG8_LAS bf16x8*)(lds + PG8_SA(b, h) + aoff + m * 2048 + k * 1024); } while (0)
#define PG8_LDB(dst, b, h) do { _Pragma("unroll") for (int n = 0; n < 2; ++n) _Pragma("unroll") for (int k = 0; k < 2; ++k) dst[n][k] = *(const PG8_LAS bf16x8*)(lds + PG8_SB(b, h) + boff + n * 2048 + k * 1024); } while (0)
#define PG8_MMA(ai, bj, At, Bt) do { __builtin_amdgcn_s_setprio(1); _Pragma("unroll") for (int m = 0; m < 4; ++m) _Pragma("unroll") for (int n = 0; n < 2; ++n) _Pragma("unroll") for (int k = 0; k < 2; ++k) \
        acc[ai][bj][m][n] = __builtin_amdgcn_mfma_f32_16x16x32_bf16(Bt[n][k], At[m][k], acc[ai][bj][m][n], 0, 0, 0); __builtin_amdgcn_s_setprio(0); } while (0)
#define PG8_WAIT_V(n) asm volatile("s_waitcnt vmcnt(" #n ")" ::: "memory")
#define PG8_WAIT_L(n) asm volatile("s_waitcnt lgkmcnt(" #n ")" ::: "memory")
#define PG8_BAR __builtin_amdgcn_s_barrier()
#define PG8_SCHED __builtin_amdgcn_sched_barrier(0)
    Unit cur, nxt; int ui = 0;
    if (!S.next(0, cur)) return;
    f32x4 acc[2][2][4][2];
#pragma unroll
    for (int a = 0; a < 2; ++a)
#pragma unroll
        for (int b = 0; b < 2; ++b)
#pragma unroll
            for (int m = 0; m < 4; ++m)
#pragma unroll
                for (int n = 0; n < 2; ++n) acc[a][b][m][n] = (f32x4){0.f, 0.f, 0.f, 0.f};
    bf16x8 At[4][2], B0[2][2], B1[2][2];
    const char* cA = (const char*)g.A + (size_t)cur.pm * tstepA; const char* cB = (const char*)g.Bt + (size_t)cur.pn * tstepB + (size_t)cur.bo * 2;
    S.a_ready(cur);
    if constexpr (SP2) {
        PG8_STAGE(PG8_SB(0, 0), cB, voffB); PG8_STAGE(PG8_SB(0, 1), cB + hstepB, voffB); PG8_STAGE(PG8_SA(0, 0), cA, voffA); PG8_STAGE(PG8_SA(0, 1), cA + hstepA, voffA);
        if (wr == 1) PG8_BAR;
        PG8_WAIT_V(2); PG8_BAR;
        PG8_STAGE(PG8_SB(1, 0), cB + kstep, voffB); PG8_STAGE(PG8_SA(1, 0), cA + kstep, voffA); PG8_STAGE(PG8_SB(1, 1), cB + hstepB + kstep, voffB);
        PG8_WAIT_V(6); PG8_BAR;
    } else {
        PG8_STAGE(PG8_SB(0, 0), cB, voffB); PG8_STAGE(PG8_SA(0, 0), cA, voffA); PG8_STAGE(PG8_SB(0, 1), cB + hstepB, voffB); PG8_STAGE(PG8_SA(0, 1), cA + hstepA, voffA);
        if (wr == 1) PG8_BAR;
        PG8_WAIT_V(4); PG8_BAR;
        PG8_STAGE(PG8_SB(1, 0), cB + kstep, voffB); PG8_STAGE(PG8_SA(1, 0), cA + kstep, voffA); PG8_STAGE(PG8_SB(1, 1), cB + hstepB + kstep, voffB);
        PG8_WAIT_V(6); PG8_BAR;
    }
    for (;;) {
        const bool has_next = S.next(ui + 1, nxt);
        const char* nA = has_next ? (const char*)g.A + (size_t)nxt.pm * tstepA : cA; const char* nB = has_next ? (const char*)g.Bt + (size_t)nxt.pn * tstepB + (size_t)nxt.bo * 2 : cB;
        for (int t = 0; t < nt; t += 2) {
            const bool last = (t == nt - 2);
            const char* a1 = cA + (size_t)(t + 1) * kstep;
            const char* a2 = last ? nA : cA + (size_t)(t + 2) * kstep; const char* b2 = last ? nB : cB + (size_t)(t + 2) * kstep;
            const char* a3 = a2 + kstep; const char* b3 = b2 + kstep;
            if (last && has_next) S.a_ready(nxt);
            const bool eo1 = 2 * t < nt;
            if constexpr (SP2) {
#define PG8_WAIT_K() do { if constexpr (EO) { if (t == nt / 2 - 2) PG8_WAIT_V(4); else PG8_WAIT_V(6); } else PG8_WAIT_V(8); } while (0)
            const bool eo2 = last || (2 * (t + 2) < nt);
            PG8_LDB(B0, 0, 0); PG8_LDB(B1, 0, 1); PG8_SCHED; if (!EO || eo1) PG8_LDA(At, 0, 0); if (!EO || !eo1) PG8_STAGE(PG8_SA(1, 1), a1 + hstepA, voffA);
            PG8_WAIT_K(); PG8_WAIT_L(0); PG8_BAR; if (!EO || eo1) { PG8_MMA(0, 0, At, B0); PG8_MMA(0, 1, At, B1); } PG8_BAR; PG8_SCHED;
            if (!EO || !eo1) PG8_LDA(At, 0, 1); PG8_STAGE(PG8_SB(0, 0), b2, voffB); PG8_STAGE(PG8_SB(0, 1), b2 + hstepB, voffB); if (!EO || eo2) PG8_STAGE(PG8_SA(0, 0), a2, voffA);
            PG8_WAIT_K(); PG8_WAIT_L(0); PG8_BAR; if (!EO || !eo1) { PG8_MMA(1, 0, At, B0); PG8_MMA(1, 1, At, B1); } PG8_BAR; PG8_SCHED;
            PG8_LDB(B0, 1, 0); PG8_LDB(B1, 1, 1); PG8_SCHED; if (!EO || eo1) PG8_LDA(At, 1, 0); if (!EO || !eo2) PG8_STAGE(PG8_SA(0, 1), a2 + hstepA, voffA);
            PG8_WAIT_K(); PG8_WAIT_L(0); PG8_BAR; if (!EO || eo1) { PG8_MMA(0, 0, At, B0); PG8_MMA(0, 1, At, B1); } PG8_BAR; PG8_SCHED;
            if (!EO || !eo1) PG8_LDA(At, 1, 1); PG8_STAGE(PG8_SB(1, 0), b3, voffB); PG8_STAGE(PG8_SB(1, 1), b3 + hstepB, voffB); if (!EO || eo2) PG8_STAGE(PG8_SA(1, 0), a3, voffA);
            PG8_WAIT_K(); PG8_WAIT_L(0); PG8_BAR; if (!EO || !eo1) { PG8_MMA(1, 0, At, B0); PG8_MMA(1, 1, At, B1); } PG8_BAR; PG8_SCHED;
#undef PG8_WAIT_K
            } else {
            PG8_LDB(B0, 0, 0); PG8_SCHED; PG8_LDA(At, 0, 0); PG8_STAGE(PG8_SA(1, 1), a1 + hstepA, voffA);
            PG8_WAIT_L(8); PG8_BAR; PG8_WAIT_L(0); PG8_MMA(0, 0, At, B0); PG8_BAR; PG8_SCHED;
            PG8_LDB(B1, 0, 1); PG8_STAGE(PG8_SB(0, 0), b2, voffB);
            PG8_BAR; PG8_WAIT_L(0); PG8_MMA(0, 1, At, B1); PG8_BAR;
            PG8_LDA(At, 0, 1); PG8_STAGE(PG8_SA(0, 0), a2, voffA);
            PG8_BAR; PG8_WAIT_L(0); PG8_MMA(1, 0, At, B0); PG8_BAR; PG8_SCHED;
            PG8_STAGE(PG8_SB(0, 1), b2 + hstepB, voffB);
            PG8_WAIT_V(6); PG8_BAR; PG8_MMA(1, 1, At, B1); PG8_BAR;
            PG8_LDB(B0, 1, 0); PG8_SCHED; PG8_LDA(At, 1, 0); PG8_STAGE(PG8_SA(0, 1), a2 + hstepA, voffA);
            PG8_WAIT_L(8); PG8_BAR; PG8_WAIT_L(0); PG8_MMA(0, 0, At, B0); PG8_BAR; PG8_SCHED;
            PG8_LDB(B1, 1, 1); PG8_STAGE(PG8_SB(1, 0), b3, voffB);
            PG8_BAR; PG8_WAIT_L(0); PG8_MMA(0, 1, At, B1); PG8_BAR;
            PG8_LDA(At, 1, 1); PG8_STAGE(PG8_SA(1, 0), a3, voffA);
            PG8_BAR; PG8_WAIT_L(0); PG8_MMA(1, 0, At, B0); PG8_BAR; PG8_SCHED;
            PG8_STAGE(PG8_SB(1, 1), b3 + hstepB, voffB);
            PG8_WAIT_V(6); PG8_BAR; PG8_MMA(1, 1, At, B1); PG8_BAR;
            }
        }
        if constexpr (ALIGN_EPI) { if (wr == 0) PG8_BAR; }
        if constexpr (!Epi::AFTER_DRAIN) { E(acc, cur, wr, wc, fr, fq); S.done(cur); }
        if (!has_next) break;
#pragma unroll
        for (int a = 0; a < 2; ++a)
#pragma unroll
            for (int b = 0; b < 2; ++b)
#pragma unroll
                for (int m = 0; m < 4; ++m)
#pragma unroll
                    for (int n = 0; n < 2; ++n) acc[a][b][m][n] = (f32x4){0.f, 0.f, 0.f, 0.f};
        cur = nxt; cA = nA; cB = nB; ++ui;
        if constexpr (ALIGN_EPI) { if (wr == 1) PG8_BAR; }
    }
    PG8_WAIT_V(0);
    if constexpr (!ALIGN_EPI) { if (wr == 0) PG8_BAR; }
    PG8_BAR;
    if constexpr (Epi::AFTER_DRAIN) { E.fused(acc, cur, wr, wc, fr, fq, lds, wid, lane); S.done(cur); }
#undef PG8_SA
#undef PG8_SB
#undef PG8_STAGE
#undef PG8_LDA
#undef PG8_LDB
#undef PG8_MMA
#undef PG8_WAIT_V
#undef PG8_WAIT_L
#undef PG8_BAR
#undef PG8_SCHED
}
}
#define GAS __attribute__((address_space(1)))
#define LAS __attribute__((address_space(3)))
typedef unsigned short bf16_t;
typedef unsigned u32x4 __attribute__((ext_vector_type(4)));
typedef unsigned u32x2 __attribute__((ext_vector_type(2)));
typedef float f32x4 __attribute__((ext_vector_type(4)));
typedef float f32x2 __attribute__((ext_vector_type(2)));

constexpr int D = 2048, NBATCH = 16, SEQ = 2048, DEPTH = 4, CTXL = 256;
constexpr int ML = NBATCH * SEQ, MC = NBATCH * CTXL, MT = ML + MC;
constexpr int NPROJ = 3840, DFF = 5632, NGU = 2 * DFF, MODW = 6 * D;
constexpr int OFF_Z = 0  , OFF_AX = 0, OFF_AB = 512, OFF_AC = 1024, OFF_F = 1536, OFF_Q = 2048, OFF_K = 2560, OFF_V = 2688, OFF_U = 2816, OFF_MV = 3328;
constexpr float EPS = 1e-6f;
constexpr int NWAVES = 8, NTHREADS = 512;

constexpr size_t al256(size_t x) { return (x + 255) & ~(size_t)255; }
constexpr size_t WS_CTL = 0, CTL_ZERO_BYTES = 1u << 20;
constexpr size_t WS_WIN = CTL_ZERO_BYTES;
constexpr size_t WS_WOUT = WS_WIN + (size_t)DEPTH * NPROJ * D * 2;
constexpr size_t WS_WGU = WS_WOUT + (size_t)DEPTH * D * D * 2;
constexpr size_t WS_WDN = WS_WGU + (size_t)DEPTH * NGU * D * 2;
constexpr size_t WS_MOD = WS_WDN + (size_t)DEPTH * D * DFF * 2;
constexpr size_t WS_MODP = al256(WS_MOD + (size_t)DEPTH * 17 * MODW * 4);
constexpr size_t WS_XS = al256(WS_MODP + (size_t)DEPTH * 8 * 17 * MODW * 4);
constexpr size_t WS_H = WS_XS + (size_t)MT * D * 2;
constexpr size_t WS_P = WS_H + (size_t)MT * D * 2;
constexpr size_t WS_Y = WS_P + (size_t)MT * NPROJ * 2;
constexpr size_t WS_HF = WS_P;
constexpr size_t WS_TT = WS_Y + (size_t)MT * D * 2;
static_assert(WS_HF + (size_t)MT * DFF * 2 <= WS_TT, "hf overlay");
constexpr size_t WS_TTC = WS_TT + (size_t)NBATCH * 512 * 4096 * 2;
constexpr size_t WS_DFTN = WS_TTC + (size_t)NBATCH * 512 * 512 * 2;
constexpr size_t WS_DFTC = WS_DFTN + (size_t)2048 * 4096 * 2;
constexpr size_t WS_ROPE = WS_DFTC + (size_t)256 * 512 * 2;
constexpr size_t WS_CSBD = WS_ROPE + (size_t)2048 * 32 * 8;
constexpr size_t WS_DL = WS_CSBD + (size_t)1024 * 512 * 2;
constexpr size_t WS_WSB = WS_DL + (size_t)MT * D * 2;
constexpr size_t WS_END = WS_WSB + (size_t)DEPTH * 4 * 128 * 128 * 2;
constexpr int CW_BAR = 4096;

constexpr int LDS_BYTES = 147456;
constexpr int ROPE_LDS_OFF = 131072;
constexpr int LDSCTL_OFF = 146432, MISC_OFF = LDSCTL_OFF;

#define LDS_WAIT() asm volatile("s_waitcnt lgkmcnt(0)" ::: "memory")
__device__ __forceinline__ float bf2f(unsigned b) { return __uint_as_float(b << 16); }
__device__ __forceinline__ unsigned f2bf(float f) { unsigned u = __float_as_uint(f); return (u + 0x7fffu + ((u >> 16) & 1u)) >> 16; }
typedef __bf16 bf16x2_hw __attribute__((ext_vector_type(2)));
__device__ __forceinline__ unsigned pk2(float lo, float hi) { const f32x2 v = {lo, hi}; const bf16x2_hw b = __builtin_convertvector(v, bf16x2_hw); return __builtin_bit_cast(unsigned, b); }
__device__ __forceinline__ void unpack8(const u32x4 w, float* o) {
    o[0] = __uint_as_float(w.x << 16); o[1] = __uint_as_float(w.x & 0xffff0000u); o[2] = __uint_as_float(w.y << 16); o[3] = __uint_as_float(w.y & 0xffff0000u);
    o[4] = __uint_as_float(w.z << 16); o[5] = __uint_as_float(w.z & 0xffff0000u); o[6] = __uint_as_float(w.w << 16); o[7] = __uint_as_float(w.w & 0xffff0000u);
}
__device__ __forceinline__ float wave_sum(float v) {
#pragma unroll
    for (int o = 1; o < 64; o <<= 1) v += __shfl_xor(v, o);
    return v;
}
__device__ __forceinline__ float gelu_tanh(float x) {
    const float u = 0.7978845608028654f * (x + 0.044715f * x * x * x);
    const float e = __expf(2.0f * u);
    const float t = 1.0f - 2.0f * __builtin_amdgcn_rcpf(1.0f + e);
    return 0.5f * x * (1.0f + t);
}
#define XB_TMO      128
#define XB_XCNT(j)  (256  + 64 * (j))
#define XB_XSUB(j)  (1280 + 64 * (j))
#define XB_XGEN(j)  (2304 + 64 * (j))
#define XB_TOP      3328
#define XB_TOPGEN   3392
#define XCD_BAR_WORDS 3456
#define XB_SPIN_CAP (1u << 18)

__device__ __forceinline__ unsigned xb_ld(unsigned* p)              { return __hip_atomic_load(p, __ATOMIC_RELAXED, __HIP_MEMORY_SCOPE_AGENT); }
__device__ __forceinline__ unsigned xb_add(unsigned* p, unsigned v) { return __hip_atomic_fetch_add(p, v, __ATOMIC_RELAXED, __HIP_MEMORY_SCOPE_AGENT); }
__device__ __forceinline__ unsigned xb_xcc_id() { return (unsigned)__builtin_amdgcn_s_getreg((3 << 11) | 20) & 0xFu; }
#define XB_SPIN(cond, bar) do { unsigned _sp = 0; while (cond) { __builtin_amdgcn_s_sleep(1); \
    if ((++_sp & 255u) == 0u) { if (xb_ld(&(bar)[XB_TMO])) break; if (_sp > XB_SPIN_CAP) { atomicAdd(&(bar)[XB_TMO], 1u); break; } } } } while (0)

struct XcdBarrier {
    unsigned* bar; unsigned x;
    volatile LAS unsigned* st;
};

__device__ __forceinline__ XcdBarrier xcd_barrier_post(unsigned* bar, volatile LAS unsigned* st) {
    XcdBarrier b; b.bar = bar; b.x = xb_xcc_id(); b.st = st;
    if (threadIdx.x == 0) (void)xb_add(&bar[XB_XCNT(b.x)], 1u);
    return b;
}
__device__ __forceinline__ void xcd_barrier_complete(unsigned* bar, unsigned x, unsigned& nloc, unsigned& nx) {
    const unsigned G = gridDim.x * gridDim.y * gridDim.z;
    unsigned sum, cnt, mine, sp = 0u;
    for (;;) {
        sum = 0u; cnt = 0u; mine = 0u;
#pragma unroll
        for (unsigned j = 0; j < 16; ++j) { const unsigned c = xb_ld(&bar[XB_XCNT(j)]); sum += c; cnt += (c > 0u) ? 1u : 0u; mine = (j == x) ? c : mine; }
        if (sum == G) break;
        __builtin_amdgcn_s_sleep(1);
        if ((++sp & 255u) == 0u) { if (xb_ld(&bar[XB_TMO])) break; if (sp > XB_SPIN_CAP) { atomicAdd(&bar[XB_TMO], 1u); break; } }
    }
    nloc = mine > 0u ? mine : 1u; nx = cnt > 0u ? cnt : 1u;
}

__device__ __forceinline__ void xcd_barrier(const XcdBarrier& b) {
    asm volatile("s_waitcnt vmcnt(0)" ::: "memory");
    __syncthreads();
    if (threadIdx.x == 0) {
        unsigned* bar = b.bar;
        __builtin_amdgcn_s_waitcnt(0);
        unsigned nloc = b.st[0], nx = b.st[1];
        if (nloc == 0u) { xcd_barrier_complete(bar, b.x, nloc, nx); b.st[0] = nloc; b.st[1] = nx; }
        const unsigned old = xb_add(&bar[XB_XSUB(b.x)], 1u);
        const unsigned gen = old / nloc;
        if (old + 1u == (gen + 1u) * nloc) {
            __builtin_amdgcn_fence(__ATOMIC_RELEASE, "agent");
            asm volatile("s_waitcnt vmcnt(0)" ::: "memory");
            const unsigned og = xb_add(&bar[XB_TOP], 1u);
            const unsigned tg = og / nx;
            if (og + 1u == (tg + 1u) * nx) xb_add(&bar[XB_TOPGEN], 1u);
            else XB_SPIN(xb_ld(&bar[XB_TOPGEN]) == tg, bar);
            __builtin_amdgcn_fence(__ATOMIC_ACQUIRE, "agent");
            xb_add(&bar[XB_XGEN(b.x)], 1u);
            asm volatile("s_waitcnt vmcnt(0)" ::: "memory");
        } else {
            XB_SPIN(xb_ld(&bar[XB_XGEN(b.x)]) == gen, bar);
            __builtin_amdgcn_fence(__ATOMIC_ACQUIRE, "agent");
            asm volatile("s_waitcnt vmcnt(0)" ::: "memory");
        }
    }
    __syncthreads();
}
__device__ __forceinline__ void tr_item(const float* __restrict__ W, int K, int N, bf16_t* __restrict__ WT, int k0, int n0, int drow0, LAS float* scr, int lane) {
    { const int kr = lane >> 3, c4 = (lane & 7) * 4;
      f32x4 v[8];
#pragma unroll
      for (int i = 0; i < 8; ++i) v[i] = __builtin_nontemporal_load((const f32x4*)(W + (size_t)(k0 + 8 * i + kr) * N + n0 + c4));
#pragma unroll
      for (int i = 0; i < 8; ++i) { LAS float* d = scr + (8 * i + kr) * 33 + c4; d[0] = v[i].x; d[1] = v[i].y; d[2] = v[i].z; d[3] = v[i].w; } }
    LDS_WAIT(); asm volatile("" ::: "memory");
    const int c = lane & 7;
#pragma unroll
    for (int j = 0; j < 4; ++j) { const int n = (lane >> 3) + 8 * j; const LAS float* s = scr + (8 * c) * 33 + n;
        u32x4 o; o.x = pk2(s[0 * 33], s[1 * 33]); o.y = pk2(s[2 * 33], s[3 * 33]); o.z = pk2(s[4 * 33], s[5 * 33]); o.w = pk2(s[6 * 33], s[7 * 33]);
        *(u32x4*)(WT + (size_t)(drow0 + n) * K + k0 + 8 * c) = o; }
    LDS_WAIT(); asm volatile("" ::: "memory");
}
__device__ __forceinline__ int win_drow(int n0) {
    if (n0 < 512) return (n0 >> 7) * 256 + (n0 & 127);
    if (n0 < 1024) return 1024 + (n0 - 512);
    if (n0 < 1536) { const int c = n0 - 1024; return (c >> 7) * 256 + 128 + (c & 127); }
    return n0;
}
constexpr int TR_IN = 32 * 120, TR_OUT = 32 * 64, TR_G = 32 * 176, TR_DN = 88 * 64, TR_P0L = TR_IN + TR_OUT;
__device__ __forceinline__ void p0_transposes(const float* w_in, const float* w_out, bf16_t* WIN, bf16_t* WOUT, LAS float* scr, int gw, int NGW, int lane) {
    for (int it = gw; it < TR_IN + TR_OUT; it += NGW) {
        int r = it;
        if (r < TR_IN) { const int kb = r / 120, nb = r % 120; tr_item(w_in, D, NPROJ, WIN, kb * 64, nb * 32, win_drow(nb * 32), scr, lane); continue; } r -= TR_IN;
        { const int kb = r / 64, nb = r % 64; tr_item(w_out, D, D, WOUT, kb * 64, nb * 32, nb * 32, scr, lane); }
    }
}
__device__ __forceinline__ void tr_wout123(const float* w_out, bf16_t* WOUT, LAS float* scr, int sw, int nsw, int lane) {
    for (int it = sw; it < 3 * TR_OUT; it += nsw) { const int l = 1 + it / TR_OUT, q = it % TR_OUT, kb = q / 64, nb = q % 64;
        tr_item(w_out + (size_t)l * D * D, D, D, WOUT + (size_t)l * D * D, kb * 64, nb * 32, nb * 32, scr, lane); }
}
__device__ __forceinline__ void tr_load(const float* __restrict__ W, int N, int k0, int n0, int lane, f32x4 (&v)[8]) {
    const int kr = lane >> 3, c4 = (lane & 7) * 4;
#pragma unroll
    for (int i = 0; i < 8; ++i) v[i] = __builtin_nontemporal_load((const f32x4*)(W + (size_t)(k0 + 8 * i + kr) * N + n0 + c4));
}
__device__ __forceinline__ void tr_emit(const f32x4 (&v)[8], int K, bf16_t* __restrict__ WT, int k0, int drow0, LAS float* scr, int lane) {
    { const int kr = lane >> 3, c4 = (lane & 7) * 4;
#pragma unroll
      for (int i = 0; i < 8; ++i) { LAS float* d = scr + (8 * i + kr) * 33 + c4; d[0] = v[i].x; d[1] = v[i].y; d[2] = v[i].z; d[3] = v[i].w; } }
    LDS_WAIT(); asm volatile("" ::: "memory");
    const int c = lane & 7;
#pragma unroll
    for (int j = 0; j < 4; ++j) { const int n = (lane >> 3) + 8 * j; const LAS float* sp = scr + (8 * c) * 33 + n;
        u32x4 o; o.x = pk2(sp[0 * 33], sp[1 * 33]); o.y = pk2(sp[2 * 33], sp[3 * 33]); o.z = pk2(sp[4 * 33], sp[5 * 33]); o.w = pk2(sp[6 * 33], sp[7 * 33]);
        *(u32x4*)(WT + (size_t)(drow0 + n) * K + k0 + 8 * c) = o; }
    LDS_WAIT(); asm volatile("" ::: "memory");
}
__device__ __forceinline__ void tr_gateup(const float* w_gate_l, const float* w_up_l, bf16_t* WGU_l, LAS float* scr, int sw, int nsw, int lane, int lo = 0, int hi = 2 * TR_G) {
    f32x4 v[8], vn[8]; int it = lo + sw;
    if (it < hi) { const int up = it >= TR_G, r = up ? it - TR_G : it; tr_load(up ? w_up_l : w_gate_l, DFF, (r / 176) * 64, (r % 176) * 32, lane, v); }
    for (; it < hi; it += nsw) {
        const int nx = it + nsw;
        if (nx < hi) { const int up = nx >= TR_G, r = up ? nx - TR_G : nx; tr_load(up ? w_up_l : w_gate_l, DFF, (r / 176) * 64, (r % 176) * 32, lane, vn); }
        const int up = it >= TR_G, r = up ? it - TR_G : it, kb = r / 176, n0 = (r % 176) * 32;
        tr_emit(v, D, WGU_l, kb * 64, (n0 >> 7) * 256 + (up ? 128 : 0) + (n0 & 127), scr, lane);
#pragma unroll
        for (int i = 0; i < 8; ++i) v[i] = vn[i];
    }
}
__device__ __forceinline__ void tr_win(const float* w_in_l, bf16_t* WIN_l, LAS float* scr, int sw, int nsw, int lane) {
    f32x4 v[8], vn[8]; int it = sw;
    if (it < TR_IN) tr_load(w_in_l, NPROJ, (it / 120) * 64, (it % 120) * 32, lane, v);
    for (; it < TR_IN; it += nsw) {
        const int nx = it + nsw;
        if (nx < TR_IN) tr_load(w_in_l, NPROJ, (nx / 120) * 64, (nx % 120) * 32, lane, vn);
        tr_emit(v, D, WIN_l, (it / 120) * 64, win_drow((it % 120) * 32), scr, lane);
#pragma unroll
        for (int i = 0; i < 8; ++i) v[i] = vn[i];
    }
}
__device__ __forceinline__ void tr_down(const float* w_down_l, bf16_t* WDN_l, LAS float* scr, int sw, int nsw, int lane) {
    f32x4 v[8], vn[8]; int it = sw;
    if (it < TR_DN) tr_load(w_down_l, D, (it / 64) * 64, (it % 64) * 32, lane, v);
    for (; it < TR_DN; it += nsw) {
        const int nx = it + nsw;
        if (nx < TR_DN) tr_load(w_down_l, D, (nx / 64) * 64, (nx % 64) * 32, lane, vn);
        tr_emit(v, DFF, WDN_l, (it / 64) * 64, (it % 64) * 32, scr, lane);
#pragma unroll
        for (int i = 0; i < 8; ++i) v[i] = vn[i];
    }
}
__device__ __forceinline__ void p0_modp(const float* __restrict__ c, const float* __restrict__ c_ctx, const float* __restrict__ w_ada, float* __restrict__ modp, LAS float* scr  , int gw, int NGW, int lane) {
    for (int it = gw; it < DEPTH * 48 * 8; it += NGW) {
        const int l = it / 384, rem = it % 384, cc = rem >> 3, ks = rem & 7, k0 = ks * 256;
#pragma unroll
        for (int r = 0; r < 17; ++r)
#pragma unroll
            for (int j = 0; j < 4; ++j) { const int idx = j * 64 + lane; const float v = (r < 16) ? c[r * D + k0 + idx] : c_ctx[k0 + idx]; scr[r * 256 + idx] = v * (1.0f / (1.0f + __expf(-v))); }
        LDS_WAIT(); asm volatile("" ::: "memory");
        f32x4 acc[17];
#pragma unroll
        for (int r = 0; r < 17; ++r) acc[r] = (f32x4){0.f, 0.f, 0.f, 0.f};
        const float* wp = w_ada + ((size_t)l * D + k0) * MODW + cc * 256 + lane * 4;
#pragma unroll 2
        for (int k4 = 0; k4 < 64; ++k4) {
            const f32x4 w0 = *(const f32x4*)(wp + (size_t)(4 * k4 + 0) * MODW), w1 = *(const f32x4*)(wp + (size_t)(4 * k4 + 1) * MODW);
            const f32x4 w2 = *(const f32x4*)(wp + (size_t)(4 * k4 + 2) * MODW), w3 = *(const f32x4*)(wp + (size_t)(4 * k4 + 3) * MODW);
#pragma unroll
            for (int r = 0; r < 17; ++r) { const f32x4 s = *(const LAS f32x4*)(scr + r * 256 + 4 * k4); acc[r] = acc[r] + w0 * s.x + w1 * s.y + w2 * s.z + w3 * s.w; }
        }
#pragma unroll
        for (int r = 0; r < 17; ++r) *(f32x4*)(modp + ((size_t)((l * 8 + ks) * 17 + r)) * MODW + cc * 256 + lane * 4) = acc[r];
        LDS_WAIT(); asm volatile("" ::: "memory");
    }
}
__device__ __forceinline__ void p0_tables(bf16_t* DFTN, bf16_t* DFTC, bf16_t* CSBD, f32x2* ROPE, size_t gtid, size_t NT) {
    for (size_t i = gtid; i < (size_t)1024 * 128 / 8; i += NT) {
        const int r = (int)(i >> 4), c0 = (int)(i & 15) * 8, t = (r >> 7) & 1, m = r & 127; float v[8];
#pragma unroll
        for (int e = 0; e < 8; ++e) { const int j = (m * (c0 + e)) & 127; const float x = (float)j * (1.0f / 64.0f); v[e] = t == 0 ? cospif(x) : sinpif(x); }
        u32x4 o; o.x = pk2(v[0], v[1]); o.y = pk2(v[2], v[3]); o.z = pk2(v[4], v[5]); o.w = pk2(v[6], v[7]);
        *(u32x4*)(CSBD + i * 8) = o;
    }
    for (size_t i = gtid; i < (size_t)2048 * 4096 / 8; i += NT) {
        const int rho = (int)(i >> 9), n0 = (int)(i & 511) * 8, h = (rho >> 7) & 1, k = (rho >> 8) * 128 + (rho & 127); float v[8];
#pragma unroll
        for (int e = 0; e < 8; ++e) { const int np = n0 + e, n = np & 2047, j = (k * n) & 2047; const float x = (float)j * (1.0f / 1024.0f); v[e] = (np < 2048) ? (h == 0 ? cospif(x) : 0.f) : (h == 1 ? sinpif(x) : 0.f); }
        u32x4 o; o.x = pk2(v[0], v[1]); o.y = pk2(v[2], v[3]); o.z = pk2(v[4], v[5]); o.w = pk2(v[6], v[7]);
        *(u32x4*)(DFTN + i * 8) = o;
    }
    for (size_t i = gtid; i < (size_t)256 * 512 / 8; i += NT) {
        const int k = (int)(i >> 6), n0 = (int)(i & 63) * 8; float v[8];
#pragma unroll
        for (int e = 0; e < 8; ++e) { const int np = n0 + e, n = np & 255, j = (k * n) & 255; const float x = (float)j * (1.0f / 128.0f); v[e] = np < 256 ? cospif(x) : -sinpif(x); }
        u32x4 o; o.x = pk2(v[0], v[1]); o.y = pk2(v[2], v[3]); o.z = pk2(v[4], v[5]); o.w = pk2(v[6], v[7]);
        *(u32x4*)(DFTC + i * 8) = o;
    }
    for (size_t i = gtid; i < (size_t)96 * 16; i += NT) {
        const int c = (int)(i >> 4), fi = (int)(i & 15), coord = c < 32 ? c : c - 32;
        const float inv = exp2f(-(float)fi * (13.287712379549449f / 16.0f));
        const float xr = ((float)coord * inv) * 0.3183098861837907f;
        ROPE[i] = (f32x2){cospif(xr), sinpif(xr)};
    }
}
__device__ __forceinline__ void p1_wsb(const float* __restrict__ w_s, bf16_t* __restrict__ WSB, size_t gtid, size_t NT) {
    for (size_t i = gtid; i < (size_t)DEPTH * 4 * 128 * 128 / 8; i += NT) { const f32x4 a = ((const f32x4*)w_s)[2 * i], b = ((const f32x4*)w_s)[2 * i + 1];
        u32x4 w; w.x = pk2(a.x, a.y); w.y = pk2(a.z, a.w); w.z = pk2(b.x, b.y); w.w = pk2(b.z, b.w); ((u32x4*)WSB)[i] = w; }
}
__device__ __forceinline__ void p1_mod(const float* __restrict__ modp, const float* __restrict__ b_ada, float* __restrict__ mod, size_t gtid, size_t NT) {
    for (size_t i = gtid; i < (size_t)DEPTH * 17 * MODW; i += NT) {
        const int l = (int)(i / (17 * MODW)), rn = (int)(i % (17 * MODW)), n = rn % MODW;
        float s = b_ada[l * MODW + n];
#pragma unroll
        for (int ks = 0; ks < 8; ++ks) s += modp[(size_t)(l * 8 + ks) * 17 * MODW + rn];
        mod[i] = s;
    }
}
__device__ __forceinline__ void unpack8v(const u32x4 w, f32x4& lo, f32x4& hi) {
    lo = (f32x4){__uint_as_float(w.x << 16), __uint_as_float(w.x & 0xffff0000u), __uint_as_float(w.y << 16), __uint_as_float(w.y & 0xffff0000u)};
    hi = (f32x4){__uint_as_float(w.z << 16), __uint_as_float(w.z & 0xffff0000u), __uint_as_float(w.w << 16), __uint_as_float(w.w & 0xffff0000u)};
}
__device__ __forceinline__ u32x4 pack8v(const f32x4 lo, const f32x4 hi) { u32x4 w; w.x = pk2(lo.x, lo.y); w.y = pk2(lo.z, lo.w); w.z = pk2(hi.x, hi.y); w.w = pk2(hi.z, hi.w); return w; }
template <bool XF32, bool HAS_DELTA, bool WRITE_X>
__device__ __forceinline__ void resnorm_rows(const void* __restrict__ xlat, const void* __restrict__ xctx, const bf16_t* __restrict__ DL, bf16_t* __restrict__ xout, const float* __restrict__ gvec,
                                             const float* __restrict__ modl, int shoff, int scoff, bf16_t* __restrict__ H, int r0, int r1, int lane) {
    int bcur = -1; f32x4 gm[8], sh[8];
    for (int row = r0; row < r1; ) {
        const int b = row < ML ? (row >> 11) : 16, bn = (row + 1) < ML ? ((row + 1) >> 11) : 16;
        const bool two = (row + 1 < r1) && (bn == b) && ((row + 1 == ML) == false);
        if (b != bcur) { bcur = b; const float* mrow = modl + (size_t)b * MODW;
#pragma unroll
            for (int j = 0; j < 8; ++j) { const int col = 8 * lane + 512 * (j >> 1) + 4 * (j & 1); gm[j] = *(const f32x4*)(gvec + col) * (*(const f32x4*)(mrow + scoff + col) + 1.0f); sh[j] = *(const f32x4*)(mrow + shoff + col); } }
        const size_t roff = (row < ML) ? (size_t)row * D : (size_t)(row - ML) * D;
        f32x4 va[8], vb[8];
        if (XF32) { const float* xa = (const float*)(row < ML ? xlat : xctx) + roff + 8 * lane; const float* xb = two ? xa + D : xa;
#pragma unroll
            for (int j = 0; j < 8; ++j) { const int o = 512 * (j >> 1) + 4 * (j & 1); va[j] = __builtin_nontemporal_load((const f32x4*)(xa + o)); vb[j] = __builtin_nontemporal_load((const f32x4*)(xb + o)); } }
        else { const bf16_t* xa = (const bf16_t*)(row < ML ? xlat : xctx) + roff + 8 * lane; const bf16_t* xb = two ? xa + D : xa; u32x4 wa[4], wb[4];
#pragma unroll
            for (int j = 0; j < 4; ++j) { wa[j] = __builtin_nontemporal_load((const u32x4*)(xa + 512 * j)); wb[j] = __builtin_nontemporal_load((const u32x4*)(xb + 512 * j)); }
#pragma unroll
            for (int j = 0; j < 4; ++j) { unpack8v(wa[j], va[2 * j], va[2 * j + 1]); unpack8v(wb[j], vb[2 * j], vb[2 * j + 1]); } }
        if (HAS_DELTA) { const bf16_t* da = DL + (size_t)row * D + 8 * lane; const bf16_t* db = two ? da + D : da; u32x4 wa[4], wb[4];
#pragma unroll
            for (int j = 0; j < 4; ++j) { wa[j] = __builtin_nontemporal_load((const u32x4*)(da + 512 * j)); wb[j] = __builtin_nontemporal_load((const u32x4*)(db + 512 * j)); }
#pragma unroll
            for (int j = 0; j < 4; ++j) { f32x4 l0, h0, l1, h1; unpack8v(wa[j], l0, h0); unpack8v(wb[j], l1, h1);
                va[2 * j] = va[2 * j] + l0; va[2 * j + 1] = va[2 * j + 1] + h0; vb[2 * j] = vb[2 * j] + l1; vb[2 * j + 1] = vb[2 * j + 1] + h1; } }
        float sa = 0.f, sb = 0.f;
#pragma unroll
        for (int j = 0; j < 8; ++j) { sa += (va[j].x * va[j].x + va[j].y * va[j].y) + (va[j].z * va[j].z + va[j].w * va[j].w); sb += (vb[j].x * vb[j].x + vb[j].y * vb[j].y) + (vb[j].z * vb[j].z + vb[j].w * vb[j].w); }
#pragma unroll
        for (int o = 1; o < 64; o <<= 1) { sa += __shfl_xor(sa, o); sb += __shfl_xor(sb, o); }
        const float ra = 1.0f / sqrtf(sa * (1.0f / D) + EPS), rb = 1.0f / sqrtf(sb * (1.0f / D) + EPS);
        if (WRITE_X) { bf16_t* oa = xout + (size_t)row * D + 8 * lane;
#pragma unroll
            for (int j = 0; j < 4; ++j) { __builtin_nontemporal_store(pack8v(va[2 * j], va[2 * j + 1]), (u32x4*)(oa + 512 * j)); if (two) __builtin_nontemporal_store(pack8v(vb[2 * j], vb[2 * j + 1]), (u32x4*)(oa + D + 512 * j)); } }
        bf16_t* ha = H + (size_t)row * D + 8 * lane;
#pragma unroll
        for (int j = 0; j < 4; ++j) {
            *(u32x4*)(ha + 512 * j) = pack8v((va[2 * j] * ra) * gm[2 * j] + sh[2 * j], (va[2 * j + 1] * ra) * gm[2 * j + 1] + sh[2 * j + 1]);
            if (two) *(u32x4*)(ha + D + 512 * j) = pack8v((vb[2 * j] * rb) * gm[2 * j] + sh[2 * j], (vb[2 * j + 1] * rb) * gm[2 * j + 1] + sh[2 * j + 1]); }
        row += two ? 2 : 1;
    }
}
__device__ __forceinline__ void final_rows(const bf16_t* __restrict__ xs, const float* __restrict__ gvec, float* __restrict__ out, int gw, int NGW, int lane) {
    const int rpw = (ML + NGW - 1) / NGW, r0 = gw * rpw, r1 = (r0 + rpw < ML) ? r0 + rpw : ML;
    f32x4 g4[8];
#pragma unroll
    for (int j = 0; j < 8; ++j) g4[j] = *(const f32x4*)(gvec + 8 * lane + 512 * (j >> 1) + 4 * (j & 1));
    for (int row = r0; row < r1; ++row) {
        const bf16_t* xa = xs + (size_t)row * D + 8 * lane;
        u32x4 wx[4]; f32x4 v[8]; float ss = 0.f;
#pragma unroll
        for (int j = 0; j < 4; ++j) wx[j] = __builtin_nontemporal_load((const u32x4*)(xa + 512 * j));
#pragma unroll
        for (int j = 0; j < 4; ++j) unpack8v(wx[j], v[2 * j], v[2 * j + 1]);
#pragma unroll
        for (int j = 0; j < 8; ++j) ss += (v[j].x * v[j].x + v[j].y * v[j].y) + (v[j].z * v[j].z + v[j].w * v[j].w);
        const float rstd = 1.0f / sqrtf(wave_sum(ss) * (1.0f / D) + EPS);
        float* oa = out + (size_t)row * D + 8 * lane;
#pragma unroll
        for (int j = 0; j < 8; ++j) __builtin_nontemporal_store((v[j] * rstd) * g4[j], (f32x4*)(oa + 512 * (j >> 1) + 4 * (j & 1)));
    }
}
__device__ __forceinline__ void four_nyquist_rows(const bf16_t* __restrict__ TT, bf16_t* __restrict__ Y, int gw, int NGW, int lane) {
    for (int it = gw; it < NBATCH * 512; it += NGW) {
        const bf16_t* tr = TT + (size_t)it * 4096 + 8 * lane; float s = 0.f;
#pragma unroll
        for (int j = 0; j < 4; ++j) { float v[8]; unpack8(*(const u32x4*)(tr + 512 * j), v); s += ((v[0] - v[1]) + (v[2] - v[3])) + ((v[4] - v[5]) + (v[6] - v[7])); }
        s = wave_sum(s);
        if (lane == 0) Y[(size_t)((it >> 9) * 2048 + 1024) * D + 512 + (it & 511)] = (bf16_t)f2bf(s * (1.0f / 512.0f));
    }
}
__device__ __forceinline__ void mix_conv(const bf16_t* __restrict__ P, const float* __restrict__ wc  , bf16_t* __restrict__ Y, int nrows, size_t gtid, size_t NT) {
    const int R = (nrows * 64 + (int)NT - 1) / (int)NT > 0 ? (nrows + (int)(NT >> 6) - 1) / (int)(NT >> 6) : 1;
    const int run = (int)(gtid >> 6), c0 = (int)(gtid & 63) * 8;
    float w0[8], w1[8], w2[8];
#pragma unroll
    for (int e = 0; e < 8; ++e) { w0[e] = wc[c0 + e]; w1[e] = wc[512 + c0 + e]; w2[e] = wc[1024 + c0 + e]; }
    const int rbeg = run * R, rend = (rbeg + R < nrows) ? rbeg + R : nrows;
    for (int rb = rbeg; rb < rend; rb += 6) {
        u32x4 xr[8], br[6]; bool ok[8];
#pragma unroll
        for (int i = 0; i < 8; ++i) { const int row = rb - 1 + i;
            int n, L; if (row < ML) { n = row & 2047; L = 2048; } else { n = (row - ML) & 255; L = 256; }
            ok[i] = row >= 0 && row < nrows; (void)n; (void)L;
            const bf16_t* pr = P + (size_t)(ok[i] ? row : 0) * NPROJ;
            xr[i] = *(const u32x4*)(pr + OFF_Z + c0); }
#pragma unroll
        for (int i = 0; i < 6; ++i) { const int row = rb + i; br[i] = *(const u32x4*)(P + (size_t)(row < nrows ? row : 0) * NPROJ + OFF_AB + c0); }
        float z[8][8];
#pragma unroll
        for (int i = 0; i < 8; ++i) unpack8(xr[i], z[i]);
#pragma unroll
        for (int i = 0; i < 6; ++i) { const int row = rb + i; if (row < rend) {
            int n, L; if (row < ML) { n = row & 2047; L = 2048; } else { n = (row - ML) & 255; L = 256; }
            const float pm = n > 0 ? 1.f : 0.f, nm = n < L - 1 ? 1.f : 0.f;
            float gb[8], o[8]; unpack8(br[i], gb);
#pragma unroll
            for (int e = 0; e < 8; ++e) o[e] = gb[e] * ((pm * z[i][e]) * w0[e] + z[i + 1][e] * w1[e] + (nm * z[i + 2][e]) * w2[e]);
            u32x4 w; w.x = pk2(o[0], o[1]); w.y = pk2(o[2], o[3]); w.z = pk2(o[4], o[5]); w.w = pk2(o[6], o[7]);
            *(u32x4*)(Y + (size_t)row * D + c0) = w; } }
    }
}
typedef short bf16x8_t __attribute__((ext_vector_type(8)));
typedef short bf16x4_t __attribute__((ext_vector_type(4)));
constexpr int ATT_KLD = 72, ATT_VLD = 80  , ATT_KS = 0, ATT_VT = 128 * ATT_KLD * 2, ATT_BUF = ATT_VT + 128 * ATT_VLD * 2;
__device__ __forceinline__ void attn_item(const bf16_t* __restrict__ P, bf16_t* __restrict__ Y, const float* __restrict__ sinkl, int b, int kvh, int qb, bool isctx, LAS unsigned char* lds, int tid) {
    const int lane = tid & 63, wave = __builtin_amdgcn_readfirstlane(tid >> 6), fr = lane & 15, fq = lane >> 4;
    const int g = wave >> 1, h = kvh * 4 + g, p0 = qb * 128 + (wave & 1) * 64;
    const float L2E = 1.4426950408889634f, QS = 0.125f * L2E;
    const int t_hi = (qb == 15) ? 2 : 3;
    int t = isctx ? 3 : ((qb == 0) ? 1 : 0), buf = 0;
    const int sj = tid >> 3, part = tid & 7;
    u32x4 pv0, pv1, pk0, pk1;
#define ATT_PF(tt) do { const bool loc_ = (tt) < 3; const int k0_ = loc_ ? (qb - 1) * 128 + (tt) * 128 : ((tt) - 3) * 128; \
        const bf16_t* r_ = P + (loc_ ? (size_t)b * 2048 + k0_ + sj : (size_t)ML + b * 256 + k0_ + sj) * NPROJ + kvh * 64 + part * 8; \
        pk0 = *(const u32x4*)(r_ + OFF_K); pv0 = *(const u32x4*)(r_ + OFF_V); pk1 = *(const u32x4*)(r_ + (size_t)64 * NPROJ + OFF_K); pv1 = *(const u32x4*)(r_ + (size_t)64 * NPROJ + OFF_V); } while (0)
    ATT_PF(t);
    bf16x8_t Qf[4][2];
#pragma unroll
    for (int qblk = 0; qblk < 4; ++qblk) {
        const int qpos = p0 + qblk * 16 + fr;
        const size_t rowq = isctx ? (size_t)ML + b * 256 + qpos : (size_t)b * 2048 + qpos;
        const bf16_t* qp = P + rowq * NPROJ + OFF_Q + h * 64;
#pragma unroll
        for (int s = 0; s < 2; ++s) Qf[qblk][s] = *(const bf16x8_t*)(qp + 32 * s + 8 * fq);
    }
    f32x4 O[4][4]; float mrun[4], lsum[4];
    const float sk = sinkl[h] * L2E;
#pragma unroll
    for (int qblk = 0; qblk < 4; ++qblk) { mrun[qblk] = sk; lsum[qblk] = fq == 0 ? 1.0f : 0.0f;
#pragma unroll
        for (int db = 0; db < 4; ++db) O[qblk][db] = (f32x4){0.f, 0.f, 0.f, 0.f}; }
#pragma unroll 1
    for (;;) {
        const bool local = t < 3; const int k0 = local ? (qb - 1) * 128 + t * 128 : (t - 3) * 128;
        LAS bf16_t* Ks = (LAS bf16_t*)(lds + ATT_KS + buf * ATT_BUF); LAS bf16_t* Vt = (LAS bf16_t*)(lds + ATT_VT + buf * ATT_BUF);
        { *(LAS u32x4*)(Ks + sj * ATT_KLD + part * 8) = pk0; *(LAS u32x4*)(Ks + (sj + 64) * ATT_KLD + part * 8) = pk1;
          *(LAS u32x4*)(Vt + sj * ATT_VLD + part * 8) = pv0; *(LAS u32x4*)(Vt + (sj + 64) * ATT_VLD + part * 8) = pv1;
        }
        __syncthreads();
        const int tn = (t + 1 == t_hi) ? 3 : t + 1;
        if (tn < 5) ATT_PF(tn);
#pragma unroll 1
        for (int kb = 0; kb < 128; kb += 32) {
            const int kmin = k0 + kb;
            if (local && (kmin + 31 < p0 - 128 || kmin > p0 + 63 + 128)) continue;
            bf16x8_t Kf[2][2];
#pragma unroll
            for (int blk = 0; blk < 2; ++blk)
#pragma unroll
                for (int s = 0; s < 2; ++s) Kf[blk][s] = *(const LAS bf16x8_t*)(Ks + (kb + 16 * blk + fr) * ATT_KLD + 32 * s + 8 * fq);
            bf16x8_t Vf[4];
            int vlane = (4 * fq + (fr >> 2)) * ATT_VLD + 4 * (fr & 3); asm volatile("" : "+v"(vlane));
#pragma unroll
            for (int db = 0; db < 4; ++db) {
                const LAS bf16_t* vp = Vt + kb * ATT_VLD + vlane + 16 * db;
                const bf16x4_t lo = __builtin_amdgcn_ds_read_tr16_b64_v4i16((LAS bf16x4_t*)vp), hi = __builtin_amdgcn_ds_read_tr16_b64_v4i16((LAS bf16x4_t*)(vp + 16 * ATT_VLD));
                Vf[db] = __builtin_shufflevector(lo, hi, 0, 1, 2, 3, 4, 5, 6, 7); }
            const bool needmask = local && ((kmin + 31) - p0 > 128 || (p0 + 63) - kmin > 128);
            float sv[4][8], lm[4]; bool grow = false;
#pragma unroll
            for (int qblk = 0; qblk < 4; ++qblk) {
                f32x4 S0 = (f32x4){0.f, 0.f, 0.f, 0.f}, S1 = S0;
                S0 = __builtin_amdgcn_mfma_f32_16x16x32_bf16(Kf[0][0], Qf[qblk][0], S0, 0, 0, 0); S0 = __builtin_amdgcn_mfma_f32_16x16x32_bf16(Kf[0][1], Qf[qblk][1], S0, 0, 0, 0);
                S1 = __builtin_amdgcn_mfma_f32_16x16x32_bf16(Kf[1][0], Qf[qblk][0], S1, 0, 0, 0); S1 = __builtin_amdgcn_mfma_f32_16x16x32_bf16(Kf[1][1], Qf[qblk][1], S1, 0, 0, 0);
#pragma unroll
                for (int r = 0; r < 4; ++r) { sv[qblk][r] = S0[r]; sv[qblk][4 + r] = S1[r]; }
                if (needmask) { const int qpos = p0 + qblk * 16 + fr;
#pragma unroll
                    for (int r = 0; r < 4; ++r) { int d0 = qpos - (kmin + 4 * fq + r); d0 = d0 < 0 ? -d0 : d0; int d1 = qpos - (kmin + 16 + 4 * fq + r); d1 = d1 < 0 ? -d1 : d1;
                        sv[qblk][r] = d0 <= 128 ? sv[qblk][r] : -__builtin_inff(); sv[qblk][4 + r] = d1 <= 128 ? sv[qblk][4 + r] : -__builtin_inff(); } }
                lm[qblk] = fmaxf(fmaxf(fmaxf(sv[qblk][0], sv[qblk][1]), fmaxf(sv[qblk][2], sv[qblk][3])), fmaxf(fmaxf(sv[qblk][4], sv[qblk][5]), fmaxf(sv[qblk][6], sv[qblk][7]))) * QS;
                grow = grow || (lm[qblk] > mrun[qblk] + 8.0f);
            }
            if (__any(grow)) {
#pragma unroll
                for (int qblk = 0; qblk < 4; ++qblk) { float cm = lm[qblk];
                    { const u32x2 r16 = __builtin_amdgcn_permlane16_swap(__float_as_uint(cm), __float_as_uint(cm), false, false); cm = fmaxf(__uint_as_float(r16.x), __uint_as_float(r16.y));
                      const u32x2 r32 = __builtin_amdgcn_permlane32_swap(__float_as_uint(cm), __float_as_uint(cm), false, false); cm = fmaxf(__uint_as_float(r32.x), __uint_as_float(r32.y)); }
                    const float mnew = fmaxf(mrun[qblk], cm), sc = __builtin_amdgcn_exp2f(mrun[qblk] - mnew);
                    lsum[qblk] *= sc; mrun[qblk] = mnew;
#pragma unroll
                    for (int db = 0; db < 4; ++db) O[qblk][db] = O[qblk][db] * sc; }
            }
#pragma unroll
            for (int qblk = 0; qblk < 4; ++qblk) {
                float pp[8], ps = 0.f;
#pragma unroll
                for (int r = 0; r < 8; ++r) { pp[r] = __builtin_amdgcn_exp2f(__builtin_fmaf(sv[qblk][r], QS, -mrun[qblk])); ps += pp[r]; }
                lsum[qblk] += ps;
                u32x4 pw; pw.x = pk2(pp[0], pp[1]); pw.y = pk2(pp[2], pp[3]); pw.z = pk2(pp[4], pp[5]); pw.w = pk2(pp[6], pp[7]);
                const bf16x8_t Pf = __builtin_bit_cast(bf16x8_t, pw);
#pragma unroll
                for (int db = 0; db < 4; ++db) O[qblk][db] = __builtin_amdgcn_mfma_f32_16x16x32_bf16(Vf[db], Pf, O[qblk][db], 0, 0, 0);
            }
        }
        if (tn >= 5) break;
        t = tn; buf ^= 1;
    }
#undef ATT_PF
#pragma unroll
    for (int qblk = 0; qblk < 4; ++qblk) {
        float l = lsum[qblk]; l += __shfl_xor(l, 16); l += __shfl_xor(l, 32);
        const float rl = 1.0f / l;
        const int qpos = p0 + qblk * 16 + fr;
        const size_t rowq = isctx ? (size_t)ML + b * 256 + qpos : (size_t)b * 2048 + qpos;
        bf16_t* yp = Y + rowq * D + 1024 + h * 64 + 4 * fq;
#pragma unroll
        for (int db = 0; db < 4; ++db) { const f32x4 o = O[qblk][db] * rl; u32x2 w; w.x = pk2(o[0], o[1]); w.y = pk2(o[2], o[3]); *(u32x2*)(yp + 16 * db) = w; }
    }
}
__device__ __forceinline__ void mix_attn(const bf16_t* P, bf16_t* Y, const float* sinkl, int nitems, LAS unsigned char* lds, int vcu, int G, int tid) {
    for (int it = (G == 256) ? ((vcu + 192) & 255) : vcu; it < nitems; it += G) {

        if (it < 512) { const int b = it >> 5, kvh = (it >> 4) & 1, qb = it & 15; attn_item(P, Y, sinkl, b, kvh, qb, false, lds, tid); }
        else { const int r = it - 512, b = r >> 2, kvh = (r >> 1) & 1, qb = r & 1; attn_item(P, Y, sinkl, b, kvh, qb, true, lds, tid); }
        __syncthreads();
    }
    __syncthreads();
}
constexpr int MLP_LD = 136, MLP_BUF = 128 * MLP_LD * 2;
__device__ __forceinline__ void mix_mlp(const bf16_t* __restrict__ P, const bf16_t* __restrict__ WSB  , const float* __restrict__ b_s  , bf16_t* __restrict__ Y, int nrows, LAS unsigned char* lds, int vcu, int G, int tid) {
    const int lane = tid & 63, wave = __builtin_amdgcn_readfirstlane(tid >> 6), fr = lane & 15, fq = lane >> 4;
    const int nitems = (nrows / 128) * 4, q = tid >> 2, cp = tid & 3;
    u32x4 vr[4]; int buf = 0;
#define MLP_PF(itt) do { const bf16_t* pr_ = P + ((size_t)((itt) >> 2) * 128 + q) * NPROJ + OFF_MV + ((itt) & 3) * 128 + cp * 32; \
        _Pragma("unroll") for (int j_ = 0; j_ < 4; ++j_) vr[j_] = *(const u32x4*)(pr_ + 8 * j_); } while (0)
    int it = (G == 256) ? ((vcu + 128) & 255) : vcu;
    if (it < nitems) MLP_PF(it);
    for (; it < nitems; it += G) {
        const int ch = it >> 2, g = it & 3; const size_t row0 = (size_t)ch * 128;
        LAS bf16_t* VnT = (LAS bf16_t*)(lds + buf * MLP_BUF);
        { float vv[32];
#pragma unroll
          for (int j = 0; j < 4; ++j) unpack8(vr[j], vv + 8 * j);
          float s1 = 0.f;
#pragma unroll
          for (int i = 0; i < 32; ++i) { vv[i] = gelu_tanh(vv[i]); s1 += vv[i]; }
          s1 += __shfl_xor(s1, 1); s1 += __shfl_xor(s1, 2);
          const float mean = s1 * (1.0f / 128.0f); float qq = 0.f;
#pragma unroll
          for (int i = 0; i < 32; ++i) { vv[i] -= mean; qq += vv[i] * vv[i]; }
          qq += __shfl_xor(qq, 1); qq += __shfl_xor(qq, 2);
          const float rstd = 1.0f / sqrtf(qq * (1.0f / 128.0f) + EPS);
#pragma unroll
          for (int i = 0; i < 32; ++i) VnT[(cp * 32 + i) * MLP_LD + q] = (bf16_t)f2bf(vv[i] * rstd); }
        __syncthreads();
        if (it + G < nitems) MLP_PF(it + G);
        const int p = 16 * wave + fr;
        bf16x8_t Wf[4];
#pragma unroll
        for (int ks = 0; ks < 4; ++ks) Wf[ks] = *(const bf16x8_t*)(WSB + ((size_t)g * 128 + p) * 128 + 32 * ks + 8 * fq);
        const float bias = b_s[g * 128 + p];
        const bf16_t* ur = P + (row0 + p) * NPROJ + OFF_U + g * 128 + 4 * fq;
        bf16_t* yr = Y + (row0 + p) * D + 1536 + g * 128 + 4 * fq;
        u32x2 uw[8];
#pragma unroll
        for (int cb = 0; cb < 8; ++cb) uw[cb] = *(const u32x2*)(ur + 16 * cb);
#pragma unroll
        for (int cb = 0; cb < 8; ++cb) {
            f32x4 acc = (f32x4){0.f, 0.f, 0.f, 0.f};
#pragma unroll
            for (int ks = 0; ks < 4; ++ks) { const bf16x8_t Vf = *(const LAS bf16x8_t*)(VnT + (16 * cb + fr) * MLP_LD + 32 * ks + 8 * fq);
                acc = __builtin_amdgcn_mfma_f32_16x16x32_bf16(Vf, Wf[ks], acc, 0, 0, 0); }
            const float u0 = gelu_tanh(__uint_as_float(uw[cb].x << 16)), u1 = gelu_tanh(__uint_as_float(uw[cb].x & 0xffff0000u)), u2 = gelu_tanh(__uint_as_float(uw[cb].y << 16)), u3 = gelu_tanh(__uint_as_float(uw[cb].y & 0xffff0000u));
            u32x2 w; w.x = pk2(u0 * (acc[0] + bias), u1 * (acc[1] + bias)); w.y = pk2(u2 * (acc[2] + bias), u3 * (acc[3] + bias));
            *(u32x2*)(yr + 16 * cb) = w;
        }
        buf ^= 1;
    }
#undef MLP_PF
    __syncthreads();
}
constexpr int PH_LAYER0 = 2, PH_PER_LAYER = 10, PH_FINAL = PH_LAYER0 + DEPTH * PH_PER_LAYER, NPH = PH_FINAL + 1;
#ifndef PROBE_DUP
#define PROBE_DUP 0
#endif
#ifndef STAGGER_TICKS
#define STAGGER_TICKS 150
#endif
#ifndef MK_ONE_LAUNCH
#define MK_ONE_LAUNCH 1
#endif
struct Args { const float* in[18]; float* out; unsigned char* ws; int ph_lo, ph_hi, use_bar, pad; };
__global__ void __launch_bounds__(NTHREADS, 2) fwd(Args a) {
    extern __shared__ __attribute__((aligned(16))) unsigned char lds_raw[];
    LAS unsigned char* lds = (LAS unsigned char*)lds_raw;
    volatile LAS unsigned* MISC = (volatile LAS unsigned*)(lds + MISC_OFF);
    const int G = gridDim.x, bx = blockIdx.x, vcu = (G % 8 == 0) ? (bx % 8) * (G / 8) + bx / 8 : bx;
    const int NGW = G * NWAVES; const size_t NT = (size_t)G * NTHREADS;
#define TID_VARS int tid = threadIdx.x; asm volatile("" : "+v"(tid)); const int lane = tid & 63, wave = __builtin_amdgcn_readfirstlane(tid >> 6), gw = vcu * NWAVES + wave; const size_t gtid = (size_t)vcu * NTHREADS + tid; (void)lane; (void)gw; (void)gtid
    unsigned* ctl = (unsigned*)(a.ws + WS_CTL);
    for (int u = threadIdx.x; u < (LDS_BYTES - LDSCTL_OFF) / 4; u += NTHREADS) ((LAS unsigned*)(lds + LDSCTL_OFF))[u] = 0u;
    __syncthreads();
    XcdBarrier bar; bar.bar = ctl + CW_BAR; bar.x = 0; bar.st = nullptr;
    if (a.use_bar) bar = xcd_barrier_post(ctl + CW_BAR, MISC + 8);
    const int lo = a.ph_lo, hi = a.ph_hi;
#define IN(k) (lo <= (k) && (k) < hi)
#define SEAM(k) do { if (IN(k) && IN((k) + 1)) xcd_barrier(bar); } while (0)
#define STAGGER() do { if (STAGGER_TICKS) { const unsigned long long t0_ = __builtin_amdgcn_s_memrealtime(), w_ = (unsigned long long)(bx >> 5) * STAGGER_TICKS; while (__builtin_amdgcn_s_memrealtime() - t0_ < w_) __builtin_amdgcn_s_sleep(4); } } while (0)
#define REP(bit) for (int rep_ = 0; rep_ < (((PROBE_DUP) >> (bit)) & 1) + 1; ++rep_)
#define REPBAR() do { if (rep_ == 0 && a.use_bar && PROBE_DUP) xcd_barrier(bar); } while (0)
#define ARG_VARS const __attribute__((address_space(4))) Args* ap_ = (const __attribute__((address_space(4))) Args*)__builtin_amdgcn_kernarg_segment_ptr(); asm volatile("" : "+s"(ap_)); \
    unsigned char* const ws = ap_->ws; \
    const float* const x = ap_->in[0]; const float* const cvec = ap_->in[1]; const float* const ctx = ap_->in[2]; const float* const c_ctx = ap_->in[3]; const float* const w_ada = ap_->in[4]; const float* const b_ada = ap_->in[5]; \
    const float* const g_norm1 = ap_->in[6]; const float* const w_in = ap_->in[7]; const float* const w_conv = ap_->in[8]; const float* const sink = ap_->in[9]; const float* const w_s = ap_->in[10]; const float* const b_s = ap_->in[11]; \
    const float* const w_out = ap_->in[12]; const float* const g_norm2 = ap_->in[13]; const float* const w_gate = ap_->in[14]; const float* const w_up = ap_->in[15]; const float* const w_down = ap_->in[16]; const float* const g_final = ap_->in[17]; \
    bf16_t* const WIN = (bf16_t*)(ws + WS_WIN); bf16_t* const WOUT = (bf16_t*)(ws + WS_WOUT); bf16_t* const WGU = (bf16_t*)(ws + WS_WGU); bf16_t* const WDN = (bf16_t*)(ws + WS_WDN); \
    float* const MOD = (float*)(ws + WS_MOD); float* const MODP = (float*)(ws + WS_MODP); bf16_t* const XS = (bf16_t*)(ws + WS_XS); \
    bf16_t* const H = (bf16_t*)(ws + WS_H); bf16_t* const P = (bf16_t*)(ws + WS_P); bf16_t* const Y = (bf16_t*)(ws + WS_Y); bf16_t* const HF = (bf16_t*)(ws + WS_HF); \
    bf16_t* const TT = (bf16_t*)(ws + WS_TT); bf16_t* const TTC = (bf16_t*)(ws + WS_TTC); bf16_t* const DFTN = (bf16_t*)(ws + WS_DFTN); bf16_t* const DFTC = (bf16_t*)(ws + WS_DFTC); \
    f32x2* const ROPE = (f32x2*)(ws + WS_ROPE); bf16_t* const CSBD = (bf16_t*)(ws + WS_CSBD); bf16_t* const DL = (bf16_t*)(ws + WS_DL); bf16_t* const WSB = (bf16_t*)(ws + WS_WSB); \
    const float* const modl = MOD + (size_t)l * 17 * MODW; \
    (void)x; (void)cvec; (void)ctx; (void)c_ctx; (void)w_ada; (void)b_ada; (void)g_norm1; (void)w_in; (void)w_conv; (void)sink; (void)w_s; (void)b_s; (void)w_out; (void)g_norm2; (void)w_gate; (void)w_up; (void)w_down; (void)g_final; \
    (void)WIN; (void)WOUT; (void)WGU; (void)WDN; (void)MOD; (void)MODP; (void)XS; (void)H; (void)P; (void)Y; (void)HF; (void)TT; (void)TTC; (void)DFTN; (void)DFTC; (void)ROPE; (void)CSBD; (void)DL; (void)WSB; (void)modl

    REP(14) { if (rep_) xcd_barrier(bar);
    if (IN(0)) { const int l = 0; ARG_VARS; TID_VARS;
        LAS float* scr = (LAS float*)(lds + wave * 17408);
        p0_modp(cvec, c_ctx, w_ada, MODP, scr, gw, NGW, lane);
        p0_transposes(w_in, w_out, WIN, WOUT, scr, gw, NGW, lane);
        p0_tables(DFTN, DFTC, CSBD, ROPE, gtid, NT);
        SEAM(0);
    }
    if (IN(1)) { const int l = 0; ARG_VARS; TID_VARS; p1_mod(MODP, b_ada, MOD, gtid, NT); p1_wsb(w_s, WSB, gtid, NT); SEAM(1); } }

#define PASS_RANGE_LAT(ra) const int rw_ = (G == 256) ? ((bx < 128) ? (ra) : 256 - (ra)) : 0; \
        const int r0 = (G == 256) ? (((bx < 128) ? bx * (ra) : 128 * (ra) + (bx - 128) * (256 - (ra))) + wave * (rw_ >> 3)) : gw * ((ML + NGW - 1) / NGW); \
        const int r1 = (G == 256) ? r0 + (rw_ >> 3) : ((r0 + (ML + NGW - 1) / NGW < ML) ? r0 + (ML + NGW - 1) / NGW : ML)
#define PASS_RANGE_CTX() const int cr_ = (MC + NGW - 1) / NGW, r0 = ML + gw * cr_, r1 = (r0 + cr_ < MT) ? r0 + cr_ : MT
    for (int l = 0; l < DEPTH; ++l) {
        const int pb = PH_LAYER0 + l * PH_PER_LAYER;
        const bool lastl = (l == DEPTH - 1);
        const int Mrows = lastl ? ML : MT;
        if (IN(pb + 0)) { ARG_VARS;
            if (l == 0) { TID_VARS; const int rpw = (MT + NGW - 1) / NGW, r0 = gw * rpw, r1 = (r0 + rpw < MT) ? r0 + rpw : MT;
                resnorm_rows<true, false, true>(x, ctx, nullptr, XS, g_norm1, modl, 0, D, H, r0, r1, lane); }
            else {
                { pg8::Gemm g{HF + (size_t)ML * DFF, WDN + (size_t)(l - 1) * D * DFF, MC, D, DFF, DFF, DFF}; pg8::StaticOrder S; S.init(MC, D, G, bx);
                  pg8::EpiRes E{XS, modl - (size_t)17 * MODW, 5 * D, 128};
                  pg8::gemm_phase<pg8::EpiRes, pg8::StaticOrder, true, true>(lds, g, S, E); }
                TID_VARS; PASS_RANGE_LAT(0);
                resnorm_rows<false, false, false>(XS, XS, nullptr, nullptr, g_norm1 + l * D, modl, 0, D, H, r0, r1, lane);
                if (G != 256 || bx >= 128) { const int sw = (G == 256) ? (bx - 128) * NWAVES + wave : gw, nsw = (G == 256) ? 128 * NWAVES : NGW; LAS float* scr = (LAS float*)(lds + wave * 17408);
                    if (l == 1) tr_wout123(w_out, WOUT, scr, sw, nsw, lane);
                    else if (l == 2) tr_down(w_down + (size_t)3 * DFF * D, WDN + (size_t)3 * D * DFF, scr, sw, nsw, lane);
                    else tr_gateup(w_gate + (size_t)l * D * DFF, w_up + (size_t)l * D * DFF, WGU + (size_t)l * NGU * D, scr, sw, nsw, lane, 0, (G == 256) ? TR_G : 2 * TR_G); } }
            SEAM(pb + 0); }
        if (IN(pb + 1)) { ARG_VARS; if (l > 0) { TID_VARS; PASS_RANGE_CTX();
                resnorm_rows<false, false, false>(XS, XS + (size_t)ML * D, nullptr, nullptr, g_norm1 + l * D, modl, 0, D, H, r0, r1, lane); }
            if (l > 0) SEAM(pb + 1); }
        REP(2) { if (rep_) xcd_barrier(bar);
        if (IN(pb + 2)) { ARG_VARS;
            pg8::Gemm g{H, WIN + (size_t)l * NPROJ * D, Mrows, NPROJ, D, D, D}; pg8::OrderIn S; S.init(Mrows, NPROJ, G, bx); S.extra = lastl ? 16 : 0;
            { int tt_ = threadIdx.x; asm volatile("" : "+v"(tt_)); for (int i = tt_; i < 96 * 16 * 2 / 4; i += NTHREADS) ((LAS f32x4*)(lds + ROPE_LDS_OFF))[i] = ((const f32x4*)ROPE)[i]; }
            pg8::EpiP E{P, NPROJ, (const LAS float*)(lds + ROPE_LDS_OFF)};
            pg8::gemm_phase<pg8::EpiP, pg8::OrderIn, true, true>(lds, g, S, E);
            if (!lastl) { const int rem = ((Mrows / 256) * 15) % G;
              if (rem != 0 && bx >= rem) { TID_VARS; tr_gateup(w_gate + (size_t)l * D * DFF, w_up + (size_t)l * D * DFF, WGU + (size_t)l * NGU * D, (LAS float*)(lds + wave * 17408), (bx - rem) * NWAVES + wave, (G - rem) * NWAVES, lane); }
              else if (rem == 0) { TID_VARS; tr_gateup(w_gate + (size_t)l * D * DFF, w_up + (size_t)l * D * DFF, WGU + (size_t)l * NGU * D, (LAS float*)(lds + wave * 17408), gw, NGW, lane); }
            }
            if (lastl && G == 256) { const int rem = ((Mrows / 256) * 15 + 16) % G;
              if (bx >= rem) { TID_VARS; tr_gateup(w_gate + (size_t)l * D * DFF, w_up + (size_t)l * D * DFF, WGU + (size_t)l * NGU * D, (LAS float*)(lds + wave * 17408), (bx - rem) * NWAVES + wave, (G - rem) * NWAVES, lane, TR_G, 2 * TR_G); }
            }
            SEAM(pb + 2);
        } }
        REP(3) { if (rep_) xcd_barrier(bar);
        if (IN(pb + 3)) { ARG_VARS;
            REP(16) { int kf = 128; asm volatile("" : "+s"(kf));
              pg8::Gemm g{CSBD, P + OFF_F, 1024, Mrows, kf, 128, NPROJ}; pg8::OrderFour1 S; S.init(Mrows / 256, G, bx);
              pg8::EpiFour1 E{TT, TTC};
              pg8::gemm_phase<pg8::EpiFour1, pg8::OrderFour1, true, true>(lds, g, S, E); }
            TID_VARS;
            const bool conv_last = ((bx >> 3) & 1) != 0;
            if (!conv_last) { REP(17) mix_conv(P, w_conv + (size_t)l * 3 * 512, Y, Mrows, gtid, NT); }
            REP(18) mix_attn(P, Y, sink + l * 8, lastl ? 512 : 576, lds, bx, G, tid);
            REP(19) mix_mlp(P, WSB + (size_t)l * 4 * 128 * 128, b_s + (size_t)l * 4 * 128, Y, Mrows, lds, bx, G, tid);
            if (conv_last) { REP(17) mix_conv(P, w_conv + (size_t)l * 3 * 512, Y, Mrows, gtid, NT); }
            SEAM(pb + 3);
        } }
        REP(4) { if (rep_) xcd_barrier(bar);
        if (IN(pb + 4)) { ARG_VARS;
            { pg8::Gemm g{DFTN, TT, 2048, 8192, 4096, 4096, 4096}; pg8::StaticOrder S; S.init(2048, 8192, G, bx);
              pg8::EpiFourEO E{Y, 1.0f / 512.0f};
              pg8::gemm_phase<pg8::EpiFourEO, pg8::StaticOrder, true, true, true>(lds, g, S, E); }
            { TID_VARS; four_nyquist_rows(TT, Y, gw, NGW, lane); }
            if (!lastl) { pg8::Gemm g{DFTC, TTC, 256, 8192, 512, 512, 512}; pg8::StaticOrder S; S.init(256, 8192, G, bx);
              pg8::EpiFour E{Y, 0.005524271728019903f  , ML, 256};
              pg8::gemm_phase<pg8::EpiFour, pg8::StaticOrder, true, true>(lds, g, S, E); }
            if (!lastl && bx >= 32 && G > 32) { TID_VARS;
                tr_down(w_down + (size_t)l * DFF * D, WDN + (size_t)l * D * DFF, (LAS float*)(lds + wave * 17408), (bx - 32) * NWAVES + wave, (G - 32) * NWAVES, lane); }
            else if (!lastl && G <= 32) { TID_VARS; tr_down(w_down + (size_t)l * DFF * D, WDN + (size_t)l * D * DFF, (LAS float*)(lds + wave * 17408), gw, NGW, lane); }
            SEAM(pb + 4);
        } }
        REP(5) { if (rep_) xcd_barrier(bar);
        if (IN(pb + 5)) { ARG_VARS;
            pg8::Gemm g{Y, WOUT + (size_t)l * D * D, ML, D, D, D, D}; pg8::StaticOrder S; S.init(ML, D, G, bx);
            pg8::EpiRes E{XS, modl, 2 * D, 0};
            pg8::gemm_phase<pg8::EpiRes, pg8::StaticOrder, true, true>(lds, g, S, E);
            SEAM(pb + 5);
        } }
        if (IN(pb + 6)) { ARG_VARS;
            if (!lastl) { pg8::Gemm g{Y + (size_t)ML * D, WOUT + (size_t)l * D * D, MC, D, D, D, D}; pg8::StaticOrder S; S.init(MC, D, G, bx);
              pg8::EpiRes E{XS, modl, 2 * D, 128};
              pg8::gemm_phase<pg8::EpiRes, pg8::StaticOrder, true, true>(lds, g, S, E); }
            TID_VARS; PASS_RANGE_LAT(lastl ? 128 : 40);
            resnorm_rows<false, false, false>(XS, XS, nullptr, nullptr, g_norm2 + l * D, modl, 3 * D, 4 * D, H, r0, r1, lane);
            if (PROBE_DUP & (1 << 20)) resnorm_rows<false, false, false>(XS, XS, nullptr, nullptr, g_norm2 + l * D, modl, 3 * D, 4 * D, H, r0, r1, lane);
            SEAM(pb + 6); }
        if (IN(pb + 7)) { ARG_VARS; if (!lastl) { TID_VARS; PASS_RANGE_CTX();
                resnorm_rows<false, false, false>(XS, XS + (size_t)ML * D, nullptr, nullptr, g_norm2 + l * D, modl, 3 * D, 4 * D, H, r0, r1, lane); }
            if (!lastl) SEAM(pb + 7); }
        REP(8) { if (rep_) xcd_barrier(bar);
        if (IN(pb + 8)) { ARG_VARS;
            pg8::Gemm g{H, WGU + (size_t)l * NGU * D, Mrows, NGU, D, D, D}; pg8::StaticOrder S; S.init(Mrows, NGU, G, bx);
            pg8::EpiGU E{HF};
            pg8::gemm_phase<pg8::EpiGU, pg8::StaticOrder, true, true>(lds, g, S, E);
            if (!lastl) { const int rem = ((Mrows / 256) * 44) % G;
              if (rem != 0 && bx >= rem) { TID_VARS; tr_win(w_in + (size_t)(l + 1) * D * NPROJ, WIN + (size_t)(l + 1) * NPROJ * D, (LAS float*)(lds + wave * 17408), (bx - rem) * NWAVES + wave, (G - rem) * NWAVES, lane); }
              else if (rem == 0) { TID_VARS; tr_win(w_in + (size_t)(l + 1) * D * NPROJ, WIN + (size_t)(l + 1) * NPROJ * D, (LAS float*)(lds + wave * 17408), gw, NGW, lane); }
            }
            SEAM(pb + 8);
        } }
        REP(9) { if (rep_) xcd_barrier(bar);
        if (IN(pb + 9)) { ARG_VARS;
            pg8::Gemm g{HF, WDN + (size_t)l * D * DFF, ML, D, DFF, DFF, DFF}; pg8::StaticOrder S; S.init(ML, D, G, bx);
            pg8::EpiRes E{XS, modl, 5 * D, 0};
            pg8::gemm_phase<pg8::EpiRes, pg8::StaticOrder, true, true>(lds, g, S, E);
            SEAM(pb + 9);
        } }
    }
    if (IN(PH_FINAL)) { const int l = 0; ARG_VARS; TID_VARS; final_rows(XS, g_final, a.out, gw, NGW, lane); }
#undef IN
#undef SEAM
}

extern "C" void kernel_launch(void* const* d_in, const int* in_sizes, int n_in, void* d_out, int out_size, void* d_ws, size_t ws_size, hipStream_t stream) {
    static int grid = 0;
    if (grid == 0) {
        if (n_in != 18 || in_sizes[0] != ML * D || out_size != ML * D || ws_size < WS_END) { fprintf(stderr, "kernel_launch: unexpected shapes: n_in %d in0 %d out %d ws %zu (need %zu)\n", n_in, n_in > 0 ? in_sizes[0] : -1, out_size, ws_size, (size_t)WS_END); grid = -1; return; }
        int dev = 0, cus = 0, per_cu = 0;
        if (hipGetDevice(&dev) != hipSuccess || hipDeviceGetAttribute(&cus, hipDeviceAttributeMultiprocessorCount, dev) != hipSuccess) { fprintf(stderr, "kernel_launch: device query failed\n"); grid = -1; return; }
        if (hipFuncSetAttribute((const void*)fwd, hipFuncAttributeMaxDynamicSharedMemorySize, LDS_BYTES) != hipSuccess) { fprintf(stderr, "kernel_launch: hipFuncSetAttribute failed\n"); grid = -1; return; }
        if (hipOccupancyMaxActiveBlocksPerMultiprocessor(&per_cu, (const void*)fwd, NTHREADS, LDS_BYTES) != hipSuccess || per_cu < 1) fprintf(stderr, "kernel_launch: note: occupancy query reports %d workgroups per CU\n", per_cu);
        (void)hipGetLastError();
        grid = cus;
    }
    if (grid < 0) return;
    if (hipMemsetAsync((char*)d_ws + WS_CTL, 0, 32768  , stream) != hipSuccess) { fprintf(stderr, "kernel_launch: memset failed\n"); return; }
    Args a{};
    for (int i = 0; i < 18; ++i) a.in[i] = (const float*)d_in[i];
    a.out = (float*)d_out; a.ws = (unsigned char*)d_ws; a.pad = 0;
#if MK_ONE_LAUNCH
    a.ph_lo = 0; a.ph_hi = NPH; a.use_bar = 1;
    hipLaunchKernelGGL(fwd, dim3(grid), dim3(NTHREADS), LDS_BYTES, stream, a);
#else
    for (int ph = 0; ph < NPH; ++ph) { a.ph_lo = ph; a.ph_hi = ph + 1; a.use_bar = 0; hipLaunchKernelGGL(fwd, dim3(grid), dim3(NTHREADS), LDS_BYTES, stream, a); }
#endif
    const hipError_t le = hipPeekAtLastError();
    if (le != hipSuccess) fprintf(stderr, "kernel_launch: launch failed: %s\n", hipGetErrorName(le));
}
```
